# Optimizing an MI355X kernel written in HIP

```python
import math
import jax, jax.numpy as jnp
from jax import lax
import numpy as np

D_MODEL = 4096
BATCH = 2
SEQ = 4096
DEPTH = 1

PLE_DIM = 256
BLOCK = 128
ROPE_THETA = 10000.0
LN_EPS = 1e-5
RMS_EPS = 1e-6
NEG_INF = -1e30

SWA_HEAD_DIM = 64
SWA_WIDTH = D_MODEL // 2
SWA_HEADS = SWA_WIDTH // SWA_HEAD_DIM
SWA_KV_HEADS = SWA_HEADS // 8
SWA_KV_WIDTH = SWA_KV_HEADS * SWA_HEAD_DIM
SWA_WINDOW = 128

SB_HEAD_DIM = 128
SB_WIDTH = D_MODEL - SWA_WIDTH
SB_HEADS = SB_WIDTH // SB_HEAD_DIM

MIX_WIDTH = SWA_WIDTH + SB_WIDTH
IN_WIDTH = SWA_WIDTH + 2 * SWA_KV_WIDTH + 3 * SB_WIDTH

N_GROUPS = 4
EXPERTS_PER_GROUP = 8
N_EXPERTS = N_GROUPS * EXPERTS_PER_GROUP
EXPERT_TOP_K = 2
D_EXPERT = D_MODEL // 8

DEEPNORM_ALPHA = (2.0 * DEPTH) ** 0.25
DEEPNORM_BETA = (8.0 * DEPTH) ** -0.25

kernel_name = "hymba_swa_sink_stickbreak_hmoe_deepnorm"


def layer_norm(x, g, b):
    xf = x.astype(jnp.float32)
    mu = jnp.mean(xf, axis=-1, keepdims=True)
    var = jnp.mean(jnp.square(xf - mu), axis=-1, keepdims=True)
    return ((xf - mu) * lax.rsqrt(var + LN_EPS) * g.astype(jnp.float32) + b.astype(jnp.float32)).astype(x.dtype)


def rms_norm(x, g):
    xf = x.astype(jnp.float32)
    return (xf * lax.rsqrt(jnp.mean(xf * xf, axis=-1, keepdims=True) + RMS_EPS) * g.astype(jnp.float32)).astype(x.dtype)


def apply_rope(x, positions):
    d = x.shape[-1]
    inv_freq = ROPE_THETA ** (-jnp.arange(0, d, 2, dtype=jnp.float32) / d)
    ang = positions.astype(jnp.float32)[..., None] * inv_freq
    cos = jnp.cos(ang)[:, :, None, :]
    sin = jnp.sin(ang)[:, :, None, :]
    x1, x2 = jnp.split(x.astype(jnp.float32), 2, axis=-1)
    return jnp.concatenate([x1 * cos - x2 * sin, x2 * cos + x1 * sin], axis=-1).astype(x.dtype)


def sliding_window_sink_attention(q, k, v, sinks):
    B, S, Hq, d = q.shape
    Hkv = k.shape[2]
    G = Hq // Hkv
    nb = S // BLOCK
    qb = q.reshape(B, nb, BLOCK, Hkv, G, d)

    def band(t):
        tb = t.reshape(B, nb, BLOCK, Hkv, d)
        prev = jnp.pad(tb, ((0, 0), (1, 0), (0, 0), (0, 0), (0, 0)))[:, :-1]
        return jnp.concatenate([prev, tb], axis=2)

    kb, vb = band(k), band(v)
    scores = jnp.einsum('bnqhgd,bnkhd->bnhgqk', qb, kb).astype(jnp.float32) / math.sqrt(d)
    blk = jnp.arange(nb)[:, None, None]
    qpos = blk * BLOCK + jnp.arange(BLOCK)[None, :, None]
    kpos = (blk - 1) * BLOCK + jnp.arange(2 * BLOCK)[None, None, :]
    rel = qpos - kpos
    valid = (rel >= 0) & (rel < SWA_WINDOW) & (kpos >= 0)
    scores = jnp.where(valid[None, :, None, None], scores, NEG_INF)
    sink_col = jnp.broadcast_to(
        sinks.astype(jnp.float32).reshape(Hkv, G)[None, None, :, :, None, None],
        scores.shape[:-1] + (1,))
    probs = jax.nn.softmax(jnp.concatenate([scores, sink_col], axis=-1), axis=-1)[..., :-1]
    out = jnp.einsum('bnhgqk,bnkhd->bnqhgd', probs.astype(v.dtype), vb)
    return out.reshape(B, S, Hq * d)


def stick_breaking_attention(q, k, v):
    B, S, H, d = q.shape
    nb = S // BLOCK
    q_blocks = q.reshape(B, nb, BLOCK, H, d).transpose(1, 0, 2, 3, 4)
    kpos = jnp.arange(S)

    def one_block(args):
        q_blk, n = args
        z = jnp.einsum('bqhd,bkhd->bhqk', q_blk, k).astype(jnp.float32) / math.sqrt(d)
        qpos = n * BLOCK + jnp.arange(BLOCK)
        causal = kpos[None, :] < qpos[:, None]
        log_not = jnp.where(causal, jax.nn.log_sigmoid(-z), 0.0)
        suffix = lax.cumsum(log_not, axis=log_not.ndim - 1, reverse=True)
        log_a = jax.nn.log_sigmoid(z) + suffix - log_not
        a = jnp.where(causal, jnp.exp(log_a), 0.0)
        return jnp.einsum('bhqk,bkhd->bqhd', a.astype(v.dtype), v)

    out = lax.map(one_block, (q_blocks, jnp.arange(nb)))
    return out.transpose(1, 0, 2, 3, 4).reshape(B, S, H * d)


def hierarchical_moe(h, w_group, b_group, w_er, b_er, w_gate, w_up, w_down):
    B, S, D = h.shape
    t = h.reshape(-1, D)
    g_logits = (t @ w_group + b_group).astype(jnp.float32)
    g_prob = jax.nn.softmax(g_logits, axis=-1)
    g_idx = jnp.argmax(g_logits, axis=-1)
    g_w = jnp.take_along_axis(g_prob, g_idx[:, None], axis=-1)
    e_all = jnp.einsum('nd,gde->nge', t, w_er) + b_er
    e_logits = jnp.take_along_axis(e_all, g_idx[:, None, None], axis=1)[:, 0].astype(jnp.float32)
    top_val, top_idx = lax.top_k(e_logits, EXPERT_TOP_K)
    top_w = jax.nn.softmax(top_val, axis=-1) * g_w
    flat_idx = g_idx[:, None] * EXPERTS_PER_GROUP + top_idx
    combine = jnp.sum(jax.nn.one_hot(flat_idx, N_EXPERTS, dtype=jnp.float32) * top_w[..., None], axis=1)
    gate = jnp.einsum('nd,xdf->nxf', t, w_gate)
    up = jnp.einsum('nd,xdf->nxf', t, w_up)
    act = jax.nn.silu(gate) * up * combine[..., None].astype(t.dtype)
    out = jnp.einsum('nxf,xfd->nd', act, w_down)
    return out.reshape(B, S, D)


def setup_inputs(seed: int = 0) -> dict:
    key = jax.random.key(seed)
    ks = jax.random.split(key, 24)
    f32 = jnp.float32
    nrm = lambda k, shape, s: jax.random.normal(k, shape, f32) * s
    x = nrm(ks[0], (BATCH, SEQ, D_MODEL), 1.0)
    p = nrm(ks[1], (DEPTH, BATCH, SEQ, PLE_DIM), 1.0)
    offset = jax.random.randint(ks[2], (BATCH, 1), 0, 1024, dtype=jnp.int32)
    positions = (jnp.arange(SEQ, dtype=jnp.int32)[None, :] + offset).astype(jnp.int32)
    return {
        "x": x,
        "p": p,
        "positions": positions,
        "w_in": nrm(ks[3], (DEPTH, D_MODEL, IN_WIDTH), D_MODEL ** -0.5),
        "b_in": nrm(ks[4], (DEPTH, IN_WIDTH), 0.01),
        "sinks": nrm(ks[5], (DEPTH, SWA_HEADS), 0.5),
        "g_norm_a": 1.0 + nrm(ks[6], (DEPTH, SWA_WIDTH), 0.05),
        "g_norm_b": 1.0 + nrm(ks[7], (DEPTH, SB_WIDTH), 0.05),
        "w_out": nrm(ks[8], (DEPTH, MIX_WIDTH, D_MODEL), DEEPNORM_BETA * MIX_WIDTH ** -0.5),
        "b_out": nrm(ks[9], (DEPTH, D_MODEL), 0.01),
        "ln1_g": 1.0 + nrm(ks[10], (DEPTH, D_MODEL), 0.05),
        "ln1_b": nrm(ks[11], (DEPTH, D_MODEL), 0.01),
        "w_group": nrm(ks[12], (DEPTH, D_MODEL, N_GROUPS), D_MODEL ** -0.5),
        "b_group": nrm(ks[13], (DEPTH, N_GROUPS), 0.01),
        "w_er": nrm(ks[14], (DEPTH, N_GROUPS, D_MODEL, EXPERTS_PER_GROUP), D_MODEL ** -0.5),
        "b_er": nrm(ks[15], (DEPTH, N_GROUPS, EXPERTS_PER_GROUP), 0.01),
        "w_gate": nrm(ks[16], (DEPTH, N_EXPERTS, D_MODEL, D_EXPERT), D_MODEL ** -0.5),
        "w_up": nrm(ks[17], (DEPTH, N_EXPERTS, D_MODEL, D_EXPERT), D_MODEL ** -0.5),
        "w_down": nrm(ks[18], (DEPTH, N_EXPERTS, D_EXPERT, D_MODEL), DEEPNORM_BETA * D_EXPERT ** -0.5),
        "w_ple_gate": nrm(ks[19], (DEPTH, D_MODEL, D_MODEL), D_MODEL ** -0.5),
        "b_ple_gate": nrm(ks[20], (DEPTH, D_MODEL), 0.01),
        "w_ple_proj": nrm(ks[21], (DEPTH, PLE_DIM, D_MODEL), DEEPNORM_BETA * PLE_DIM ** -0.5),
        "ln2_g": 1.0 + nrm(ks[22], (DEPTH, D_MODEL), 0.05),
        "ln2_b": nrm(ks[23], (DEPTH, D_MODEL), 0.01),
    }


def reference(x, p, positions, w_in, b_in, sinks, g_norm_a, g_norm_b, w_out, b_out,
              ln1_g, ln1_b, w_group, b_group, w_er, b_er, w_gate, w_up, w_down,
              w_ple_gate, b_ple_gate, w_ple_proj, ln2_g, ln2_b):
    B, S, _ = x.shape
    splits = [SWA_WIDTH,
              SWA_WIDTH + SWA_KV_WIDTH,
              SWA_WIDTH + 2 * SWA_KV_WIDTH,
              SWA_WIDTH + 2 * SWA_KV_WIDTH + SB_WIDTH,
              SWA_WIDTH + 2 * SWA_KV_WIDTH + 2 * SB_WIDTH]
    for i in range(DEPTH):
        proj = x @ w_in[i] + b_in[i]
        qa, ka, va, qb, kb, vb = jnp.split(proj, splits, axis=-1)
        qa = apply_rope(qa.reshape(B, S, SWA_HEADS, SWA_HEAD_DIM), positions)
        ka = apply_rope(ka.reshape(B, S, SWA_KV_HEADS, SWA_HEAD_DIM), positions)
        va = va.reshape(B, S, SWA_KV_HEADS, SWA_HEAD_DIM)
        o_a = sliding_window_sink_attention(qa, ka, va, sinks[i])
        o_b = stick_breaking_attention(qb.reshape(B, S, SB_HEADS, SB_HEAD_DIM),
                                       kb.reshape(B, S, SB_HEADS, SB_HEAD_DIM),
                                       vb.reshape(B, S, SB_HEADS, SB_HEAD_DIM))
        mixed = jnp.concatenate([rms_norm(o_a, g_norm_a[i]), rms_norm(o_b, g_norm_b[i])], axis=-1)
        mix_out = mixed @ w_out[i] + b_out[i]
        x = layer_norm(DEEPNORM_ALPHA * x + mix_out, ln1_g[i], ln1_b[i])
        moe_out = hierarchical_moe(x, w_group[i], b_group[i], w_er[i], b_er[i],
                                   w_gate[i], w_up[i], w_down[i])
        ple = jax.nn.sigmoid(x @ w_ple_gate[i] + b_ple_gate[i]) * (p[i] @ w_ple_proj[i])
        x = layer_norm(DEEPNORM_ALPHA * x + moe_out + ple, ln2_g[i], ln2_b[i])
    return x
```

```cpp
#include <hip/hip_runtime.h>
#include <cstdio>
#include <cstdint>

namespace pg8 {
#define PG8_LAS __attribute__((address_space(3)))
typedef unsigned short bf16_t;
typedef short bf16x8 __attribute__((ext_vector_type(8)));
typedef float f32x4 __attribute__((ext_vector_type(4)));
typedef float f32x2 __attribute__((ext_vector_type(2)));
typedef unsigned u32x4 __attribute__((ext_vector_type(4)));
typedef unsigned u32x2 __attribute__((ext_vector_type(2)));
typedef __bf16 bf16x2_t __attribute__((ext_vector_type(2)));
typedef int v4i_t __attribute__((ext_vector_type(4)));
typedef int v8i_t __attribute__((ext_vector_type(8)));
constexpr int BM = 256, BK = 64, HALF = 128, HTB = HALF * BK * 2  , STAGE_BYTES = 8 * HTB, NXCD = 8, WGM = 8;

__host__ __device__ __forceinline__ int lds_byte(int r, int c) { const int st = (r >> 4) * 2 + (c >> 5), rr = r & 15, cc = c & 31, ob = rr * 64 + cc * 2; return st * 1024 + (ob ^ (((ob >> 9) & 1) << 5)); }
__host__ __device__ __forceinline__ void stage_rc(int b, int& R, int& C) { const int st = b / 1024, sb = b % 1024, swz = sb ^ (((sb >> 9) & 1) << 5); R = (st >> 1) * 16 + swz / 64; C = (st & 1) * 32 + (swz % 64) / 2; }
__host__ __device__ __forceinline__ int perm32(int rho) { const int n = rho >> 4, i = rho & 15; return 8 * (i >> 2) + 4 * n + (i & 3); }
template <int PM> __host__ __device__ __forceinline__ int bperm(int R) {
    if (PM == 1) return (R & ~31) + perm32(R & 31);
    if (PM == 2) { const int wc = R >> 5, n = (R >> 4) & 1, i = R & 15; return 64 * (wc >> 1) + 16 * (wc & 1) + i + 32 * n; }
    return R;
}

struct Unit { int pm, pn, e, lt; };
struct Gemm { const bf16_t* A; const bf16_t* Bt; int M, N, K; };

struct StaticOrder {
    static constexpr bool GATHER = false;
    int nM, nN, nwg, G, c;
    __host__ __device__ void init(int M, int N, int G_, int c_) { nM = M / BM; nN = N / BM; nwg = nM * nN; G = G_; c = c_; }
    __host__ __device__ bool next(int i, Unit& u) const {
        const long L = (long)i * G + c; if (L >= nwg) return false;
        int wgid = (int)L; { const int q = nwg / NXCD, r = nwg % NXCD, xcd = wgid % NXCD, off = wgid / NXCD; wgid = (xcd < r ? xcd * (q + 1) : r * (q + 1) + (xcd - r) * q) + off; }
        const int nig = WGM * nN, gid = wgid / nig, fm = gid * WGM, gsz = (nM - fm) < WGM ? (nM - fm) : WGM;
        u.pm = fm + ((wgid % nig) % gsz); u.pn = (wgid % nig) / gsz; u.e = 0; u.lt = 0; return true;
    }
    __device__ __forceinline__ void a_ready(const Unit&) const {}
    __device__ __forceinline__ void done(const Unit&) const {}
};
struct GroupedOrder {
    static constexpr bool GATHER = false;
    const PG8_LAS int* tstart; int nN, total, G, c;
    __device__ __forceinline__ bool next(int i, Unit& u) const {
        const int L = i * G + c; if (L >= total * nN) return false;
        const int mt = L / nN, pn = L - mt * nN; int e = 0;
        while (e < 31 && tstart[e + 1] <= mt) ++e;
        u.pm = mt; u.pn = e * nN + pn; u.e = e; u.lt = mt - tstart[e]; return true;
    }
    __device__ __forceinline__ void a_ready(const Unit&) const {}
    __device__ __forceinline__ void done(const Unit&) const {}
};

struct DenseList {
    static constexpr bool GATHER = false;
    int nM, nN, nwg, v0, stride, n;
    __device__ __forceinline__ void init(int M, int N, int v0_, int stride_, int n_) { nM = M / BM; nN = N / BM; nwg = nM * nN; v0 = v0_; stride = stride_; n = n_; }
    __device__ __forceinline__ bool next(int i, Unit& u) const {
        if (i >= n) return false;
        int wgid = v0 + stride * i; if (wgid >= nwg) return false;
        { const int q = nwg / NXCD, r = nwg % NXCD, xcd = wgid % NXCD, off = wgid / NXCD; wgid = (xcd < r ? xcd * (q + 1) : r * (q + 1) + (xcd - r) * q) + off; }
        const int nig = WGM * nN, gid = wgid / nig, fm = gid * WGM, gsz = (nM - fm) < WGM ? (nM - fm) : WGM;
        u.pm = fm + ((wgid % nig) % gsz); u.pn = (wgid % nig) / gsz; u.e = 0; u.lt = 0; return true;
    }
    __device__ __forceinline__ void a_ready(const Unit&) const {}
    __device__ __forceinline__ void done(const Unit&) const {}
};
template <bool GATHER_> struct GroupedList {
    static constexpr bool GATHER = GATHER_;
    const PG8_LAS int* tstart; int nN, total, l0, stride, n;
    const int* list;
    __device__ __forceinline__ void a_rows(const Unit& u, const int (&R)[2], int (&rows)[2][2]) const {
        const int n_e = tstart[33 + u.e];
#pragma unroll
        for (int h = 0; h < 2; ++h)
#pragma unroll
            for (int i = 0; i < 2; ++i) { const int ii = u.lt * BM + h * HALF + R[i]; rows[h][i] = ii < n_e ? (list[u.e * 8192 + ii] >> 1) : 0; }
    }
    __device__ __forceinline__ bool next(int i, Unit& u) const {
        if (i >= n) return false;
        const int L = l0 + stride * i; if (L >= total * nN) return false;
        const int mt = L / nN, pn = L - mt * nN; int e = 0;
        while (e < 31 && tstart[e + 1] <= mt) ++e;
        u.pm = mt; u.pn = e * nN + pn; u.e = e; u.lt = mt - tstart[e]; return true;
    }
    __device__ __forceinline__ void a_ready(const Unit&) const {}
    __device__ __forceinline__ void done(const Unit&) const {}
};

__device__ __forceinline__ unsigned cvt_pk_bf16(float lo, float hi) { f32x2 v = {lo, hi}; bf16x2_t b = __builtin_convertvector(v, bf16x2_t); return __builtin_bit_cast(unsigned, b); }

__device__ __forceinline__ unsigned cvt_pk_fp8x4(float a_, float b_, float c_, float d_) { int w = 0; w = __builtin_amdgcn_cvt_pk_fp8_f32(a_, b_, w, false); w = __builtin_amdgcn_cvt_pk_fp8_f32(c_, d_, w, true); return (unsigned)w; }

constexpr float LOG2E = 1.4426950408889634f;
constexpr float ALPHA = 1.189207115002721f;
constexpr float QA_SCALE = 0.18033688011112042f;
constexpr float QB_SCALE = 0.12751743082459868f;


struct EpiPlainBf16 {
    static constexpr int PM = 1; static constexpr bool AFTER_DRAIN = false, MIDK = false;
    bf16_t* O; int ldc;
    __device__ __forceinline__ void operator()(const f32x4 (&acc)[2][2][4][2], const Unit& u, int wr, int wc, int fr, int fq) const {
        const int row0 = u.pm * BM + wr * 64 + fr, col0 = u.pn * BM + wc * 32 + 8 * fq;
#pragma unroll
        for (int ai = 0; ai < 2; ++ai)
#pragma unroll
            for (int m = 0; m < 4; ++m) { bf16_t* rowp = O + (size_t)(row0 + ai * HALF + m * 16) * ldc + col0;
#pragma unroll
                for (int bj = 0; bj < 2; ++bj) { const f32x4 v0 = acc[ai][bj][m][0], v1 = acc[ai][bj][m][1];
                    u32x4 w; w.x = cvt_pk_bf16(v0[0], v0[1]); w.y = cvt_pk_bf16(v0[2], v0[3]); w.z = cvt_pk_bf16(v1[0], v1[1]); w.w = cvt_pk_bf16(v1[2], v1[3]);
                    *(u32x4*)(rowp + bj * HALF) = w; } }
    }
};

struct EpiProj {
    static constexpr int PM = 2; static constexpr bool AFTER_DRAIN = false, MIDK = false;
    bf16_t* O; const float* bias; const float* cs;
    static constexpr int ST_OFF = 131072, ST_ROWB = 272, ST_TILE = 32 * ST_ROWB;
    __device__ __forceinline__ void epi_staged(const f32x4 (&acc)[2][2][4][2], const Unit& u, int wr, int wc, int fr, int fq, PG8_LAS unsigned char* lds, int wid, int lane) const {
        constexpr int LD = 8704;
        const int row0 = u.pm * BM + wr * 64 + fr, tile = u.pn;
        const bool rope = tile < 9;
        const float sc = tile < 8 ? QA_SCALE : ((tile >= 10 && tile < 18) ? QB_SCALE : 1.0f);
        const int p0 = 16 * (wc & 1) + 4 * fq;
        const int wofs = (wr * 16 + fr) * ST_ROWB + (64 * (wc >> 1) + p0) * 2;
        const int t = wid * 64 + lane, rr_ = t >> 4, ch = t & 15;
        const int rofs = rr_ * ST_ROWB + ch * 16;
        bf16_t* gout = O + (size_t)(u.pm * BM + (rr_ >> 4) * 64 + (rr_ & 15)) * LD + tile * BM + ch * 8;
        int step = 0;
#pragma unroll
        for (int bj = 0; bj < 2; ++bj) {
            const int cb = tile * BM + HALF * bj + 64 * (wc >> 1) + p0;
            const f32x4 blo = *(const f32x4*)(bias + cb), bhi = *(const f32x4*)(bias + cb + 32);
#pragma unroll
            for (int ai = 0; ai < 2; ++ai)
#pragma unroll
                for (int m = 0; m < 4; ++m) {
                    const int row = row0 + ai * HALF + m * 16;
                    f32x4 a = acc[ai][bj][m][0] + blo, b = acc[ai][bj][m][1] + bhi;
                    if (rope) {
                        const f32x4 c01 = *(const f32x4*)(cs + (size_t)row * 64 + 2 * p0), c23 = *(const f32x4*)(cs + (size_t)row * 64 + 2 * p0 + 4);
                        const f32x4 co = {c01[0], c01[2], c23[0], c23[2]}, si = {c01[1], c01[3], c23[1], c23[3]};
                        const f32x4 ra = a * co - b * si, rb = b * co + a * si; a = ra; b = rb;
                    }
                    a = a * sc; b = b * sc;
                    u32x2 wa, wb; wa.x = cvt_pk_bf16(a[0], a[1]); wa.y = cvt_pk_bf16(a[2], a[3]); wb.x = cvt_pk_bf16(b[0], b[1]); wb.y = cvt_pk_bf16(b[2], b[3]);
                    PG8_LAS unsigned char* st = lds + ST_OFF + (step & 1) * ST_TILE;
                    *(PG8_LAS u32x2*)(st + wofs) = wa; *(PG8_LAS u32x2*)(st + wofs + 64) = wb;
                    asm volatile("s_waitcnt lgkmcnt(0)" ::: "memory");
                    __builtin_amdgcn_s_barrier();
                    const u32x4 v = *(const PG8_LAS u32x4*)(st + rofs);
                    *(u32x4*)(gout + (size_t)(ai * HALF + m * 16) * LD + bj * HALF) = v;
                    ++step;
                }
        }
        asm volatile("s_waitcnt lgkmcnt(0)" ::: "memory");
    }
};

#ifndef D_FP8
#define D_FP8 1
#endif
#ifndef D_KSPLIT
#define D_KSPLIT 2048
#endif
constexpr int OKS = D_FP8 ? D_KSPLIT : 4096, ORB = OKS * 2 + (4096 - OKS);
constexpr int O_TSPLIT = D_FP8 ? OKS / 64 : 0, O_MIDT = !D_FP8 ? 0 : (OKS >= 2048 ? 32 : OKS / 64 + (2048 - OKS) / 128);
static_assert(OKS % 128 == 0 && OKS >= 0 && OKS <= 4096 && (O_MIDT % 2) == 0, "D_KSPLIT");
struct EpiWout {
    static constexpr int PM = 1; static constexpr bool AFTER_DRAIN = false, MIDK = true; static constexpr int MIDK_T = O_MIDT;
    const bf16_t* xb; bf16_t* Y; const float* bias; const float* rr;
    static constexpr int RRT_OFF = 131072;
    __device__ __forceinline__ void unit_begin(PG8_LAS unsigned char* lds, const Unit& u, int par, int wid, int lane) const {
        __builtin_amdgcn_global_load_lds((const unsigned*)(rr + 2 * (size_t)(u.pm * BM) + 64 * wid + lane), (PG8_LAS unsigned*)(lds + RRT_OFF + par * 2048 + wid * 256), 4, 0, 0);
    }
    __device__ __forceinline__ void midk(f32x4 (&acc)[2][2][4][2], const Unit& u, int wr, int fr, PG8_LAS unsigned char* lds, int par) const {
        const PG8_LAS float* rt = (const PG8_LAS float*)(lds + RRT_OFF + par * 2048);
#pragma unroll
        for (int ai = 0; ai < 2; ++ai)
#pragma unroll
            for (int m = 0; m < 4; ++m) { const f32x2 r = *(const PG8_LAS f32x2*)(rt + 2 * (ai * HALF + wr * 64 + m * 16 + fr));
                const float ratio = r.x / r.y;
#pragma unroll
                for (int bj = 0; bj < 2; ++bj)
#pragma unroll
                    for (int n = 0; n < 2; ++n) acc[ai][bj][m][n] = acc[ai][bj][m][n] * ratio;
                asm volatile("" : "+v"(acc[ai][0][m][0]), "+v"(acc[ai][0][m][1]), "+v"(acc[ai][1][m][0]), "+v"(acc[ai][1][m][1])); }
    }
    __device__ __forceinline__ void epi(const f32x4 (&acc)[2][2][4][2], const Unit& u, int wr, int wc, int fr, int fq, PG8_LAS unsigned char* lds, int par) const {
        constexpr int LD = 4096;
        const PG8_LAS float* rt = (const PG8_LAS float*)(lds + RRT_OFF + par * 2048);
        const int row0 = u.pm * BM + wr * 64 + fr, col0 = u.pn * BM + wc * 32 + 8 * fq;
        f32x4 bv[2][2];
#pragma unroll
        for (int bj = 0; bj < 2; ++bj)
#pragma unroll
            for (int n = 0; n < 2; ++n) bv[bj][n] = *(const f32x4*)(bias + col0 + bj * HALF + 4 * n);
        u32x4 xq[4][2][2];
#define EPW_LOAD(b_) do { _Pragma("unroll") for (int m_ = 0; m_ < 2; ++m_) { const size_t off_ = (size_t)(row0 + ((b_) >> 1) * HALF + (2 * ((b_) & 1) + m_) * 16) * LD + col0; xq[b_][m_][0] = *(const u32x4*)(xb + off_); xq[b_][m_][1] = *(const u32x4*)(xb + off_ + HALF); } } while (0)
        EPW_LOAD(0);
#pragma unroll
        for (int b = 0; b < 4; ++b) { const int ai = b >> 1;
            if (b == 0) EPW_LOAD(1); else if (b == 1) EPW_LOAD(2); else if (b == 2) EPW_LOAD(3);
            asm volatile("" ::: "memory");
#pragma unroll
            for (int mm = 0; mm < 2; ++mm) { const int m = 2 * (b & 1) + mm; const int row = row0 + ai * HALF + m * 16; const float rb = rt[2 * (ai * HALF + wr * 64 + m * 16 + fr) + 1]; const size_t off = (size_t)row * LD + col0;
#pragma unroll
                for (int bj = 0; bj < 2; ++bj) { const u32x4 xw = xq[b][mm][bj];
                    const f32x4 xa = {__uint_as_float(xw.x << 16), __uint_as_float(xw.x & 0xffff0000u), __uint_as_float(xw.y << 16), __uint_as_float(xw.y & 0xffff0000u)};
                    const f32x4 xc = {__uint_as_float(xw.z << 16), __uint_as_float(xw.z & 0xffff0000u), __uint_as_float(xw.w << 16), __uint_as_float(xw.w & 0xffff0000u)};
                    const f32x4 v0 = xa * ALPHA + acc[ai][bj][m][0] * rb + bv[bj][0], v1 = xc * ALPHA + acc[ai][bj][m][1] * rb + bv[bj][1];
                    u32x4 w; w.x = cvt_pk_bf16(v0[0], v0[1]); w.y = cvt_pk_bf16(v0[2], v0[3]); w.z = cvt_pk_bf16(v1[0], v1[1]); w.w = cvt_pk_bf16(v1[2], v1[3]);
                    *(u32x4*)(Y + off + bj * HALF) = w; } }
            asm volatile("" ::: "memory"); }
#undef EPW_LOAD
    }
};

struct EpiGateUp {
    static constexpr int PM = 1; static constexpr bool AFTER_DRAIN = false, MIDK = false;
    unsigned char* H;
    __device__ __forceinline__ void operator()(const f32x4 (&acc)[2][2][4][2], const Unit& u, int wr, int wc, int fr, int fq) const {
        constexpr int LD = 512;
        const int row0 = u.pm * BM + wr * 64 + fr, col0 = (u.pn & 3) * HALF + wc * 32 + 8 * fq;
#pragma unroll
        for (int ai = 0; ai < 2; ++ai)
#pragma unroll
            for (int m = 0; m < 4; ++m) {
                float h[8];
#pragma unroll
                for (int n = 0; n < 2; ++n)
#pragma unroll
                    for (int j = 0; j < 4; ++j) { const float g = acc[ai][0][m][n][j], up = acc[ai][1][m][n][j];
                        const float sg = __builtin_amdgcn_rcpf(1.0f + __builtin_amdgcn_exp2f(-g * LOG2E));
                        h[4 * n + j] = g * sg * up; }
                u32x2 w; w.x = cvt_pk_fp8x4(h[0], h[1], h[2], h[3]); w.y = cvt_pk_fp8x4(h[4], h[5], h[6], h[7]);
                *(u32x2*)(H + (size_t)(row0 + ai * HALF + m * 16) * LD + col0) = w;
            }
    }
};

struct EpiDown {
    static constexpr int PM = 1; static constexpr bool AFTER_DRAIN = false, MIDK = false;
    bf16_t* MOE; const int* list; const float* wts; const PG8_LAS int* cnt;
    __device__ __forceinline__ void operator()(const f32x4 (&acc)[2][2][4][2], const Unit& u, int wr, int wc, int fr, int fq) const {
        constexpr int LD = 4096, MTOK = 8192;
        const int n_e = cnt[u.e], i0 = u.lt * BM + wr * 64 + fr, col0 = (u.pn & 15) * BM + wc * 32 + 8 * fq;
#pragma unroll
        for (int ai = 0; ai < 2; ++ai)
#pragma unroll
            for (int m = 0; m < 4; ++m) {
                const int i = i0 + ai * HALF + m * 16;
                if (i < n_e) {
                    const int ent = list[u.e * MTOK + i]; const float w = wts[ent];
                    bf16_t* rowp = MOE + ((size_t)(ent & 1) * MTOK + (size_t)(ent >> 1)) * LD + col0;
#pragma unroll
                    for (int bj = 0; bj < 2; ++bj) { const f32x4 v0 = acc[ai][bj][m][0] * w, v1 = acc[ai][bj][m][1] * w;
                        u32x4 o; o.x = cvt_pk_bf16(v0[0], v0[1]); o.y = cvt_pk_bf16(v0[2], v0[3]); o.z = cvt_pk_bf16(v1[0], v1[1]); o.w = cvt_pk_bf16(v1[2], v1[3]);
                        *(u32x4*)(rowp + bj * HALF) = o; }
                }
            }
    }
};

struct EpiPle {
    static constexpr int PM = 1; static constexpr bool AFTER_DRAIN = false, MIDK = false;
    const bf16_t* Y1; bf16_t* Y2; const float* bias; const bf16_t* pp; const float* stats; const float* lng; const float* lnb;
    __device__ __forceinline__ void operator()(const f32x4 (&acc)[2][2][4][2], const Unit& u, int wr, int wc, int fr, int fq) const {
        constexpr int LD = 4096;
        const int row0 = u.pm * BM + wr * 64 + fr, col0 = u.pn * BM + wc * 32 + 8 * fq;
        f32x4 bv[2][2], gv[2][2], cv[2][2];
#pragma unroll
        for (int bj = 0; bj < 2; ++bj)
#pragma unroll
            for (int n = 0; n < 2; ++n) { bv[bj][n] = *(const f32x4*)(bias + col0 + bj * HALF + 4 * n); gv[bj][n] = *(const f32x4*)(lng + col0 + bj * HALF + 4 * n); cv[bj][n] = *(const f32x4*)(lnb + col0 + bj * HALF + 4 * n); }
#pragma unroll
        for (int ai = 0; ai < 2; ++ai)
#pragma unroll
            for (int m = 0; m < 4; ++m) { const int row = row0 + ai * HALF + m * 16; const size_t off = (size_t)row * LD + col0;
                const f32x2 st = *(const f32x2*)(stats + 2 * (size_t)row);
                const u32x4 y0 = *(const u32x4*)(Y1 + off), y1 = *(const u32x4*)(Y1 + off + HALF), p0 = *(const u32x4*)(pp + off), p1 = *(const u32x4*)(pp + off + HALF);
#pragma unroll
                for (int bj = 0; bj < 2; ++bj) { const u32x4 yw = bj ? y1 : y0, pw = bj ? p1 : p0; u32x4 w;
#pragma unroll
                    for (int n = 0; n < 2; ++n) { const unsigned ya = n ? yw.z : yw.x, yb = n ? yw.w : yw.y, pa = n ? pw.z : pw.x, pb = n ? pw.w : pw.y;
                        const f32x4 yv = {__uint_as_float(ya << 16), __uint_as_float(ya & 0xffff0000u), __uint_as_float(yb << 16), __uint_as_float(yb & 0xffff0000u)};
                        const f32x4 pv = {__uint_as_float(pa << 16), __uint_as_float(pa & 0xffff0000u), __uint_as_float(pb << 16), __uint_as_float(pb & 0xffff0000u)};
                        const f32x4 x1 = (yv - st.x) * st.y * gv[bj][n] + cv[bj][n];
                        const f32x4 t = acc[ai][bj][m][n] + bv[bj][n]; f32x4 sg;
#pragma unroll
                        for (int j = 0; j < 4; ++j) sg[j] = __builtin_amdgcn_rcpf(1.0f + __builtin_amdgcn_exp2f(-t[j] * LOG2E));
                        const f32x4 o = x1 * ALPHA + sg * pv;
                        if (n == 0) { w.x = cvt_pk_bf16(o[0], o[1]); w.y = cvt_pk_bf16(o[2], o[3]); } else { w.z = cvt_pk_bf16(o[0], o[1]); w.w = cvt_pk_bf16(o[2], o[3]); } }
                    *(u32x4*)(Y2 + off + bj * HALF) = w; }
                asm volatile("" ::: "memory"); }
    }
};

template <class Epi, class Sched, bool ALIGN_EPI = false, bool SP2 = false, int ELT = 2, int TSPLIT = 0, int ASCALE = 0x7c7c7c7c>
__device__ __forceinline__ void gemm_phase(PG8_LAS unsigned char* lds, const Gemm g, const Sched& S, const Epi& E, int tid_in) {
    int tid_ = tid_in; asm volatile("" : "+v"(tid_));
    const int tid = tid_, wid = __builtin_amdgcn_readfirstlane(tid >> 6), lane = tid & 63, wr = wid >> 2, wc = wid & 3, fr = lane & 15, fq = lane >> 4;
    const int K = g.K, nt = K * ELT / (BK * 2);
    static_assert(SP2 || !Sched::GATHER, "the gather form is written for the SP2 loop only");
    unsigned voffB[2];
#pragma unroll
    for (int i = 0; i < 2; ++i) { int R, C; stage_rc(tid * 16 + i * 8192, R, C); const int Rb = bperm<Epi::PM>(R);
        voffB[i] = (unsigned)(Rb * K * ELT + C * 2); }
    unsigned vAc[2][2], vAn[2][2];
#define PG8_AOFFS(dst, unit) do { int aR[2], aC[2]; _Pragma("unroll") for (int i_ = 0; i_ < 2; ++i_) stage_rc(tid * 16 + i_ * 8192, aR[i_], aC[i_]);     \
        if constexpr (Sched::GATHER) { int rows_[2][2]; S.a_rows(unit, aR, rows_); _Pragma("unroll") for (int h_ = 0; h_ < 2; ++h_) _Pragma("unroll") for (int i_ = 0; i_ < 2; ++i_) \
            dst[h_][i_] = (unsigned)rows_[h_][i_] * (unsigned)(K * ELT) + (unsigned)(aC[i_] * 2); } \
        else { _Pragma("unroll") for (int h_ = 0; h_ < 2; ++h_) _Pragma("unroll") for (int i_ = 0; i_ < 2; ++i_) dst[h_][i_] = (unsigned)((h_ * HALF + aR[i_]) * K * ELT + aC[i_] * 2); } } while (0)
    const size_t kstep = (size_t)(BK * 2);
    const size_t hstep = (size_t)HALF * K * ELT;
    const size_t tstep = 2 * hstep;
    const unsigned ldsw = (unsigned)wid * 1024u;
    const int aoff = lds_byte(wr * 64 + fr, fq * 8), boff = lds_byte(wc * 32 + fr, fq * 8);
#define PG8_SA(b, h) (((b) * 2 + (h)) * HTB)
#define PG8_SB(b, h) ((4 + (b) * 2 + (h)) * HTB)
#define PG8_STAGE(bufoff, gbase, voff) do { _Pragma("unroll") for (int _i = 0; _i < 2; ++_i) \
        __builtin_amdgcn_global_load_lds((const unsigned*)((const char*)(gbase) + (voff)[_i]), (PG8_LAS unsigned*)(lds + (bufoff) + ldsw + _i * 8192), 16, 0, 0); } while (0)
#define PG8_LDA(dst, b, h) do { _Pragma("unroll") for (int m = 0; m < 4; ++m) { if constexpr (ELT == 2 || PG8_BF16T) { _Pragma("unroll") for (int k = 0; k < 2; ++k) dst[m][k] = *(const PG8_LAS bf16x8*)(lds + PG8_SA(b, h) + aoff + m * 2048 + k * 1024); } \
        else { const v4i_t lo_ = *(const PG8_LAS v4i_t*)(lds + PG8_SA(b, h) + aoff + m * 2048), hi_ = *(const PG8_LAS v4i_t*)(lds + PG8_SA(b, h) + aoff + m * 2048 + 1024); dst##8[m] = __builtin_shufflevector(lo_, hi_, 0, 1, 2, 3, 4, 5, 6, 7); } } } while (0)
#define PG8_LDB(dst, b, h) do { _Pragma("unroll") for (int n = 0; n < 2; ++n) { if constexpr (ELT == 2 || PG8_BF16T) { _Pragma("unroll") for (int k = 0; k < 2; ++k) dst[n][k] = *(const PG8_LAS bf16x8*)(lds + PG8_SB(b, h) + boff + n * 2048 + k * 1024); } \
        else { const v4i_t lo_ = *(const PG8_LAS v4i_t*)(lds + PG8_SB(b, h) + boff + n * 2048), hi_ = *(const PG8_LAS v4i_t*)(lds + PG8_SB(b, h) + boff + n * 2048 + 1024); dst##8[n] = __builtin_shufflevector(lo_, hi_, 0, 1, 2, 3, 4, 5, 6, 7); } } } while (0)
#define PG8_MMA(ai, bj, At, Bt) do { __builtin_amdgcn_s_setprio(1); \
        if constexpr (ELT == 2 || PG8_BF16T) { _Pragma("unroll") for (int m = 0; m < 4; ++m) _Pragma("unroll") for (int n = 0; n < 2; ++n) _Pragma("unroll") for (int k = 0; k < 2; ++k) \
            acc[ai][bj][m][n] = __builtin_amdgcn_mfma_f32_16x16x32_bf16(Bt[n][k], At[m][k], acc[ai][bj][m][n], 0, 0, 0); } \
        else { _Pragma("unroll") for (int m = 0; m < 4; ++m) _Pragma("unroll") for (int n = 0; n < 2; ++n) \
            asm volatile("v_mfma_scale_f32_16x16x128_f8f6f4 %0, %1, %2, %0, %3, %4 op_sel_hi:[0,0,0]" : "+v"(acc[ai][bj][m][n]) : "v"(Bt##8[n]), "v"(At##8[m]), "v"(mxscale), "v"(mxscale_a)); }     \
        __builtin_amdgcn_s_setprio(0); } while (0)
#define PG8_WAIT_V(n) asm volatile("s_waitcnt vmcnt(" #n ")" ::: "memory")
#define PG8_WAIT_L(n) asm volatile("s_waitcnt lgkmcnt(" #n ")" ::: "memory")
#define PG8_BAR __builtin_amdgcn_s_barrier()
#define PG8_SCHED __builtin_amdgcn_sched_barrier(0)
    Unit cur, nxt; int ui = 0;
    if (!S.next(0, cur)) return;
    f32x4 acc[2][2][4][2];
#pragma unroll
    for (int a = 0; a < 2; ++a)
#pragma unroll
        for (int b = 0; b < 2; ++b)
#pragma unroll
            for (int m = 0; m < 4; ++m)
#pragma unroll
                for (int n = 0; n < 2; ++n) acc[a][b][m][n] = (f32x4){0.f, 0.f, 0.f, 0.f};
    bf16x8 At[4][2], B0[2][2], B1[2][2];
    v8i_t At8[4], B08[2], B18[2];
    int mxscale = 0x7c7c7c7c; asm volatile("" : "+v"(mxscale));
    int mxscale_a = ASCALE; asm volatile("" : "+v"(mxscale_a));
    const char* cA = (const char*)g.A + (Sched::GATHER ? (size_t)0 : (size_t)cur.pm * tstep); const char* cB = (const char*)g.Bt + (size_t)cur.pn * tstep;
    S.a_ready(cur);
    if constexpr (Epi::MIDK) E.unit_begin(lds, cur, 0, wid, lane);
    PG8_AOFFS(vAc, cur);
#pragma unroll
    for (int h_ = 0; h_ < 2; ++h_)
#pragma unroll
        for (int i_ = 0; i_ < 2; ++i_) vAn[h_][i_] = vAc[h_][i_];
    if constexpr (SP2) {
        PG8_STAGE(PG8_SB(0, 0), cB, voffB); PG8_STAGE(PG8_SB(0, 1), cB + hstep, voffB); PG8_STAGE(PG8_SA(0, 0), cA, vAc[0]); PG8_STAGE(PG8_SA(0, 1), cA, vAc[1]);
        if (wr == 1) PG8_BAR;
        PG8_WAIT_V(2); PG8_BAR;
        PG8_STAGE(PG8_SB(1, 0), cB + kstep, voffB); PG8_STAGE(PG8_SA(1, 0), cA + kstep, vAc[0]); PG8_STAGE(PG8_SB(1, 1), cB + hstep + kstep, voffB);
        PG8_WAIT_V(6); PG8_BAR;
    } else {
        PG8_STAGE(PG8_SB(0, 0), cB, voffB); PG8_STAGE(PG8_SA(0, 0), cA, vAc[0]); PG8_STAGE(PG8_SB(0, 1), cB + hstep, voffB); PG8_STAGE(PG8_SA(0, 1), cA, vAc[1]);
        if (wr == 1) PG8_BAR;
        PG8_WAIT_V(4); PG8_BAR;
        PG8_STAGE(PG8_SB(1, 0), cB + kstep, voffB); PG8_STAGE(PG8_SA(1, 0), cA + kstep, vAc[0]); PG8_STAGE(PG8_SB(1, 1), cB + hstep + kstep, voffB);
        PG8_WAIT_V(6); PG8_BAR;
    }
    for (;;) {
        const bool has_next = S.next(ui + 1, nxt);
        const char* nA = (has_next && !Sched::GATHER) ? (const char*)g.A + (size_t)nxt.pm * tstep : cA; const char* nB = has_next ? (const char*)g.Bt + (size_t)nxt.pn * tstep : cB;
        if constexpr (TSPLIT > 0) { constexpr bool PG8_BF16T = true;
#pragma unroll 1
        for (int t = 0; t < TSPLIT; t += 2) {
            const bool last = (t == nt - 2);
            if constexpr (TSPLIT > 0) asm volatile("" : "+v"(voffB[0]), "+v"(voffB[1]), "+v"(vAc[0][0]), "+v"(vAc[0][1]), "+v"(vAc[1][0]), "+v"(vAc[1][1]));
            const char* a1 = cA + (size_t)(t + 1) * kstep;
            const char* a2 = last ? nA : cA + (size_t)(t + 2) * kstep; const char* b2 = last ? nB : cB + (size_t)(t + 2) * kstep;
            const char* a3 = a2 + kstep; const char* b3 = b2 + kstep;
            if (last && has_next) { S.a_ready(nxt); if constexpr (Sched::GATHER) PG8_AOFFS(vAn, nxt); if constexpr (Epi::MIDK) E.unit_begin(lds, nxt, (ui + 1) & 1, wid, lane); }
            if constexpr (Epi::MIDK) { if (t == (Epi::MIDK_T ? Epi::MIDK_T : (nt >> 1))) E.midk(acc, cur, wr, fr, lds, ui & 1); }
            if constexpr (SP2) {
            PG8_LDB(B0, 0, 0); PG8_LDB(B1, 0, 1); PG8_SCHED; PG8_LDA(At, 0, 0); PG8_STAGE(PG8_SA(1, 1), a1, vAc[1]);
            if constexpr (Sched::GATHER) { if (last) { _Pragma("unroll") for (int h_ = 0; h_ < 2; ++h_) _Pragma("unroll") for (int i_ = 0; i_ < 2; ++i_) vAc[h_][i_] = vAn[h_][i_]; } }
            PG8_WAIT_V(8); PG8_WAIT_L(0); PG8_BAR; PG8_MMA(0, 0, At, B0); PG8_MMA(0, 1, At, B1); PG8_BAR; PG8_SCHED;
            PG8_LDA(At, 0, 1); PG8_STAGE(PG8_SB(0, 0), b2, voffB); PG8_STAGE(PG8_SB(0, 1), b2 + hstep, voffB); PG8_STAGE(PG8_SA(0, 0), a2, vAc[0]);
            PG8_WAIT_V(8); PG8_WAIT_L(0); PG8_BAR; PG8_MMA(1, 0, At, B0); PG8_MMA(1, 1, At, B1); PG8_BAR; PG8_SCHED;
            PG8_LDB(B0, 1, 0); PG8_LDB(B1, 1, 1); PG8_SCHED; PG8_LDA(At, 1, 0); PG8_STAGE(PG8_SA(0, 1), a2, vAc[1]);
            PG8_WAIT_V(8); PG8_WAIT_L(0); PG8_BAR; PG8_MMA(0, 0, At, B0); PG8_MMA(0, 1, At, B1); PG8_BAR; PG8_SCHED;
            PG8_LDA(At, 1, 1); PG8_STAGE(PG8_SB(1, 0), b3, voffB); PG8_STAGE(PG8_SB(1, 1), b3 + hstep, voffB); PG8_STAGE(PG8_SA(1, 0), a3, vAc[0]);
            PG8_WAIT_V(8); PG8_WAIT_L(0); PG8_BAR; PG8_MMA(1, 0, At, B0); PG8_MMA(1, 1, At, B1); PG8_BAR; PG8_SCHED;
            } else {
            PG8_LDB(B0, 0, 0); PG8_SCHED; PG8_LDA(At, 0, 0); PG8_STAGE(PG8_SA(1, 1), a1, vAc[1]);
            PG8_WAIT_L(8); PG8_BAR; PG8_WAIT_L(0); PG8_MMA(0, 0, At, B0); PG8_BAR; PG8_SCHED;
            PG8_LDB(B1, 0, 1); PG8_STAGE(PG8_SB(0, 0), b2, voffB);
            PG8_BAR; PG8_WAIT_L(0); PG8_MMA(0, 1, At, B1); PG8_BAR;
            PG8_LDA(At, 0, 1); PG8_STAGE(PG8_SA(0, 0), a2, vAc[0]);
            PG8_BAR; PG8_WAIT_L(0); PG8_MMA(1, 0, At, B0); PG8_BAR; PG8_SCHED;
            PG8_STAGE(PG8_SB(0, 1), b2 + hstep, voffB);
            PG8_WAIT_V(6); PG8_BAR; PG8_MMA(1, 1, At, B1); PG8_BAR;
            PG8_LDB(B0, 1, 0); PG8_SCHED; PG8_LDA(At, 1, 0); PG8_STAGE(PG8_SA(0, 1), a2, vAc[1]);
            PG8_WAIT_L(8); PG8_BAR; PG8_WAIT_L(0); PG8_MMA(0, 0, At, B0); PG8_BAR; PG8_SCHED;
            PG8_LDB(B1, 1, 1); PG8_STAGE(PG8_SB(1, 0), b3, voffB);
            PG8_BAR; PG8_WAIT_L(0); PG8_MMA(0, 1, At, B1); PG8_BAR;
            PG8_LDA(At, 1, 1); PG8_STAGE(PG8_SA(1, 0), a3, vAc[0]);
            PG8_BAR; PG8_WAIT_L(0); PG8_MMA(1, 0, At, B0); PG8_BAR; PG8_SCHED;
            PG8_STAGE(PG8_SB(1, 1), b3 + hstep, voffB);
            PG8_WAIT_V(6); PG8_BAR; PG8_MMA(1, 1, At, B1); PG8_BAR;
            }
        }
        }
        { constexpr bool PG8_BF16T = false;
#pragma unroll 1
        for (int t = TSPLIT; t < nt; t += 2) {
            const bool last = (t == nt - 2);
            if constexpr (TSPLIT > 0) asm volatile("" : "+v"(voffB[0]), "+v"(voffB[1]), "+v"(vAc[0][0]), "+v"(vAc[0][1]), "+v"(vAc[1][0]), "+v"(vAc[1][1]));
            const char* a1 = cA + (size_t)(t + 1) * kstep;
            const char* a2 = last ? nA : cA + (size_t)(t + 2) * kstep; const char* b2 = last ? nB : cB + (size_t)(t + 2) * kstep;
            const char* a3 = a2 + kstep; const char* b3 = b2 + kstep;
            if (last && has_next) { S.a_ready(nxt); if constexpr (Sched::GATHER) PG8_AOFFS(vAn, nxt); if constexpr (Epi::MIDK) E.unit_begin(lds, nxt, (ui + 1) & 1, wid, lane); }
            if constexpr (Epi::MIDK) { if (t == (Epi::MIDK_T ? Epi::MIDK_T : (nt >> 1))) E.midk(acc, cur, wr, fr, lds, ui & 1); }
            if constexpr (SP2) {
            PG8_LDB(B0, 0, 0); PG8_LDB(B1, 0, 1); PG8_SCHED; PG8_LDA(At, 0, 0); PG8_STAGE(PG8_SA(1, 1), a1, vAc[1]);
            if constexpr (Sched::GATHER) { if (last) { _Pragma("unroll") for (int h_ = 0; h_ < 2; ++h_) _Pragma("unroll") for (int i_ = 0; i_ < 2; ++i_) vAc[h_][i_] = vAn[h_][i_]; } }
            PG8_WAIT_V(8); PG8_WAIT_L(0); PG8_BAR; PG8_MMA(0, 0, At, B0); PG8_MMA(0, 1, At, B1); PG8_BAR; PG8_SCHED;
            PG8_LDA(At, 0, 1); PG8_STAGE(PG8_SB(0, 0), b2, voffB); PG8_STAGE(PG8_SB(0, 1), b2 + hstep, voffB); PG8_STAGE(PG8_SA(0, 0), a2, vAc[0]);
            PG8_WAIT_V(8); PG8_WAIT_L(0); PG8_BAR; PG8_MMA(1, 0, At, B0); PG8_MMA(1, 1, At, B1); PG8_BAR; PG8_SCHED;
            PG8_LDB(B0, 1, 0); PG8_LDB(B1, 1, 1); PG8_SCHED; PG8_LDA(At, 1, 0); PG8_STAGE(PG8_SA(0, 1), a2, vAc[1]);
            PG8_WAIT_V(8); PG8_WAIT_L(0); PG8_BAR; PG8_MMA(0, 0, At, B0); PG8_MMA(0, 1, At, B1); PG8_BAR; PG8_SCHED;
            PG8_LDA(At, 1, 1); PG8_STAGE(PG8_SB(1, 0), b3, voffB); PG8_STAGE(PG8_SB(1, 1), b3 + hstep, voffB); PG8_STAGE(PG8_SA(1, 0), a3, vAc[0]);
            PG8_WAIT_V(8); PG8_WAIT_L(0); PG8_BAR; PG8_MMA(1, 0, At, B0); PG8_MMA(1, 1, At, B1); PG8_BAR; PG8_SCHED;
            } else {
            PG8_LDB(B0, 0, 0); PG8_SCHED; PG8_LDA(At, 0, 0); PG8_STAGE(PG8_SA(1, 1), a1, vAc[1]);
            PG8_WAIT_L(8); PG8_BAR; PG8_WAIT_L(0); PG8_MMA(0, 0, At, B0); PG8_BAR; PG8_SCHED;
            PG8_LDB(B1, 0, 1); PG8_STAGE(PG8_SB(0, 0), b2, voffB);
            PG8_BAR; PG8_WAIT_L(0); PG8_MMA(0, 1, At, B1); PG8_BAR;
            PG8_LDA(At, 0, 1); PG8_STAGE(PG8_SA(0, 0), a2, vAc[0]);
            PG8_BAR; PG8_WAIT_L(0); PG8_MMA(1, 0, At, B0); PG8_BAR; PG8_SCHED;
            PG8_STAGE(PG8_SB(0, 1), b2 + hstep, voffB);
            PG8_WAIT_V(6); PG8_BAR; PG8_MMA(1, 1, At, B1); PG8_BAR;
            PG8_LDB(B0, 1, 0); PG8_SCHED; PG8_LDA(At, 1, 0); PG8_STAGE(PG8_SA(0, 1), a2, vAc[1]);
            PG8_WAIT_L(8); PG8_BAR; PG8_WAIT_L(0); PG8_MMA(0, 0, At, B0); PG8_BAR; PG8_SCHED;
            PG8_LDB(B1, 1, 1); PG8_STAGE(PG8_SB(1, 0), b3, voffB);
            PG8_BAR; PG8_WAIT_L(0); PG8_MMA(0, 1, At, B1); PG8_BAR;
            PG8_LDA(At, 1, 1); PG8_STAGE(PG8_SA(1, 0), a3, vAc[0]);
            PG8_BAR; PG8_WAIT_L(0); PG8_MMA(1, 0, At, B0); PG8_BAR; PG8_SCHED;
            PG8_STAGE(PG8_SB(1, 1), b3 + hstep, voffB);
            PG8_WAIT_V(6); PG8_BAR; PG8_MMA(1, 1, At, B1); PG8_BAR;
            }
        }
        }
        if constexpr (ALIGN_EPI) { if (wr == 0) PG8_BAR; }
        if constexpr (ELT == 1) asm volatile("s_nop 15\n\ts_nop 15" ::: "memory");
        if constexpr (Epi::MIDK) { E.epi(acc, cur, wr, wc, fr, fq, lds, ui & 1); S.done(cur); }
        else if constexpr (Epi::PM == 2) { E.epi_staged(acc, cur, wr, wc, fr, fq, lds, wid, lane); S.done(cur); }
        else if constexpr (!Epi::AFTER_DRAIN) { E(acc, cur, wr, wc, fr, fq); S.done(cur); }
        if (!has_next) break;
#pragma unroll
        for (int a = 0; a < 2; ++a)
#pragma unroll
            for (int b = 0; b < 2; ++b)
#pragma unroll
                for (int m = 0; m < 4; ++m)
#pragma unroll
                    for (int n = 0; n < 2; ++n) acc[a][b][m][n] = (f32x4){0.f, 0.f, 0.f, 0.f};
        cur = nxt; cA = nA; cB = nB; ++ui;
        if constexpr (ALIGN_EPI) { if (wr == 1) PG8_BAR; }
    }
    PG8_WAIT_V(0);
    if constexpr (!ALIGN_EPI) { if (wr == 0) PG8_BAR; }
    PG8_BAR;
    if constexpr (Epi::AFTER_DRAIN) { E.fused(acc, cur, wr, wc, fr, fq, lds, wid, lane); S.done(cur); }
#undef PG8_AOFFS
#undef PG8_SA
#undef PG8_SB
#undef PG8_STAGE
#undef PG8_LDA
#undef PG8_LDB
#undef PG8_MMA
#undef PG8_WAIT_V
#undef PG8_WAIT_L
#undef PG8_BAR
#undef PG8_SCHED
}
}

constexpr int NWAVES = 8;
#ifndef MK_N_LAUNCHES
#define MK_N_LAUNCHES 1
#endif
constexpr int N_PHASES = 9;
constexpr int N_LAUNCHES = MK_N_LAUNCHES;
static_assert(N_LAUNCHES == 1 || N_LAUNCHES == N_PHASES, "MK_N_LAUNCHES is 1 or 9");

constexpr int BATCH = 2, SEQ = 4096, DM = 4096, M = BATCH * SEQ;
constexpr int NIN = 8704;
constexpr int QA0 = 0, KA0 = 2048, VA0 = 2304, QB0 = 2560, KB0 = 4608, VB0 = 6656;
constexpr int NEXP = 32, DEXP = 512, PLE = 256, NRT = 48;
constexpr float LN_EPS = 1e-5f, RMS_EPS = 1e-6f;
constexpr float SB_STOP = 32.0f;

constexpr size_t MiB = 1u << 20;
constexpr size_t WS_CTL = 0, CTL_ZERO_BYTES = 64 * 1024;
constexpr size_t WS_CS = 1 * MiB;
constexpr size_t WS_WRT = 3 * MiB;
constexpr size_t WS_RR = 3 * MiB + 512 * 1024;
constexpr size_t WS_WTS = 3 * MiB + 640 * 1024;
constexpr size_t WS_STATS = 3 * MiB + 768 * 1024;
constexpr size_t WS_LIST = 4 * MiB;
constexpr size_t WS_WINT = 8 * MiB;
constexpr size_t WS_WOUTT = 76 * MiB;
constexpr size_t WS_WGT = 108 * MiB;
constexpr size_t WS_WPT = 140 * MiB;
constexpr size_t WS_PB = 142 * MiB;
constexpr size_t WS_WGUT = 146 * MiB;
constexpr size_t WS_WDT = 402 * MiB;
constexpr size_t WS_XB = 530 * MiB;
constexpr size_t WS_QKV = 594 * MiB;
constexpr size_t WS_XG = 530 * MiB;
constexpr size_t WS_Y1B = 594 * MiB;
constexpr size_t WS_Y2B = 658 * MiB;
constexpr size_t WS_O = 730 * MiB;
constexpr size_t WS_H = 730 * MiB;
constexpr size_t WS_X1B = 794 * MiB;
constexpr size_t WS_PP = 858 * MiB;
constexpr size_t WS_MOE = 922 * MiB;
constexpr size_t WS_END = 1050 * MiB;
constexpr int MPAD_MAX = 24576;
constexpr int CW_TMO = 0, CW_CODE = 1;
constexpr int CW_BAR = 4096;
constexpr int CW_CNT = 8192;
constexpr int CW_DONE = 12352;
constexpr int CW_Q = 12288;
static_assert((CW_CNT + 64 * NEXP) * 4 <= (int)CTL_ZERO_BYTES, "CTL words inside the memset region");
constexpr int CW_READY = 16384 + 64;

constexpr int RING_OFF = 0, RING_BYTES = 131072;
constexpr int LDS_BYTES = 163840;
constexpr int MISC_OFF = LDS_BYTES - 1024;
constexpr int TAB_OFF = MISC_OFF + 256;
constexpr int ATT_VIMG = 16384, ATT_RED = 131072, ATT_G = 133120;
constexpr int LN_ROWB = 8208, LN_RED = 131328, LN_LOG = 155904;
static_assert(LN_LOG + 3072 + 192 <= MISC_OFF && ATT_RED + 2048 <= ATT_G && ATT_G + 16384 <= MISC_OFF, "LDS map");

#define GAS __attribute__((address_space(1)))
#define LAS __attribute__((address_space(3)))
typedef unsigned short bf16;
typedef unsigned v4u __attribute__((ext_vector_type(4)));
typedef unsigned v2u __attribute__((ext_vector_type(2)));
typedef float f32x4 __attribute__((ext_vector_type(4)));
typedef float f32x2 __attribute__((ext_vector_type(2)));
typedef float f32x16 __attribute__((ext_vector_type(16)));
typedef short bf16x8 __attribute__((ext_vector_type(8)));
typedef short s16x4 __attribute__((ext_vector_type(4)));
typedef GAS unsigned gu32;
#define RLX_AGENT __ATOMIC_RELAXED, __HIP_MEMORY_SCOPE_AGENT
#define LDS_WAIT() asm volatile("s_waitcnt lgkmcnt(0)" ::: "memory")
#define VM_WAIT() asm volatile("s_waitcnt vmcnt(0)" ::: "memory")
#define MFMA32(a, b, c) __builtin_amdgcn_mfma_f32_32x32x16_bf16((a), (b), (c), 0, 0, 0)
#define MFMA16(a, b, c) __builtin_amdgcn_mfma_f32_16x16x32_bf16((a), (b), (c), 0, 0, 0)
using pg8::cvt_pk_bf16;
using pg8::LOG2E;
using pg8::OKS;
__device__ __forceinline__ float bf2f(unsigned short b) { return __uint_as_float(((unsigned)b) << 16); }

#define XB_TMO      128
#define XB_XCNT(j)  (256  + 64 * (j))
#define XB_XSUB(j)  (1280 + 64 * (j))
#define XB_XGEN(j)  (2304 + 64 * (j))
#define XB_TOP      3328
#define XB_TOPGEN   3392
#define XCD_BAR_WORDS 3456
#define XB_SPIN_CAP (1u << 18)

__device__ __forceinline__ unsigned xb_ld(unsigned* p)              { return __hip_atomic_load(p, __ATOMIC_RELAXED, __HIP_MEMORY_SCOPE_AGENT); }
__device__ __forceinline__ unsigned xb_add(unsigned* p, unsigned v) { return __hip_atomic_fetch_add(p, v, __ATOMIC_RELAXED, __HIP_MEMORY_SCOPE_AGENT); }
__device__ __forceinline__ unsigned xb_xcc_id() { return (unsigned)__builtin_amdgcn_s_getreg((3 << 11) | 20) & 0xFu; }
#define XB_SPIN(cond, bar) do { unsigned _sp = 0; while (cond) { __builtin_amdgcn_s_sleep(1); \
    if ((++_sp & 255u) == 0u) { if (xb_ld(&(bar)[XB_TMO])) break; if (_sp > XB_SPIN_CAP) { atomicAdd(&(bar)[XB_TMO], 1u); break; } } } } while (0)

struct XcdBarrier {
    unsigned* bar; unsigned x;
    volatile LAS unsigned* st;
};

__device__ __forceinline__ XcdBarrier xcd_barrier_post(unsigned* bar, volatile LAS unsigned* st, bool lead) {
    XcdBarrier b; b.bar = bar; b.x = xb_xcc_id(); b.st = st;
    if (lead) (void)xb_add(&bar[XB_XCNT(b.x)], 1u);
    return b;
}
__device__ __forceinline__ void xcd_barrier_complete(unsigned* bar, unsigned x, unsigned& nloc, unsigned& nx) {
    const unsigned G = gridDim.x * gridDim.y * gridDim.z;
    unsigned sum, cnt, mine, sp = 0u;
    for (;;) {
        sum = 0u; cnt = 0u; mine = 0u;
#pragma unroll
        for (unsigned j = 0; j < 16; ++j) { const unsigned c = xb_ld(&bar[XB_XCNT(j)]); sum += c; cnt += (c > 0u) ? 1u : 0u; mine = (j == x) ? c : mine; }
        if (sum == G) break;
        __builtin_amdgcn_s_sleep(1);
        if ((++sp & 255u) == 0u) { if (xb_ld(&bar[XB_TMO])) break; if (sp > XB_SPIN_CAP) { atomicAdd(&bar[XB_TMO], 1u); break; } }
    }
    nloc = mine > 0u ? mine : 1u; nx = cnt > 0u ? cnt : 1u;
}

__device__ __forceinline__ void xcd_barrier(const XcdBarrier& b, bool lead) {
    asm volatile("s_waitcnt vmcnt(0)" ::: "memory");
    __syncthreads();
    if (lead) {
        unsigned* bar = b.bar;
        __builtin_amdgcn_s_waitcnt(0);
        unsigned nloc = b.st[0], nx = b.st[1];
        if (nloc == 0u) { xcd_barrier_complete(bar, b.x, nloc, nx); b.st[0] = nloc; b.st[1] = nx; }
        const unsigned old = xb_add(&bar[XB_XSUB(b.x)], 1u);
        const unsigned gen = old / nloc;
        if (old + 1u == (gen + 1u) * nloc) {
            __builtin_amdgcn_fence(__ATOMIC_RELEASE, "agent");
            asm volatile("s_waitcnt vmcnt(0)" ::: "memory");
            const unsigned og = xb_add(&bar[XB_TOP], 1u);
            const unsigned tg = og / nx;
            if (og + 1u == (tg + 1u) * nx) xb_add(&bar[XB_TOPGEN], 1u);
            else XB_SPIN(xb_ld(&bar[XB_TOPGEN]) == tg, bar);
            __builtin_amdgcn_fence(__ATOMIC_ACQUIRE, "agent");
            xb_add(&bar[XB_XGEN(b.x)], 1u);
            asm volatile("s_waitcnt vmcnt(0)" ::: "memory");
        } else {
            XB_SPIN(xb_ld(&bar[XB_XGEN(b.x)]) == gen, bar);
            __builtin_amdgcn_fence(__ATOMIC_ACQUIRE, "agent");
            asm volatile("s_waitcnt vmcnt(0)" ::: "memory");
        }
    }
    __syncthreads();
}

struct Frame {
    LAS unsigned char* lds;
    volatile LAS unsigned* MISC;
    gu32* ctl;
    int tid, lane, wave, wave0;
    int vcu, G;
    const float *x, *p; const int* positions;
    const float *w_in, *b_in, *sinks, *g_a, *g_b, *w_out, *b_out, *ln1_g, *ln1_b, *w_group, *b_group, *w_er, *b_er, *w_gate, *w_up, *w_down, *w_pg, *b_pg, *w_pp, *ln2_g, *ln2_b;
    float* out;
    float *cs, *rr, *wts, *stats; int* list;
    bf16 *WrT, *WinT, *WoutT, *WpT, *PB, *XB, *QKV, *XG, *O, *PP, *MOE, *Y1B, *Y2B;
    unsigned char *Wg8, *Wgu8, *Wd8, *X18, *H8;
};

__device__ __forceinline__ float wave_sum(float v) {
#pragma unroll
    for (int o = 1; o < 64; o <<= 1) v += __shfl_xor(v, o);
    return v;
}
__device__ __forceinline__ f32x2 pair32(float v) { auto r = __builtin_amdgcn_permlane32_swap(__float_as_uint(v), __float_as_uint(v), false, false); return (f32x2){__uint_as_float(r[0]), __uint_as_float(r[1])}; }


__device__ __forceinline__ int hw_lane() { int l; asm volatile("v_mbcnt_lo_u32_b32 %0, -1, 0\n\tv_mbcnt_hi_u32_b32 %0, -1, %0" : "=v"(l)); return l; }
struct Args { const void* in[24]; float* out; unsigned char* ws; int ph_lo, ph_hi; };
typedef __attribute__((address_space(4))) const Args CArgs;
__device__ __forceinline__ void fill_ptrs(Frame& F) {
    CArgs* ap = (CArgs*)__builtin_amdgcn_kernarg_segment_ptr();
    asm volatile("" : "+s"(ap));
    { int t = F.wave0 * 64 + hw_lane(); asm volatile("" : "+v"(t)); F.tid = t; F.lane = t & 63; F.wave = __builtin_amdgcn_readfirstlane(t >> 6); }
    unsigned char* ws = ap->ws;
    F.x = (const float*)ap->in[0]; F.p = (const float*)ap->in[1]; F.positions = (const int*)ap->in[2];
    F.w_in = (const float*)ap->in[3]; F.b_in = (const float*)ap->in[4]; F.sinks = (const float*)ap->in[5]; F.g_a = (const float*)ap->in[6]; F.g_b = (const float*)ap->in[7];
    F.w_out = (const float*)ap->in[8]; F.b_out = (const float*)ap->in[9]; F.ln1_g = (const float*)ap->in[10]; F.ln1_b = (const float*)ap->in[11];
    F.w_group = (const float*)ap->in[12]; F.b_group = (const float*)ap->in[13]; F.w_er = (const float*)ap->in[14]; F.b_er = (const float*)ap->in[15];
    F.w_gate = (const float*)ap->in[16]; F.w_up = (const float*)ap->in[17]; F.w_down = (const float*)ap->in[18];
    F.w_pg = (const float*)ap->in[19]; F.b_pg = (const float*)ap->in[20]; F.w_pp = (const float*)ap->in[21]; F.ln2_g = (const float*)ap->in[22]; F.ln2_b = (const float*)ap->in[23];
    F.out = ap->out;
    F.ctl = (gu32*)(ws + WS_CTL);
    F.cs = (float*)(ws + WS_CS); F.rr = (float*)(ws + WS_RR); F.wts = (float*)(ws + WS_WTS); F.stats = (float*)(ws + WS_STATS); F.list = (int*)(ws + WS_LIST);
    F.WrT = (bf16*)(ws + WS_WRT); F.WinT = (bf16*)(ws + WS_WINT); F.WoutT = (bf16*)(ws + WS_WOUTT); F.Wg8 = ws + WS_WGT; F.WpT = (bf16*)(ws + WS_WPT); F.PB = (bf16*)(ws + WS_PB);
    F.Wgu8 = ws + WS_WGUT; F.Wd8 = ws + WS_WDT; F.XB = (bf16*)(ws + WS_XB); F.QKV = (bf16*)(ws + WS_QKV); F.XG = (bf16*)(ws + WS_XG);
    F.O = (bf16*)(ws + WS_O); F.H8 = ws + WS_H; F.X18 = ws + WS_X1B; F.PP = (bf16*)(ws + WS_PP); F.MOE = (bf16*)(ws + WS_MOE); F.Y1B = (bf16*)(ws + WS_Y1B); F.Y2B = (bf16*)(ws + WS_Y2B);
}

struct CvItem { const float* src; bf16* dst; int N, K, f8; };
__device__ __forceinline__ void cv_load(const CvItem& d, f32x4 (&v)[16], int lane) {
    if (d.f8) {
#pragma unroll
        for (int ii = 0; ii < 4; ++ii)
#pragma unroll
            for (int jj = 0; jj < 4; ++jj) v[4 * ii + jj] = *(const GAS f32x4*)(d.src + (size_t)(4 * ((lane >> 3) + 8 * ii) + jj) * d.N + 4 * (lane & 7));
        return; }
#pragma unroll
    for (int i = 0; i < 8; ++i) { const float* p = d.src + (size_t)(2 * ((lane >> 4) + 4 * i)) * d.N + 4 * (lane & 15);
        v[2 * i] = *(const GAS f32x4*)p; v[2 * i + 1] = *(const GAS f32x4*)(p + d.N); }
}
__device__ __forceinline__ void cv_finish(const CvItem& d, const f32x4 (&v)[16], LAS float* scrf, int lane) {
    LAS unsigned* scr = (LAS unsigned*)scrf;
    if (d.f8) {
#pragma unroll
        for (int ii = 0; ii < 4; ++ii) { LAS unsigned* p = scr + ((lane >> 3) + 8 * ii) * 33 + 4 * (lane & 7);
#pragma unroll
            for (int cc = 0; cc < 4; ++cc) p[cc] = pg8::cvt_pk_fp8x4(v[4 * ii][cc] * 64.0f, v[4 * ii + 1][cc] * 64.0f, v[4 * ii + 2][cc] * 64.0f, v[4 * ii + 3][cc] * 64.0f); }
        LDS_WAIT(); asm volatile("" ::: "memory");
        const int ch = lane & 7;
#pragma unroll
        for (int j = 0; j < 4; ++j) { const int n = (lane >> 3) + 8 * j; const LAS unsigned* sp = scr + (4 * ch) * 33 + n;
            v4u o; o.x = sp[0 * 33]; o.y = sp[1 * 33]; o.z = sp[2 * 33]; o.w = sp[3 * 33];
            *(GAS v4u*)((unsigned char*)d.dst + (size_t)n * d.K + 16 * ch) = o; }
        LDS_WAIT(); asm volatile("" ::: "memory");
        return; }
#pragma unroll
    for (int i = 0; i < 8; ++i) { LAS unsigned* p = scr + ((lane >> 4) + 4 * i) * 65 + 4 * (lane & 15);
#pragma unroll
        for (int j = 0; j < 4; ++j) p[j] = cvt_pk_bf16(v[2 * i][j], v[2 * i + 1][j]); }
    LDS_WAIT(); asm volatile("" ::: "memory");
    const int c = lane & 7;
#pragma unroll
    for (int j = 0; j < 8; ++j) { const int n = (lane >> 3) + 8 * j; const LAS unsigned* s = scr + (4 * c) * 65 + n;
        v4u o; o.x = s[0 * 65]; o.y = s[1 * 65]; o.z = s[2 * 65]; o.w = s[3 * 65];
        *(GAS v4u*)(d.dst + (size_t)n * d.K + 8 * c) = o; }
    LDS_WAIT(); asm volatile("" ::: "memory");
}
__device__ const double ROPE_INV_FREQ[32] = {1.0, 0.7498942093324559, 0.5623413251903491, 0.4216965034285822, 0.31622776601683794, 0.23713737056616552, 0.1778279410038923, 0.1333521432163324,
    0.1, 0.07498942093324558, 0.05623413251903491, 0.042169650342858224, 0.03162277660168379, 0.023713737056616554, 0.01778279410038923, 0.01333521432163324,
    0.01, 0.007498942093324558, 0.005623413251903491, 0.004216965034285823, 0.0031622776601683794, 0.0023713737056616554, 0.0017782794100389228, 0.001333521432163324,
    0.001, 0.0007498942093324559, 0.0005623413251903491, 0.00042169650342858224, 0.00031622776601683794, 0.00023713737056616554, 0.00017782794100389227, 0.0001333521432163324};

constexpr int I_IN = (DM / 64) * (NIN / 64), I_SQ = (DM / 64) * (DM / 64), I_PP = (PLE / 64) * (DM / 64);
constexpr int I_GU = (DM / 64) * (DEXP / 64), I_DN = (DEXP / 64) * (DM / 64);
constexpr int I_A = I_IN + I_PP, NITEMS = I_A + 2 * I_SQ + NEXP * (2 * I_GU + I_DN);
constexpr int QCHUNK = 16, NCHUNK = (NITEMS - I_A + QCHUNK - 1) / QCHUNK;
__device__ __forceinline__ CvItem cv_decode(const Frame& F, int it) {
    int r = it; CvItem d;
#define CV_SET(W, Kk, Nn, WT, nb, drow) do { const int kb_ = r / (nb), n0_ = 64 * (r % (nb)); d.src = (W) + (size_t)(64 * kb_) * (Nn) + n0_; d.dst = (WT) + (size_t)(drow) * (Kk) + 64 * kb_; d.N = (Nn); d.K = (Kk); d.f8 = 0; } while (0)
#define CV_SET8(W, Kk, Nn, WT8, nb, drow) do { const int kb_ = r / (nb), n0_ = 32 * (r % (nb)); d.src = (W) + (size_t)(128 * kb_) * (Nn) + n0_; d.dst = (bf16*)((WT8) + (size_t)(drow) * (Kk) + 128 * kb_); d.N = (Nn); d.K = (Kk); d.f8 = 1; } while (0)
    if (r < I_IN) { CV_SET(F.w_in, DM, NIN, F.WinT, NIN / 64, (size_t)n0_); return d; } r -= I_IN;
    if (r < I_PP) { CV_SET(F.w_pp, PLE, DM, F.WpT, DM / 64, (size_t)n0_); return d; } r -= I_PP;
    if (r < OKS) { CV_SET(F.w_out, pg8::ORB / 2, DM, F.WoutT, DM / 64, (size_t)n0_); return d; }
    if (r < I_SQ) { r -= OKS; CV_SET8(F.w_out + (size_t)OKS * DM, pg8::ORB, DM, (unsigned char*)F.WoutT + 2 * OKS, DM / 32, (size_t)n0_); return d; }
    r -= I_SQ;
    if (r < I_SQ) { CV_SET8(F.w_pg, DM, DM, F.Wg8, DM / 32, (size_t)n0_); return d; } r -= I_SQ;
    const int e = r / (2 * I_GU + I_DN); r -= e * (2 * I_GU + I_DN);
    if (r < 2 * I_GU) { const int up = r >= I_GU; if (up) r -= I_GU;
        CV_SET8((up ? F.w_up : F.w_gate) + (size_t)e * DM * DEXP, DM, DEXP, F.Wgu8, DEXP / 32, (size_t)e * 1024 + (size_t)(n0_ >> 7) * 256 + (up ? 128 : 0) + (n0_ & 127)); return d; }
    r -= 2 * I_GU;
    CV_SET8(F.w_down + (size_t)e * DEXP * DM, DEXP, DM, F.Wd8, DM / 32, (size_t)e * DM + n0_); return d;
#undef CV_SET
#undef CV_SET8
}
__device__ __forceinline__ void cv_run(const Frame& F, int first, int stride, int end, LAS float* scr) {
    if (first >= end) return;
    CvItem cur = cv_decode(F, first); f32x4 va[16], vb[16];
    cv_load(cur, va, F.lane);
    for (int it = first; it < end; it += stride) {
        const bool more = it + stride < end; CvItem nxt = cur;
        if (more) { nxt = cv_decode(F, it + stride); cv_load(nxt, vb, F.lane); }
        cv_finish(cur, va, scr, F.lane);
        cur = nxt;
#pragma unroll
        for (int i = 0; i < 16; ++i) va[i] = vb[i];
    }
}
__device__ __forceinline__ void conv_queue(Frame& F) {
    LAS float* scr = (LAS float*)(F.lds + RING_OFF + F.wave * 16384);
    constexpr int IPW = QCHUNK / NWAVES;
    __syncthreads();
    if (F.tid == 0) F.MISC[16] = __hip_atomic_fetch_add(F.ctl + CW_Q, 1u, RLX_AGENT);
    __syncthreads();
    int ch = (int)F.MISC[16], slot = 0, k = 0;
    if (ch >= NCHUNK) return;
    if (F.tid == 0) F.MISC[17] = __hip_atomic_fetch_add(F.ctl + CW_Q, 1u, RLX_AGENT);
#define CV_NEXT(dst) do { if (k == IPW) { __syncthreads(); slot ^= 1; ch = (int)F.MISC[16 + slot]; k = 0; \
            if (F.tid == 0 && ch < NCHUNK) F.MISC[16 + (slot ^ 1)] = __hip_atomic_fetch_add(F.ctl + CW_Q, 1u, RLX_AGENT); } \
        dst = (ch < NCHUNK) ? I_A + ch * QCHUNK + F.wave * IPW + k : -1; ++k; } while (0)
    int it0; CV_NEXT(it0);
    CvItem cur = cv_decode(F, it0); f32x4 va[16], vb[16];
    cv_load(cur, va, F.lane);
    for (;;) {
        int it1; CV_NEXT(it1);
        CvItem nxt = cur;
        if (it1 >= 0) { nxt = cv_decode(F, it1); cv_load(nxt, vb, F.lane); }
        cv_finish(cur, va, scr, F.lane);
        if (it1 < 0) break;
        cur = nxt;
#pragma unroll
        for (int i = 0; i < 16; ++i) va[i] = vb[i];
    }
    __syncthreads();
#undef CV_NEXT
}
__device__ __forceinline__ void p0_prologue(Frame& F) {
    LAS float* scr = (LAS float*)(F.lds + RING_OFF + F.wave * 16384);
    const int gw = F.vcu * NWAVES + F.wave, NGW = F.G * NWAVES;
    cv_run(F, gw, NGW, I_A, scr);
    const int gt = gw * 64 + F.lane, NGT = NGW * 64;
    for (int idx = gt; idx < NRT * DM; idx += NGT) { const int c = idx / DM, k = idx - c * DM; float v = 0.f;
        if (c < 4) v = F.w_group[(size_t)k * 4 + c]; else if (c < 36) v = F.w_er[((size_t)((c - 4) >> 3) * DM + k) * 8 + ((c - 4) & 7)];
        F.WrT[idx] = (bf16)(cvt_pk_bf16(v, 0.f) & 0xffffu); }
    for (size_t i = gt; i < (size_t)M * DM / 8; i += NGT) { const f32x4 a = *(const f32x4*)(F.x + 8 * i), b = *(const f32x4*)(F.x + 8 * i + 4);
        v4u o; o.x = cvt_pk_bf16(a[0], a[1]); o.y = cvt_pk_bf16(a[2], a[3]); o.z = cvt_pk_bf16(b[0], b[1]); o.w = cvt_pk_bf16(b[2], b[3]); *(GAS v4u*)(F.XB + 8 * i) = o; }
    for (size_t i = gt; i < (size_t)M * PLE / 8; i += NGT) { const f32x4 a = *(const f32x4*)(F.p + 8 * i), b = *(const f32x4*)(F.p + 8 * i + 4);
        v4u o; o.x = cvt_pk_bf16(a[0], a[1]); o.y = cvt_pk_bf16(a[2], a[3]); o.z = cvt_pk_bf16(b[0], b[1]); o.w = cvt_pk_bf16(b[2], b[3]); *(GAS v4u*)(F.PB + 8 * i) = o; }
    for (int idx = gt; idx < M * 32; idx += NGT) { const int m = idx >> 5, pr = idx & 31;
        const float ang = (float)F.positions[m] * (float)ROPE_INV_FREQ[pr];
        const double rev = (double)ang * 0.15915494309189535; const float fr = (float)(rev - __builtin_floor(rev));
        F.cs[2 * (size_t)idx] = __builtin_amdgcn_cosf(fr); F.cs[2 * (size_t)idx + 1] = __builtin_amdgcn_sinf(fr); }
}

__device__ __forceinline__ int crow(int r, int hi) { return (r & 3) + 8 * (r >> 2) + 4 * hi; }
__device__ __forceinline__ s16x4 tr_read(const LAS unsigned char* p) {
    typedef short v4i16_t __attribute__((ext_vector_type(4)));
    return __builtin_bit_cast(s16x4, __builtin_amdgcn_ds_read_tr16_b64_v4i16((LAS v4i16_t*)p)); }
__device__ __forceinline__ bf16x8 pack8(const f32x16& x, int s) {
    v4u p; p.x = cvt_pk_bf16(x[8 * s], x[8 * s + 1]); p.y = cvt_pk_bf16(x[8 * s + 2], x[8 * s + 3]); p.z = cvt_pk_bf16(x[8 * s + 4], x[8 * s + 5]); p.w = cvt_pk_bf16(x[8 * s + 6], x[8 * s + 7]);
    return __builtin_bit_cast(bf16x8, p); }

#define GLDS16(gptr, ldsptr) __builtin_amdgcn_global_load_lds((const unsigned*)(gptr), (LAS unsigned*)(ldsptr), 16, 0, 0)
#define ATT_WAIT_V(n) asm volatile("s_waitcnt vmcnt(" #n ")" ::: "memory")
#define ATT_WAIT_L() asm volatile("s_waitcnt lgkmcnt(0)" ::: "memory")
template <int NDQ>
__device__ __forceinline__ void att_issue(const unsigned char* base, unsigned loff, LAS unsigned char* img) {
#pragma unroll
    for (int kh = 0; kh < 2; ++kh)
#pragma unroll
        for (int dq = 0; dq < NDQ; ++dq) GLDS16(base + (size_t)kh * (16 * NIN * 2) + dq * 64 + loff, img + (kh * NDQ + dq) * 1024);
}

#define SB_ISSUE(KF, b, key0) do { const bf16* kr_ = kbase + (size_t)(key0) * NIN; \
    _Pragma("unroll") for (int s = 0; s < 8; ++s) KF[s] = *(const bf16x8*)(kr_ + 16 * s); \
    att_issue<4>(vg + (size_t)(key0) * (NIN * 2), voff, vimg + (b) * 8192); } while (0)
#define SB_TILE(KF, b, k0, NEXT) do { \
        f32x16 z; \
        _Pragma("unroll") for (int i = 0; i < 16; ++i) z[i] = 0.f; \
        _Pragma("unroll") for (int s = 0; s < 8; ++s) z = MFMA32(KF[s], qf[s], z); \
        const int cdiag = ((k0) == s0) ? c : 64;                            \
        float L[16], G[4]; \
        _Pragma("unroll") for (int i = 0; i < 16; ++i) { const float z2 = z[i], e = __builtin_amdgcn_exp2f(-__builtin_fabsf(z2)); \
            float l = __builtin_fmaxf(z2, 0.f) + __builtin_amdgcn_logf(1.0f + e);         \
            if (crow(i, hh) >= cdiag) l = 0.f;                                                 \
            L[i] = l; } \
        _Pragma("unroll") for (int g = 0; g < 4; ++g) G[g] = (L[4 * g] + L[4 * g + 1]) + (L[4 * g + 2] + L[4 * g + 3]); \
        f32x2 GP[4]; \
        _Pragma("unroll") for (int g = 0; g < 4; ++g) GP[g] = pair32(G[g]);                                   \
        float after[4]; float tail = 0.f;                                                   \
        _Pragma("unroll") for (int g = 3; g >= 0; --g) { after[g] = tail + (hh ? 0.f : GP[g].y); tail += GP[g].x + GP[g].y; } \
        f32x16 pt; \
        _Pragma("unroll") for (int g = 0; g < 4; ++g) { float run = carry + after[g]; \
            _Pragma("unroll") for (int u = 3; u >= 0; --u) { const int i = 4 * g + u; run += L[i]; \
                float a = __builtin_amdgcn_exp2f(z[i] - run); \
                if (crow(i, hh) >= cdiag) a = 0.f; \
                pt[i] = a; } } \
        carry += tail; \
        if (NEXT) ATT_WAIT_V(16); else ATT_WAIT_V(0);                       \
        const LAS unsigned char* vb = vimg + (b) * 8192 + trb; \
        _Pragma("unroll") for (int s2 = 0; s2 < 2; ++s2) { const bf16x8 pb = pack8(pt, s2); \
            _Pragma("unroll") for (int db = 0; db < 4; ++db) { \
                const s16x4 lo = tr_read(vb + (s2 * 4 + db) * 1024), hi = tr_read(vb + (s2 * 4 + db) * 1024 + 512); \
                const bf16x8 va = __builtin_shufflevector(lo, hi, 0, 1, 2, 3, 4, 5, 6, 7); \
                o[db] = MFMA32(va, pb, o[db]); } } \
    } while (0)
__device__ __forceinline__ float sb_head(const Frame& F, int m0, int s0, int h, LAS unsigned char* vimg, const LAS float* gl) {
    int lane_ = F.lane; asm volatile("" : "+v"(lane_));
    const int lane = lane_, c = lane & 31, hh = lane >> 5;
    const bf16* qrow = F.QKV + (size_t)(m0 + c) * NIN + QB0 + h * 128 + 8 * hh;
    bf16x8 qf[8];
#pragma unroll
    for (int s = 0; s < 8; ++s) qf[s] = *(const bf16x8*)(qrow + 16 * s);
    f32x16 o[4];
#pragma unroll
    for (int d = 0; d < 4; ++d)
#pragma unroll
        for (int i = 0; i < 16; ++i) o[d][i] = 0.f;
    float carry = 0.f;
    const int rowbase = m0 - s0;
    const int q4 = (lane & 15) >> 2, p4 = lane & 3, g1 = (lane >> 4) & 1;
    const int trb = (4 * hh + q4) * 64 + (16 * g1 + 4 * p4) * 2;
    const unsigned voff = (unsigned)((lane >> 2) * (NIN * 2) + (lane & 3) * 16);
    const bf16* kbase = F.QKV + (size_t)(rowbase + c) * NIN + KB0 + h * 128 + 8 * hh;
    const unsigned char* vg = (const unsigned char*)(F.QKV + (size_t)rowbase * NIN + VB0 + h * 128);
    int kt = s0 >> 5;
    bf16x8 kf[8], kn[8];
    SB_ISSUE(kf, 0, kt * 32);
    if (kt > 0) SB_ISSUE(kn, 1, kt * 32 - 32);
    for (;;) {
        SB_TILE(kf, 0, kt * 32, kt > 0);
        if (kt == 0 || __all(carry > SB_STOP)) break;
        if (kt >= 2) { ATT_WAIT_L(); SB_ISSUE(kf, 0, kt * 32 - 64); }
        --kt;
        SB_TILE(kn, 1, kt * 32, kt > 0);
        if (kt == 0 || __all(carry > SB_STOP)) break;
        if (kt >= 2) { ATT_WAIT_L(); SB_ISSUE(kn, 1, kt * 32 - 64); }
        --kt;
    }
    ATT_WAIT_V(0);
    ATT_WAIT_L();
    float ssq = 0.f;
    LAS unsigned char* ot = vimg;
    const LAS float* gp = gl + 2048 + h * 128;
    const int OCOL = 2048 + h * 128;
#pragma unroll
    for (int db = 0; db < 4; ++db)
#pragma unroll
        for (int g = 0; g < 4; ++g) { const int d0 = 32 * db + 8 * g + 4 * hh; const f32x4 gv = *(const LAS f32x4*)(gp + d0);
            const float a0 = o[db][4 * g], a1 = o[db][4 * g + 1], a2 = o[db][4 * g + 2], a3 = o[db][4 * g + 3];
            ssq += (a0 * a0 + a1 * a1) + (a2 * a2 + a3 * a3);
            if (OCOL >= OKS) *(LAS unsigned*)(ot + c * 144 + d0) = pg8::cvt_pk_fp8x4(a0 * gv[0] * 8.0f, a1 * gv[1] * 8.0f, a2 * gv[2] * 8.0f, a3 * gv[3] * 8.0f);
            else { v2u w; w.x = cvt_pk_bf16(a0 * gv[0], a1 * gv[1]); w.y = cvt_pk_bf16(a2 * gv[2], a3 * gv[3]); *(LAS v2u*)(ot + c * 272 + d0 * 2) = w; } }
    asm volatile("" ::: "memory");
    if (OCOL >= OKS) { unsigned char* ob = (unsigned char*)F.O + (size_t)(m0 + (lane >> 3)) * pg8::ORB + (2 * OKS + OCOL - OKS) + (lane & 7) * 16;
#pragma unroll
      for (int k = 0; k < 4; ++k) { const v4u val = *(const LAS v4u*)(ot + (8 * k + (lane >> 3)) * 144 + (lane & 7) * 16); *(GAS v4u*)(ob + (size_t)(8 * k) * pg8::ORB) = val; } }
    else { unsigned char* ob = (unsigned char*)F.O + (size_t)(m0 + (lane >> 4)) * pg8::ORB + 2 * OCOL + (lane & 15) * 16;
#pragma unroll
      for (int k = 0; k < 8; ++k) { const v4u val = *(const LAS v4u*)(ot + (4 * k + (lane >> 4)) * 272 + (lane & 15) * 16); *(GAS v4u*)(ob + (size_t)(4 * k) * pg8::ORB) = val; } }
    ATT_WAIT_L();
    const f32x2 sp = pair32(ssq);
    return sp.x + sp.y;
}

__device__ __forceinline__ float swa_pair(const Frame& F, int m0, int s0, int hq, LAS unsigned char* vimg, const LAS float* gl) {
    int lane_ = F.lane; asm volatile("" : "+v"(lane_));
    const int lane = lane_, c = lane & 31, hh = lane >> 5, kvh = hq >> 3;
    LAS unsigned char* kimg = vimg + 8192;
    const bf16* qrow = F.QKV + (size_t)(m0 + c) * NIN + QA0 + hq * 64 + 8 * hh;
    bf16x8 qa[4], qb[4];
#pragma unroll
    for (int s = 0; s < 4; ++s) { qa[s] = *(const bf16x8*)(qrow + 16 * s); qb[s] = *(const bf16x8*)(qrow + 64 + 16 * s); }
    f32x16 oa[2], ob[2];
#pragma unroll
    for (int d = 0; d < 2; ++d)
#pragma unroll
        for (int i = 0; i < 16; ++i) { oa[d][i] = 0.f; ob[d][i] = 0.f; }
    float mxa = F.sinks[hq] * LOG2E, mxb = F.sinks[hq + 1] * LOG2E, la = 1.0f, lb = 1.0f;
    const int rowbase = m0 - s0;
    const int q4 = (lane & 15) >> 2, p4 = lane & 3, g1 = (lane >> 4) & 1;
    const int trb = (4 * hh + q4) * 64 + (16 * g1 + 4 * p4) * 2;
    const unsigned voff = (unsigned)((lane >> 2) * (NIN * 2) + (lane & 3) * 16);
    const unsigned koff = (unsigned)((lane >> 2) * (NIN * 2) + (((lane & 3) ^ ((lane >> 4) & 3)) * 16));
    const unsigned char* kg = (const unsigned char*)(F.QKV + (size_t)rowbase * NIN + KA0 + kvh * 64);
    const unsigned char* vg = (const unsigned char*)(F.QKV + (size_t)rowbase * NIN + VA0 + kvh * 64);
    const int x4 = (c >> 2) & 3;
    const int kr0 = (c >> 4) * 2048 + (c & 15) * 64 + ((hh ^ x4) << 4), kr1 = (c >> 4) * 2048 + (c & 15) * 64 + (((2 + hh) ^ x4) << 4);
    int j = (s0 >= 128) ? 0 : (128 - s0) >> 5;
#define SWA_ISSUE(jj) do { const ptrdiff_t ko_ = (ptrdiff_t)(s0 - 128 + 32 * (jj)) * (NIN * 2); const int b_ = ((jj) & 1) * 4096; \
        att_issue<2>(kg + ko_, koff, kimg + b_); att_issue<2>(vg + ko_, voff, vimg + b_); } while (0)
    SWA_ISSUE(j);
    if (j < 4) SWA_ISSUE(j + 1);
#pragma unroll 1
    for (; j < 5; ++j) {
        const int bo = (j & 1) * 4096;
        if (j < 4) ATT_WAIT_V(8); else ATT_WAIT_V(0);
        bf16x8 kf[4];
#pragma unroll
        for (int s = 0; s < 4; ++s) kf[s] = *(const LAS bf16x8*)(kimg + bo + ((s & 1) ? kr1 : kr0) + (s >> 1) * 1024);
        f32x16 za, zb;
#pragma unroll
        for (int i = 0; i < 16; ++i) { za[i] = 0.f; zb[i] = 0.f; }
#pragma unroll
        for (int s = 0; s < 4; ++s) { za = MFMA32(kf[s], qa[s], za); zb = MFMA32(kf[s], qb[s], zb); }
        const int wlo = (j == 0) ? c : -1, whi = (j == 4) ? c : 64;
        float tma = -1e30f, tmb = -1e30f;
#pragma unroll
        for (int i = 0; i < 16; ++i) { const int r = crow(i, hh); if (r <= wlo || r > whi) { za[i] = -1e30f; zb[i] = -1e30f; }
            tma = __builtin_fmaxf(tma, za[i]); tmb = __builtin_fmaxf(tmb, zb[i]); }
        const f32x2 tpa = pair32(tma), tpb = pair32(tmb);
        const float mna = __builtin_fmaxf(mxa, __builtin_fmaxf(tpa.x, tpa.y)), ala = __builtin_amdgcn_exp2f(mxa - mna);
        const float mnb = __builtin_fmaxf(mxb, __builtin_fmaxf(tpb.x, tpb.y)), alb = __builtin_amdgcn_exp2f(mxb - mnb);
        f32x16 pa, pb; float psa = 0.f, psb = 0.f;
#pragma unroll
        for (int i = 0; i < 16; ++i) { pa[i] = __builtin_amdgcn_exp2f(za[i] - mna); psa += pa[i]; pb[i] = __builtin_amdgcn_exp2f(zb[i] - mnb); psb += pb[i]; }
        const f32x2 ppa = pair32(psa), ppb = pair32(psb);
        la = la * ala + (ppa.x + ppa.y); mxa = mna; lb = lb * alb + (ppb.x + ppb.y); mxb = mnb;
#pragma unroll
        for (int d = 0; d < 2; ++d)
#pragma unroll
            for (int i = 0; i < 16; ++i) { oa[d][i] *= ala; ob[d][i] *= alb; }
        const LAS unsigned char* vb = vimg + bo + trb;
#pragma unroll
        for (int s2 = 0; s2 < 2; ++s2) { const bf16x8 fa = pack8(pa, s2), fb = pack8(pb, s2);
#pragma unroll
            for (int db = 0; db < 2; ++db) {
                const s16x4 lo = tr_read(vb + (s2 * 2 + db) * 1024), hi = tr_read(vb + (s2 * 2 + db) * 1024 + 512);
                const bf16x8 va = __builtin_shufflevector(lo, hi, 0, 1, 2, 3, 4, 5, 6, 7);
                oa[db] = MFMA32(va, fa, oa[db]); ob[db] = MFMA32(va, fb, ob[db]); } }
        if (j < 3) { ATT_WAIT_L(); SWA_ISSUE(j + 2); }
    }
#undef SWA_ISSUE
    const float inva = 1.0f / la, invb = 1.0f / lb;
    ATT_WAIT_L();
    float ssq = 0.f;
    LAS unsigned char* ot = vimg;
    const LAS float* gp = gl + hq * 64;
    const int OCOL = hq * 64;
#pragma unroll
    for (int db = 0; db < 2; ++db)
#pragma unroll
        for (int g = 0; g < 4; ++g) { const int d0 = 32 * db + 8 * g + 4 * hh; const f32x4 gva = *(const LAS f32x4*)(gp + d0), gvb = *(const LAS f32x4*)(gp + 64 + d0);
            const float a0 = oa[db][4 * g] * inva, a1 = oa[db][4 * g + 1] * inva, a2 = oa[db][4 * g + 2] * inva, a3 = oa[db][4 * g + 3] * inva;
            const float b0 = ob[db][4 * g] * invb, b1 = ob[db][4 * g + 1] * invb, b2 = ob[db][4 * g + 2] * invb, b3 = ob[db][4 * g + 3] * invb;
            ssq += ((a0 * a0 + a1 * a1) + (a2 * a2 + a3 * a3)) + ((b0 * b0 + b1 * b1) + (b2 * b2 + b3 * b3));
            if (OCOL >= OKS) { *(LAS unsigned*)(ot + c * 144 + d0) = pg8::cvt_pk_fp8x4(a0 * gva[0] * 8.0f, a1 * gva[1] * 8.0f, a2 * gva[2] * 8.0f, a3 * gva[3] * 8.0f);
                *(LAS unsigned*)(ot + c * 144 + 64 + d0) = pg8::cvt_pk_fp8x4(b0 * gvb[0] * 8.0f, b1 * gvb[1] * 8.0f, b2 * gvb[2] * 8.0f, b3 * gvb[3] * 8.0f); }
            else { v2u w; w.x = cvt_pk_bf16(a0 * gva[0], a1 * gva[1]); w.y = cvt_pk_bf16(a2 * gva[2], a3 * gva[3]); *(LAS v2u*)(ot + c * 272 + d0 * 2) = w;
                v2u x; x.x = cvt_pk_bf16(b0 * gvb[0], b1 * gvb[1]); x.y = cvt_pk_bf16(b2 * gvb[2], b3 * gvb[3]); *(LAS v2u*)(ot + c * 272 + 128 + d0 * 2) = x; } }
    asm volatile("" ::: "memory");
    if (OCOL >= OKS) { unsigned char* obp = (unsigned char*)F.O + (size_t)(m0 + (lane >> 3)) * pg8::ORB + (2 * OKS + OCOL - OKS) + (lane & 7) * 16;
#pragma unroll
      for (int k = 0; k < 4; ++k) { const v4u val = *(const LAS v4u*)(ot + (8 * k + (lane >> 3)) * 144 + (lane & 7) * 16); *(GAS v4u*)(obp + (size_t)(8 * k) * pg8::ORB) = val; } }
    else { unsigned char* obp = (unsigned char*)F.O + (size_t)(m0 + (lane >> 4)) * pg8::ORB + 2 * OCOL + (lane & 15) * 16;
#pragma unroll
      for (int k = 0; k < 8; ++k) { const v4u val = *(const LAS v4u*)(ot + (4 * k + (lane >> 4)) * 272 + (lane & 15) * 16); *(GAS v4u*)(obp + (size_t)(4 * k) * pg8::ORB) = val; } }
    ATT_WAIT_L();
    const f32x2 sp = pair32(ssq);
    return sp.x + sp.y;
}

__device__ __forceinline__ void p2_attention(Frame& F) {
    LAS unsigned char* vimg = F.lds + F.wave * ATT_VIMG;
    LAS float* red = (LAS float*)(F.lds + ATT_RED);
    LAS float* gl = (LAS float*)(F.lds + ATT_G);
    { const int i4 = 4 * F.tid;
      *(LAS f32x4*)(gl + i4) = *(const f32x4*)(F.g_a + i4); *(LAS f32x4*)(gl + 2048 + i4) = *(const f32x4*)(F.g_b + i4); }
    __syncthreads();
    for (int u = F.vcu; u < M / 32; u += F.G) {
        const int m0 = 32 * u, s0 = m0 & (SEQ - 1);
        float sa = 0.f, sb = 0.f;
        if (F.wave >= 4) __builtin_amdgcn_s_setprio(1); else __builtin_amdgcn_s_setprio(0);
#pragma unroll 1
        for (int i = 0; i < 2; ++i) sa += swa_pair(F, m0, s0, 4 * F.wave + 2 * i, vimg, gl);
        if (F.wave >= 4) __builtin_amdgcn_s_setprio(0); else __builtin_amdgcn_s_setprio(1);
#pragma unroll 1
        for (int i = 0; i < 2; ++i) sb += sb_head(F, m0, s0, 2 * F.wave + i, vimg, gl);
        __builtin_amdgcn_s_setprio(0);
        if (F.lane < 32) { red[(F.wave * 32 + F.lane) * 2] = sa; red[(F.wave * 32 + F.lane) * 2 + 1] = sb; }
        __syncthreads();
        if (F.tid < 32) { float ta = 0.f, tb = 0.f;
#pragma unroll
            for (int w = 0; w < 8; ++w) { ta += red[(w * 32 + F.tid) * 2]; tb += red[(w * 32 + F.tid) * 2 + 1]; }
            F.rr[2 * (size_t)(m0 + F.tid)] = 1.0f / __builtin_sqrtf(ta * (1.0f / 2048.0f) + RMS_EPS);
            F.rr[2 * (size_t)(m0 + F.tid) + 1] = 1.0f / __builtin_sqrtf(tb * (1.0f / 2048.0f) + RMS_EPS); }
        __syncthreads();
    }
}

__device__ __forceinline__ void p4_ln1_router(Frame& F, float* x1dst, int cw_cnt) {
    LAS unsigned char* ximg = F.lds;
    LAS float* red = (LAS float*)(F.lds + LN_RED);
    LAS float* lg = (LAS float*)(F.lds + LN_LOG);
    LAS float* bt = (LAS float*)(F.lds + LN_LOG + 3072);
    const int lane = F.lane, w = F.wave;
    if (F.tid < NRT) bt[F.tid] = F.tid < 4 ? F.b_group[F.tid] : (F.tid < 36 ? F.b_er[F.tid - 4] : 0.f);
    for (int it = F.vcu; it < M / 16; it += F.G) {
        const int row0 = 16 * it;
        v4u raw[2][8];
#pragma unroll
        for (int r2 = 0; r2 < 2; ++r2)
#pragma unroll
            for (int j = 0; j < 8; ++j) raw[r2][j] = *(const GAS v4u*)(F.Y1B + (size_t)(row0 + 2 * w + r2) * DM + 8 * lane + 512 * j);
#define LN_DEC(wd, lo4, hi4) const f32x4 lo4 = {__uint_as_float((wd).x << 16), __uint_as_float((wd).x & 0xffff0000u), __uint_as_float((wd).y << 16), __uint_as_float((wd).y & 0xffff0000u)}, \
                                         hi4 = {__uint_as_float((wd).z << 16), __uint_as_float((wd).z & 0xffff0000u), __uint_as_float((wd).w << 16), __uint_as_float((wd).w & 0xffff0000u)}
        float mean[2], rstd[2];
#pragma unroll
        for (int r2 = 0; r2 < 2; ++r2) { float s = 0.f;
#pragma unroll
            for (int j = 0; j < 8; ++j) { LN_DEC(raw[r2][j], a, b); s += ((a[0] + a[1]) + (a[2] + a[3])) + ((b[0] + b[1]) + (b[2] + b[3])); }
            mean[r2] = wave_sum(s) * (1.0f / DM); float q = 0.f;
#pragma unroll
            for (int j = 0; j < 8; ++j) { LN_DEC(raw[r2][j], a0, b0); const f32x4 a = a0 - mean[r2], b = b0 - mean[r2]; q += ((a[0] * a[0] + a[1] * a[1]) + (a[2] * a[2] + a[3] * a[3])) + ((b[0] * b[0] + b[1] * b[1]) + (b[2] * b[2] + b[3] * b[3])); }
            rstd[r2] = 1.0f / __builtin_sqrtf(wave_sum(q) * (1.0f / DM) + LN_EPS);
            if (lane == 0) *(f32x2*)(x1dst + 2 * (size_t)(row0 + 2 * w + r2)) = (f32x2){mean[r2], rstd[r2]}; }
#pragma unroll
        for (int j = 0; j < 8; ++j) { const int col = 8 * lane + 512 * j;
            const f32x4 g0 = *(const f32x4*)(F.ln1_g + col), g1 = *(const f32x4*)(F.ln1_g + col + 4), b0 = *(const f32x4*)(F.ln1_b + col), b1 = *(const f32x4*)(F.ln1_b + col + 4);
#pragma unroll
            for (int r2 = 0; r2 < 2; ++r2) { const int lr = 2 * w + r2, row = row0 + lr;
                LN_DEC(raw[r2][j], ya, yc);
                const f32x4 xa = (ya - mean[r2]) * rstd[r2] * g0 + b0, xc = (yc - mean[r2]) * rstd[r2] * g1 + b1;
                v4u pk; pk.x = cvt_pk_bf16(xa[0], xa[1]); pk.y = cvt_pk_bf16(xa[2], xa[3]); pk.z = cvt_pk_bf16(xc[0], xc[1]); pk.w = cvt_pk_bf16(xc[2], xc[3]);
                v2u p8; p8.x = pg8::cvt_pk_fp8x4(xa[0], xa[1], xa[2], xa[3]); p8.y = pg8::cvt_pk_fp8x4(xc[0], xc[1], xc[2], xc[3]);
                *(GAS v2u*)(F.X18 + (size_t)row * DM + col) = p8;
                *(LAS v4u*)(ximg + lr * LN_ROWB + col * 2) = pk; }
            if ((j & 1) == 1) asm volatile("" ::: "memory"); }
#undef LN_DEC
        __syncthreads();
        f32x4 acc[3];
#pragma unroll
        for (int cb = 0; cb < 3; ++cb) acc[cb] = (f32x4){0.f, 0.f, 0.f, 0.f};
#pragma unroll 8
        for (int ks = 0; ks < 16; ++ks) { const int k0 = 512 * w + 32 * ks + 8 * (lane >> 4);
            const bf16x8 a = *(const LAS bf16x8*)(ximg + (lane & 15) * LN_ROWB + k0 * 2);
#pragma unroll
            for (int cb = 0; cb < 3; ++cb) { const bf16x8 b = *(const bf16x8*)(F.WrT + (size_t)(16 * cb + (lane & 15)) * DM + k0); acc[cb] = MFMA16(a, b, acc[cb]); } }
#pragma unroll
        for (int cb = 0; cb < 3; ++cb)
#pragma unroll
            for (int j = 0; j < 4; ++j) red[(w * 16 + 4 * (lane >> 4) + j) * NRT + 16 * cb + (lane & 15)] = acc[cb][j];
        __syncthreads();
        for (int idx = F.tid; idx < 16 * NRT; idx += NWAVES * 64) { float t = 0.f;
#pragma unroll
            for (int ww = 0; ww < 8; ++ww) t += red[ww * 16 * NRT + idx];
            lg[idx] = t + bt[idx % NRT]; }
        __syncthreads();
        if (F.tid < 16) {
            const int tok = row0 + F.tid; const LAS float* lp = lg + F.tid * NRT;
            float gl[4]; int gi = 0;
#pragma unroll
            for (int cgi = 0; cgi < 4; ++cgi) gl[cgi] = lp[cgi];
#pragma unroll
            for (int cgi = 1; cgi < 4; ++cgi) if (gl[cgi] > gl[gi]) gi = cgi;
            float den = 0.f;
#pragma unroll
            for (int cgi = 0; cgi < 4; ++cgi) den += __expf(gl[cgi] - gl[gi]);
            const float gw = 1.0f / den;
            float el[8];
#pragma unroll
            for (int e = 0; e < 8; ++e) el[e] = lp[4 + 8 * gi + e];
            int i0 = 0;
#pragma unroll
            for (int e = 1; e < 8; ++e) if (el[e] > el[i0]) i0 = e;
            int i1 = (i0 == 0) ? 1 : 0;
#pragma unroll
            for (int e = 0; e < 8; ++e) if (e != i0 && el[e] > el[i1]) i1 = e;
            const float w0 = 1.0f / (1.0f + __expf(el[i1] - el[i0])), w1 = 1.0f - w0;
            const int e0 = 8 * gi + i0, e1 = 8 * gi + i1;
            const unsigned sl0 = __hip_atomic_fetch_add(F.ctl + cw_cnt + 64 * e0, 1u, RLX_AGENT);
            const unsigned sl1 = __hip_atomic_fetch_add(F.ctl + cw_cnt + 64 * e1, 1u, RLX_AGENT);
            F.list[e0 * M + sl0] = 2 * tok; F.list[e1 * M + sl1] = 2 * tok + 1;
            F.wts[2 * tok] = w0 * gw; F.wts[2 * tok + 1] = w1 * gw;
        }
    }
}

__device__ __forceinline__ void build_tab(Frame& F) {
    LAS int* tab = (LAS int*)(F.lds + TAB_OFF);
    __syncthreads();
    if (F.tid < NEXP) tab[33 + F.tid] = (int)__hip_atomic_load(F.ctl + CW_CNT + 64 * F.tid, RLX_AGENT);
    __syncthreads();
    if (F.tid == 0) { int a = 0; for (int e = 0; e < NEXP; ++e) { tab[e] = a; a += (tab[33 + e] + 255) >> 8; } tab[32] = a; }
    __syncthreads();
}

__device__ __forceinline__ void p9_ln2(Frame& F, float* dst) {
    const int gw = F.vcu * NWAVES + F.wave, NGW = F.G * NWAVES, lane = F.lane;
    for (int row = gw; row < M; row += NGW) {
        const bf16* y2 = F.Y2B + (size_t)row * DM + 8 * lane;
        const bf16* m0 = F.MOE + (size_t)row * DM + 8 * lane; const bf16* m1 = m0 + (size_t)M * DM;
        f32x4 v[16]; float s = 0.f;
#pragma unroll
        for (int j = 0; j < 8; ++j) { const v4u y = *(const GAS v4u*)(y2 + 512 * j), a = *(const GAS v4u*)(m0 + 512 * j), b = *(const GAS v4u*)(m1 + 512 * j);
#define BF3(f) ((__uint_as_float((y.f) << 16) + __uint_as_float((a.f) << 16)) + __uint_as_float((b.f) << 16))
#define BF3H(f) ((__uint_as_float((y.f) & 0xffff0000u) + __uint_as_float((a.f) & 0xffff0000u)) + __uint_as_float((b.f) & 0xffff0000u))
            v[2 * j] = (f32x4){BF3(x), BF3H(x), BF3(y), BF3H(y)}; v[2 * j + 1] = (f32x4){BF3(z), BF3H(z), BF3(w), BF3H(w)};
#undef BF3
#undef BF3H
            s += ((v[2 * j][0] + v[2 * j][1]) + (v[2 * j][2] + v[2 * j][3])) + ((v[2 * j + 1][0] + v[2 * j + 1][1]) + (v[2 * j + 1][2] + v[2 * j + 1][3]));
            if ((j & 1) == 1) asm volatile("" ::: "memory"); }
        const float mean = wave_sum(s) * (1.0f / DM); float q = 0.f;
#pragma unroll
        for (int j = 0; j < 16; ++j) { v[j] = v[j] - mean; q += (v[j][0] * v[j][0] + v[j][1] * v[j][1]) + (v[j][2] * v[j][2] + v[j][3] * v[j][3]); }
        const float rstd = 1.0f / __builtin_sqrtf(wave_sum(q) * (1.0f / DM) + LN_EPS);
#pragma unroll
        for (int j = 0; j < 8; ++j) { const int col = 8 * lane + 512 * j;
            const f32x4 g0 = *(const f32x4*)(F.ln2_g + col), g1 = *(const f32x4*)(F.ln2_g + col + 4), b0 = *(const f32x4*)(F.ln2_b + col), b1 = *(const f32x4*)(F.ln2_b + col + 4);
            *(f32x4*)(dst + (size_t)row * DM + col) = v[2 * j] * rstd * g0 + b0; *(f32x4*)(dst + (size_t)row * DM + col + 4) = v[2 * j + 1] * rstd * g1 + b1;
            if ((j & 1) == 1) asm volatile("" ::: "memory"); }
    }
}

__global__ void __launch_bounds__(NWAVES * 64, 2) hymba_fwd(Args args) {
    extern __shared__ __attribute__((aligned(16))) unsigned char lds[];
    Frame F;
    F.lds = (LAS unsigned char*)lds;
    F.MISC = (volatile LAS unsigned*)(F.lds + MISC_OFF);
    F.wave0 = __builtin_amdgcn_readfirstlane((int)threadIdx.x >> 6);
#define KTID() (F.wave0 * 64 + hw_lane())
    F.tid = KTID(); F.lane = F.tid & 63; F.wave = F.wave0;
    F.G = gridDim.x; { const int bx = blockIdx.x; F.vcu = (F.G % 8 == 0) ? (bx % 8) * (F.G / 8) + bx / 8 : bx; }
    F.ctl = (gu32*)(args.ws + WS_CTL);
    for (int u = KTID(); u < (LDS_BYTES - MISC_OFF) / 4; u += NWAVES * 64) ((LAS unsigned*)(F.lds + MISC_OFF))[u] = 0u;
    __syncthreads();
    XcdBarrier bar; bar.bar = (unsigned*)(F.ctl + CW_BAR); bar.x = 0; bar.st = nullptr;
    const unsigned ctl_tag = (((unsigned)(size_t)__builtin_amdgcn_dispatch_ptr() >> 6) << 1) | 1u;
    if (N_LAUNCHES == 1 && blockIdx.x == 0) {
        for (int u = KTID(); u < (int)(CTL_ZERO_BYTES / 4); u += NWAVES * 64) __hip_atomic_store(F.ctl + u, 0u, RLX_AGENT);
        __builtin_amdgcn_fence(__ATOMIC_RELEASE, "agent");
        asm volatile("s_waitcnt vmcnt(0)" ::: "memory");
        __syncthreads();
        if (KTID() == 0) __hip_atomic_store(F.ctl + CW_READY, ctl_tag, __ATOMIC_RELEASE, __HIP_MEMORY_SCOPE_AGENT);
    }
    bool ctl_ready = (N_LAUNCHES != 1);
#define CTL_READY() do { if (!ctl_ready) { ctl_ready = true; \
        if (KTID() == 0) { unsigned sp_ = 0; while (__hip_atomic_load(F.ctl + CW_READY, __ATOMIC_ACQUIRE, __HIP_MEMORY_SCOPE_AGENT) != ctl_tag) { __builtin_amdgcn_s_sleep(2); if (++sp_ > (1u << 22)) break; } } \
        __syncthreads(); bar = xcd_barrier_post((unsigned*)(F.ctl + CW_BAR), F.MISC + 8, KTID() == 0); } } while (0)
#define GRID_BAR() do { if (N_LAUNCHES == 1) { CTL_READY(); xcd_barrier(bar, KTID() == 0); } } while (0)
    const int lo = args.ph_lo, hi = args.ph_hi;
#ifndef PH_MASK
#define PH_MASK 0x3ff
#endif
#define IN(k) (((PH_MASK >> (k)) & 1) && lo <= (k) && (k) < hi)
#define BOTH(k) (IN(k) && IN((k) + 1))
#ifndef PROBE_REP
#define PROBE_REP 0
#endif
#define REP(k) (((PROBE_REP >> (k)) & 1) ? 2 : 1)
    const LAS int* tab = (const LAS int*)(F.lds + TAB_OFF);

    if (IN(0)) { Frame P = F; fill_ptrs(P); for (int rep = 0; rep < REP(0); ++rep) p0_prologue(P); if (BOTH(0)) GRID_BAR(); }
    if (IN(1)) { Frame P = F; fill_ptrs(P);
        { pg8::Gemm g{P.PB, P.WpT, M, DM, PLE}; pg8::StaticOrder S; S.init(M, DM, F.G, (int)blockIdx.x);
          pg8::EpiPlainBf16 E{P.PP, DM};
          pg8::gemm_phase<pg8::EpiPlainBf16, pg8::StaticOrder, true, true>(F.lds + RING_OFF, g, S, E, P.tid); }
        const int NG = (F.G == 256) ? 218 : F.G;
        if ((int)blockIdx.x < NG) { pg8::Gemm g{P.XB, P.WinT, M, NIN, DM}; pg8::StaticOrder S; S.init(M, NIN, NG, (int)blockIdx.x);
          pg8::EpiProj E{P.QKV, P.b_in, P.cs};
          for (int rep = 0; rep < REP(1); ++rep) pg8::gemm_phase<pg8::EpiProj, pg8::StaticOrder, true, true>(F.lds + RING_OFF, g, S, E, P.tid); }
        conv_queue(P);
        if (BOTH(1)) GRID_BAR();
    }
    if (IN(2)) { Frame P = F; fill_ptrs(P); for (int rep = 0; rep < REP(2); ++rep) p2_attention(P); if (BOTH(2)) GRID_BAR(); }
    if (IN(3)) { Frame P = F; fill_ptrs(P);
        pg8::Gemm g{P.O, P.WoutT, M, DM, D_FP8 ? pg8::ORB : DM}; pg8::StaticOrder S; S.init(M, DM, F.G, (int)blockIdx.x);
        pg8::EpiWout E{P.XB, P.Y1B, P.b_out, P.rr};
        for (int rep = 0; rep < REP(3); ++rep) pg8::gemm_phase<pg8::EpiWout, pg8::StaticOrder, true, true, D_FP8 ? 1 : 2, pg8::O_TSPLIT, D_FP8 ? 0x79797979 : 0x7c7c7c7c>(F.lds + RING_OFF, g, S, E, P.tid);
        if (BOTH(3)) GRID_BAR();
    }
    if (IN(4)) { Frame P = F; fill_ptrs(P);
        p4_ln1_router(P, P.stats, CW_CNT); if (BOTH(4)) GRID_BAR(); }
    if (IN(5)) { Frame P = F; fill_ptrs(P);
    }
    if (IN(6)) { Frame P = F; fill_ptrs(P);
        build_tab(P);
        const int G = F.G, c = (int)blockIdx.x, U6 = 4 * tab[32]; int x = 3 * G - U6; x = x < 0 ? 0 : (x > 512 ? 512 : x);
        int n6 = 0; while (n6 < 3 && c + G * n6 < U6) ++n6;
        if (U6 > 3 * G) n6 = 1 << 20;
        { pg8::Gemm g{(const pg8::bf16_t*)P.X18, (const pg8::bf16_t*)P.Wgu8, M, NEXP * 1024, DM}; pg8::GroupedList<true> S{tab, 4, tab[32], c, G, n6, P.list};
          pg8::EpiGateUp E{P.H8};
          pg8::gemm_phase<pg8::EpiGateUp, pg8::GroupedList<true>, true, true, 1>(F.lds + RING_OFF, g, S, E, P.tid); }
        { pg8::Gemm g{(const pg8::bf16_t*)P.X18, (const pg8::bf16_t*)P.Wg8, M, DM, DM}; pg8::DenseList S; const int lf = c + G * n6 - U6;
          int n8f = 0; if (n6 <= 3) { while (lf + G * n8f < x) ++n8f; }
          S.init(M, DM, lf, G, n8f);
          pg8::EpiPle E{P.Y1B, P.Y2B, P.b_pg, P.PP, P.stats, P.ln1_g, P.ln1_b};
          pg8::gemm_phase<pg8::EpiPle, pg8::DenseList, true, true, 1>(F.lds + RING_OFF, g, S, E, P.tid); }
        if (BOTH(6)) GRID_BAR();
    }
    if (IN(7)) { Frame P = F; fill_ptrs(P);
        build_tab(P);
        const int G = F.G, c = (int)blockIdx.x, U6 = 4 * tab[32]; int x = 3 * G - U6; x = x < 0 ? 0 : (x > 512 ? 512 : x);
        const int n8 = 512 - x;
        const bool one_each = n8 <= G;
        { pg8::Gemm g{(const pg8::bf16_t*)P.X18, (const pg8::bf16_t*)P.Wg8, M, DM, DM}; pg8::DenseList S;
          if (one_each) S.init(M, DM, x + c, 1, c < n8 ? 1 : 0); else S.init(M, DM, x + c, G, 1 << 20);
          pg8::EpiPle E{P.Y1B, P.Y2B, P.b_pg, P.PP, P.stats, P.ln1_g, P.ln1_b};
          pg8::gemm_phase<pg8::EpiPle, pg8::DenseList, true, true, 1>(F.lds + RING_OFF, g, S, E, P.tid); }
        { pg8::Gemm g{(const pg8::bf16_t*)P.H8, (const pg8::bf16_t*)P.Wd8, MPAD_MAX, NEXP * DM, DEXP};
          const int nw = one_each ? (G - n8) : G;
          pg8::GroupedList<false> S{tab, 16, tab[32], one_each ? c - n8 : c, nw > 0 ? nw : 1, (one_each && (c < n8 || nw <= 0)) ? 0 : (1 << 20), nullptr};
          pg8::EpiDown E{P.MOE, P.list, P.wts, tab + 33};
          pg8::gemm_phase<pg8::EpiDown, pg8::GroupedList<false>, true, true, 1>(F.lds + RING_OFF, g, S, E, P.tid); }
        if (BOTH(7)) GRID_BAR();
    }
    if (IN(8)) { Frame P = F; fill_ptrs(P); if (REP(8) == 2) p9_ln2(P, (float*)P.XG);
        p9_ln2(P, P.out); }
    if (N_LAUNCHES == 1 && blockIdx.x == 0 && KTID() == 0) __hip_atomic_store(F.ctl + CW_READY, 0u, RLX_AGENT);
#undef IN
#undef BOTH
#undef GRID_BAR
}

extern "C" void kernel_launch(void* const* d_in, const int* in_sizes, int n_in, void* d_out, int out_size, void* d_ws, size_t ws_size, hipStream_t stream) {
    static int grid = 0;
    if (grid == 0) {
        if (n_in != 24 || in_sizes[0] != M * DM || out_size != M * DM || ws_size < WS_END) { fprintf(stderr, "kernel_launch: unexpected shapes (n_in %d, in0 %d, out %d, ws %zu < %zu); nothing launched\n", n_in, n_in > 0 ? in_sizes[0] : -1, out_size, ws_size, (size_t)WS_END); grid = -1; return; }
        int dev = 0, cus = 0, per_cu = 0;
        if (hipGetDevice(&dev) != hipSuccess || hipDeviceGetAttribute(&cus, hipDeviceAttributeMultiprocessorCount, dev) != hipSuccess) { fprintf(stderr, "kernel_launch: device query failed\n"); grid = -1; return; }
        if (hipFuncSetAttribute((const void*)hymba_fwd, hipFuncAttributeMaxDynamicSharedMemorySize, LDS_BYTES) != hipSuccess) { fprintf(stderr, "kernel_launch: hipFuncSetAttribute failed\n"); grid = -1; return; }
        if (hipOccupancyMaxActiveBlocksPerMultiprocessor(&per_cu, (const void*)hymba_fwd, NWAVES * 64, LDS_BYTES) != hipSuccess || per_cu < 1)
            fprintf(stderr, "kernel_launch: note: occupancy query reports %d workgroups per CU\n", per_cu);
        (void)hipGetLastError();
        grid = cus < 256 ? cus : 256;
    }
    if (grid < 0) return;
    if (N_LAUNCHES != 1 && hipMemsetAsync((char*)d_ws + WS_CTL, 0, CTL_ZERO_BYTES, stream) != hipSuccess) { fprintf(stderr, "kernel_launch: hipMemsetAsync failed\n"); return; }
    Args a{};
    for (int i = 0; i < 24; ++i) a.in[i] = d_in[i];
    a.out = (float*)d_out; a.ws = (unsigned char*)d_ws;
    for (int li = 0; li < N_LAUNCHES; ++li) {
        a.ph_lo = (N_LAUNCHES == 1) ? 0 : li; a.ph_hi = (N_LAUNCHES == 1) ? N_PHASES : li + 1;
        hipLaunchKernelGGL(hymba_fwd, dim3(grid), dim3(NWAVES * 64), LDS_BYTES, stream, a);
        const hipError_t le = hipPeekAtLastError();
        if (le != hipSuccess) { fprintf(stderr, "kernel_launch: launch %d failed: %s\n", li, hipGetErrorName(le)); break; }
    }
}
```

```cpp
#include <hip/hip_runtime.h>
#include <cstdio>
#include <cstdint>

namespace pg8 {
#define PG8_LAS __attribute__((address_space(3)))
typedef unsigned short bf16_t;
typedef short bf16x8 __attribute__((ext_vector_type(8)));
typedef float f32x4 __attribute__((ext_vector_type(4)));
typedef float f32x2 __attribute__((ext_vector_type(2)));
typedef unsigned u32x4 __attribute__((ext_vector_type(4)));
typedef unsigned u32x2 __attribute__((ext_vector_type(2)));
typedef __bf16 bf16x2_t __attribute__((ext_vector_type(2)));
typedef int v4i_t __attribute__((ext_vector_type(4)));
typedef int v8i_t __attribute__((ext_vector_type(8)));
constexpr int BM = 256, BK = 64, HALF = 128, HTB = HALF * BK * 2  , STAGE_BYTES = 8 * HTB, NXCD = 8, WGM = 8;

__host__ __device__ __forceinline__ int lds_byte(int r, int c) { const int st = (r >> 4) * 2 + (c >> 5), rr = r & 15, cc = c & 31, ob = rr * 64 + cc * 2; return st * 1024 + (ob ^ (((ob >> 9) & 1) << 5)); }
__host__ __device__ __forceinline__ void stage_rc(int b, int& R, int& C) { const int st = b / 1024, sb = b % 1024, swz = sb ^ (((sb >> 9) & 1) << 5); R = (st >> 1) * 16 + swz / 64; C = (st & 1) * 32 + (swz % 64) / 2; }
__host__ __device__ __forceinline__ int perm32(int rho) { const int n = rho >> 4, i = rho & 15; return 8 * (i >> 2) + 4 * n + (i & 3); }
template <int PM> __host__ __device__ __forceinline__ int bperm(int R) {
    if (PM == 1) return (R & ~31) + perm32(R & 31);
    if (PM == 2) { const int wc = R >> 5, n = (R >> 4) & 1, i = R & 15; return 64 * (wc >> 1) + 16 * (wc & 1) + i + 32 * n; }
    return R;
}

struct Unit { int pm, pn, e, lt; };
struct Gemm { const bf16_t* A; const bf16_t* Bt; int M, N, K; };

struct StaticOrder {
    static constexpr bool GATHER = false;
    int nM, nN, nwg, G, c;
    __host__ __device__ void init(int M, int N, int G_, int c_) { nM = M / BM; nN = N / BM; nwg = nM * nN; G = G_; c = c_; }
    __host__ __device__ bool next(int i, Unit& u) const {
        const long L = (long)i * G + c; if (L >= nwg) return false;
        int wgid = (int)L; { const int q = nwg / NXCD, r = nwg % NXCD, xcd = wgid % NXCD, off = wgid / NXCD; wgid = (xcd < r ? xcd * (q + 1) : r * (q + 1) + (xcd - r) * q) + off; }
        const int nig = WGM * nN, gid = wgid / nig, fm = gid * WGM, gsz = (nM - fm) < WGM ? (nM - fm) : WGM;
        u.pm = fm + ((wgid % nig) % gsz); u.pn = (wgid % nig) / gsz; u.e = 0; u.lt = 0; return true;
    }
    __device__ __forceinline__ void a_ready(const Unit&) const {}
    __device__ __forceinline__ void done(const Unit&) const {}
};
struct GroupedOrder {
    static constexpr bool GATHER = false;
    const PG8_LAS int* tstart; int nN, total, G, c;
    __device__ __forceinline__ bool next(int i, Unit& u) const {
        const int L = i * G + c; if (L >= total * nN) return false;
        const int mt = L / nN, pn = L - mt * nN; int e = 0;
        while (e < 31 && tstart[e + 1] <= mt) ++e;
        u.pm = mt; u.pn = e * nN + pn; u.e = e; u.lt = mt - tstart[e]; return true;
    }
    __device__ __forceinline__ void a_ready(const Unit&) const {}
    __device__ __forceinline__ void done(const Unit&) const {}
};

struct DenseList {
    static constexpr bool GATHER = false;
    int nM, nN, nwg, v0, stride, n;
    __device__ __forceinline__ void init(int M, int N, int v0_, int stride_, int n_) { nM = M / BM; nN = N / BM; nwg = nM * nN; v0 = v0_; stride = stride_; n = n_; }
    __device__ __forceinline__ bool next(int i, Unit& u) const {
        if (i >= n) return false;
        int wgid = v0 + stride * i; if (wgid >= nwg) return false;
        { const int q = nwg / NXCD, r = nwg % NXCD, xcd = wgid % NXCD, off = wgid / NXCD; wgid = (xcd < r ? xcd * (q + 1) : r * (q + 1) + (xcd - r) * q) + off; }
        const int nig = WGM * nN, gid = wgid / nig, fm = gid * WGM, gsz = (nM - fm) < WGM ? (nM - fm) : WGM;
        u.pm = fm + ((wgid % nig) % gsz); u.pn = (wgid % nig) / gsz; u.e = 0; u.lt = 0; return true;
    }
    __device__ __forceinline__ void a_ready(const Unit&) const {}
    __device__ __forceinline__ void done(const Unit&) const {}
};
template <bool GATHER_> struct GroupedList {
    static constexpr bool GATHER = GATHER_;
    const PG8_LAS int* tstart; int nN, total, l0, stride, n;
    const int* list;
    __device__ __forceinline__ void a_rows(const Unit& u, const int (&R)[2], int (&rows)[2][2]) const {
        const int n_e = tstart[33 + u.e];
#pragma unroll
        for (int h = 0; h < 2; ++h)
#pragma unroll
            for (int i = 0; i < 2; ++i) { const int ii = u.lt * BM + h * HALF + R[i]; rows[h][i] = ii < n_e ? (list[u.e * 8192 + ii] >> 1) : 0; }
    }
    __device__ __forceinline__ bool next(int i, Unit& u) const {
        if (i >= n) return false;
        const int L = l0 + stride * i; if (L >= total * nN) return false;
        const int mt = L / nN, pn = L - mt * nN; int e = 0;
        while (e < 31 && tstart[e + 1] <= mt) ++e;
        u.pm = mt; u.pn = e * nN + pn; u.e = e; u.lt = mt - tstart[e]; return true;
    }
    __device__ __forceinline__ void a_ready(const Unit&) const {}
    __device__ __forceinline__ void done(const Unit&) const {}
};

__device__ __forceinline__ unsigned cvt_pk_bf16(float lo, float hi) { f32x2 v = {lo, hi}; bf16x2_t b = __builtin_convertvector(v, bf16x2_t); return __builtin_bit_cast(unsigned, b); }

__device__ __forceinline__ unsigned cvt_pk_fp8x4(float a_, float b_, float c_, float d_) { int w = 0; w = __builtin_amdgcn_cvt_pk_fp8_f32(a_, b_, w, false); w = __builtin_amdgcn_cvt_pk_fp8_f32(c_, d_, w, true); return (unsigned)w; }

constexpr float LOG2E = 1.4426950408889634f;
constexpr float ALPHA = 1.189207115002721f;
constexpr float QA_SCALE = 0.18033688011112042f;
constexpr float QB_SCALE = 0.12751743082459868f;


struct EpiPlainBf16 {
    static constexpr int PM = 1; static constexpr bool AFTER_DRAIN = false, MIDK = false;
    bf16_t* O; int ldc;
    __device__ __forceinline__ void operator()(const f32x4 (&acc)[2][2][4][2], const Unit& u, int wr, int wc, int fr, int fq) const {
        const int row0 = u.pm * BM + wr * 64 + fr, col0 = u.pn * BM + wc * 32 + 8 * fq;
#pragma unroll
        for (int ai = 0; ai < 2; ++ai)
#pragma unroll
            for (int m = 0; m < 4; ++m) { bf16_t* rowp = O + (size_t)(row0 + ai * HALF + m * 16) * ldc + col0;
#pragma unroll
                for (int bj = 0; bj < 2; ++bj) { const f32x4 v0 = acc[ai][bj][m][0], v1 = acc[ai][bj][m][1];
                    u32x4 w; w.x = cvt_pk_bf16(v0[0], v0[1]); w.y = cvt_pk_bf16(v0[2], v0[3]); w.z = cvt_pk_bf16(v1[0], v1[1]); w.w = cvt_pk_bf16(v1[2], v1[3]);
                    *(u32x4*)(rowp + bj * HALF) = w; } }
    }
};

struct EpiProj {
    static constexpr int PM = 2; static constexpr bool AFTER_DRAIN = false, MIDK = false;
    bf16_t* O; const float* bias; const float* cs;
    __device__ __forceinline__ void operator()(const f32x4 (&acc)[2][2][4][2], const Unit& u, int wr, int wc, int fr, int fq) const {
        constexpr int LD = 8704;
        const int row0 = u.pm * BM + wr * 64 + fr, tile = u.pn;
        const bool rope = tile < 9;
        const float sc = tile < 8 ? QA_SCALE : ((tile >= 10 && tile < 18) ? QB_SCALE : 1.0f);
        const int p0 = 16 * (wc & 1) + 4 * fq;
#pragma unroll
        for (int bj = 0; bj < 2; ++bj) {
            const int cb = tile * BM + HALF * bj + 64 * (wc >> 1) + p0;
            const f32x4 blo = *(const f32x4*)(bias + cb), bhi = *(const f32x4*)(bias + cb + 32);
#pragma unroll
            for (int ai = 0; ai < 2; ++ai)
#pragma unroll
                for (int m = 0; m < 4; ++m) {
                    const int row = row0 + ai * HALF + m * 16;
                    f32x4 a = acc[ai][bj][m][0] + blo, b = acc[ai][bj][m][1] + bhi;
                    if (rope) {
                        const f32x4 c01 = *(const f32x4*)(cs + (size_t)row * 64 + 2 * p0), c23 = *(const f32x4*)(cs + (size_t)row * 64 + 2 * p0 + 4);
                        const f32x4 co = {c01[0], c01[2], c23[0], c23[2]}, si = {c01[1], c01[3], c23[1], c23[3]};
                        const f32x4 ra = a * co - b * si, rb = b * co + a * si; a = ra; b = rb;
                    }
                    a = a * sc; b = b * sc;
                    u32x2 wa, wb; wa.x = cvt_pk_bf16(a[0], a[1]); wa.y = cvt_pk_bf16(a[2], a[3]); wb.x = cvt_pk_bf16(b[0], b[1]); wb.y = cvt_pk_bf16(b[2], b[3]);
                    bf16_t* rowp = O + (size_t)row * LD + cb;
                    *(u32x2*)rowp = wa; *(u32x2*)(rowp + 32) = wb;
                }
        }
    }
};

#ifndef D_FP8
#define D_FP8 1
#endif
#ifndef D_KSPLIT
#define D_KSPLIT 1024
#endif
constexpr int OKS = D_FP8 ? D_KSPLIT : 4096, ORB = OKS * 2 + (4096 - OKS);
constexpr int O_TSPLIT = D_FP8 ? OKS / 64 : 0, O_MIDT = !D_FP8 ? 0 : (OKS >= 2048 ? 32 : OKS / 64 + (2048 - OKS) / 128);
static_assert(OKS % 128 == 0 && OKS >= 0 && OKS <= 4096 && (O_MIDT % 2) == 0, "D_KSPLIT");
struct EpiWout {
    static constexpr int PM = 1; static constexpr bool AFTER_DRAIN = false, MIDK = true; static constexpr int MIDK_T = O_MIDT;
    const bf16_t* xb; bf16_t* Y; const float* bias; const float* rr;
    static constexpr int RRT_OFF = 131072;
    __device__ __forceinline__ void unit_begin(PG8_LAS unsigned char* lds, const Unit& u, int par, int wid, int lane) const {
        __builtin_amdgcn_global_load_lds((const unsigned*)(rr + 2 * (size_t)(u.pm * BM) + 64 * wid + lane), (PG8_LAS unsigned*)(lds + RRT_OFF + par * 2048 + wid * 256), 4, 0, 0);
    }
    __device__ __forceinline__ void midk(f32x4 (&acc)[2][2][4][2], const Unit& u, int wr, int fr, PG8_LAS unsigned char* lds, int par) const {
        const PG8_LAS float* rt = (const PG8_LAS float*)(lds + RRT_OFF + par * 2048);
#pragma unroll
        for (int ai = 0; ai < 2; ++ai)
#pragma unroll
            for (int m = 0; m < 4; ++m) { const f32x2 r = *(const PG8_LAS f32x2*)(rt + 2 * (ai * HALF + wr * 64 + m * 16 + fr));
                const float ratio = r.x / r.y;
#pragma unroll
                for (int bj = 0; bj < 2; ++bj)
#pragma unroll
                    for (int n = 0; n < 2; ++n) acc[ai][bj][m][n] = acc[ai][bj][m][n] * ratio;
                asm volatile("" : "+v"(acc[ai][0][m][0]), "+v"(acc[ai][0][m][1]), "+v"(acc[ai][1][m][0]), "+v"(acc[ai][1][m][1])); }
    }
    __device__ __forceinline__ void epi(const f32x4 (&acc)[2][2][4][2], const Unit& u, int wr, int wc, int fr, int fq, PG8_LAS unsigned char* lds, int par) const {
        constexpr int LD = 4096;
        const PG8_LAS float* rt = (const PG8_LAS float*)(lds + RRT_OFF + par * 2048);
        const int row0 = u.pm * BM + wr * 64 + fr, col0 = u.pn * BM + wc * 32 + 8 * fq;
        f32x4 bv[2][2];
#pragma unroll
        for (int bj = 0; bj < 2; ++bj)
#pragma unroll
            for (int n = 0; n < 2; ++n) bv[bj][n] = *(const f32x4*)(bias + col0 + bj * HALF + 4 * n);
        u32x4 xq[4][2][2];
#define EPW_LOAD(b_) do { _Pragma("unroll") for (int m_ = 0; m_ < 2; ++m_) { const size_t off_ = (size_t)(row0 + ((b_) >> 1) * HALF + (2 * ((b_) & 1) + m_) * 16) * LD + col0; xq[b_][m_][0] = *(const u32x4*)(xb + off_); xq[b_][m_][1] = *(const u32x4*)(xb + off_ + HALF); } } while (0)
        EPW_LOAD(0);
#pragma unroll
        for (int b = 0; b < 4; ++b) { const int ai = b >> 1;
            if (b == 0) EPW_LOAD(1); else if (b == 1) EPW_LOAD(2); else if (b == 2) EPW_LOAD(3);
            asm volatile("" ::: "memory");
#pragma unroll
            for (int mm = 0; mm < 2; ++mm) { const int m = 2 * (b & 1) + mm; const int row = row0 + ai * HALF + m * 16; const float rb = rt[2 * (ai * HALF + wr * 64 + m * 16 + fr) + 1]; const size_t off = (size_t)row * LD + col0;
#pragma unroll
                for (int bj = 0; bj < 2; ++bj) { const u32x4 xw = xq[b][mm][bj];
                    const f32x4 xa = {__uint_as_float(xw.x << 16), __uint_as_float(xw.x & 0xffff0000u), __uint_as_float(xw.y << 16), __uint_as_float(xw.y & 0xffff0000u)};
                    const f32x4 xc = {__uint_as_float(xw.z << 16), __uint_as_float(xw.z & 0xffff0000u), __uint_as_float(xw.w << 16), __uint_as_float(xw.w & 0xffff0000u)};
                    const f32x4 v0 = xa * ALPHA + acc[ai][bj][m][0] * rb + bv[bj][0], v1 = xc * ALPHA + acc[ai][bj][m][1] * rb + bv[bj][1];
                    u32x4 w; w.x = cvt_pk_bf16(v0[0], v0[1]); w.y = cvt_pk_bf16(v0[2], v0[3]); w.z = cvt_pk_bf16(v1[0], v1[1]); w.w = cvt_pk_bf16(v1[2], v1[3]);
                    *(u32x4*)(Y + off + bj * HALF) = w; } }
            asm volatile("" ::: "memory"); }
#undef EPW_LOAD
    }
};

struct EpiGateUp {
    static constexpr int PM = 1; static constexpr bool AFTER_DRAIN = false, MIDK = false;
    unsigned char* H;
    __device__ __forceinline__ void operator()(const f32x4 (&acc)[2][2][4][2], const Unit& u, int wr, int wc, int fr, int fq) const {
        constexpr int LD = 512;
        const int row0 = u.pm * BM + wr * 64 + fr, col0 = (u.pn & 3) * HALF + wc * 32 + 8 * fq;
#pragma unroll
        for (int ai = 0; ai < 2; ++ai)
#pragma unroll
            for (int m = 0; m < 4; ++m) {
                float h[8];
#pragma unroll
                for (int n = 0; n < 2; ++n)
#pragma unroll
                    for (int j = 0; j < 4; ++j) { const float g = acc[ai][0][m][n][j], up = acc[ai][1][m][n][j];
                        const float sg = __builtin_amdgcn_rcpf(1.0f + __builtin_amdgcn_exp2f(-g * LOG2E));
                        h[4 * n + j] = g * sg * up; }
                u32x2 w; w.x = cvt_pk_fp8x4(h[0], h[1], h[2], h[3]); w.y = cvt_pk_fp8x4(h[4], h[5], h[6], h[7]);
                *(u32x2*)(H + (size_t)(row0 + ai * HALF + m * 16) * LD + col0) = w;
            }
    }
};

struct EpiDown {
    static constexpr int PM = 1; static constexpr bool AFTER_DRAIN = false, MIDK = false;
    bf16_t* MOE; const int* list; const float* wts; const PG8_LAS int* cnt;
    __device__ __forceinline__ void operator()(const f32x4 (&acc)[2][2][4][2], const Unit& u, int wr, int wc, int fr, int fq) const {
        constexpr int LD = 4096, MTOK = 8192;
        const int n_e = cnt[u.e], i0 = u.lt * BM + wr * 64 + fr, col0 = (u.pn & 15) * BM + wc * 32 + 8 * fq;
#pragma unroll
        for (int ai = 0; ai < 2; ++ai)
#pragma unroll
            for (int m = 0; m < 4; ++m) {
                const int i = i0 + ai * HALF + m * 16;
                if (i < n_e) {
                    const int ent = list[u.e * MTOK + i]; const float w = wts[ent];
                    bf16_t* rowp = MOE + ((size_t)(ent & 1) * MTOK + (size_t)(ent >> 1)) * LD + col0;
#pragma unroll
                    for (int bj = 0; bj < 2; ++bj) { const f32x4 v0 = acc[ai][bj][m][0] * w, v1 = acc[ai][bj][m][1] * w;
                        u32x4 o; o.x = cvt_pk_bf16(v0[0], v0[1]); o.y = cvt_pk_bf16(v0[2], v0[3]); o.z = cvt_pk_bf16(v1[0], v1[1]); o.w = cvt_pk_bf16(v1[2], v1[3]);
                        *(u32x4*)(rowp + bj * HALF) = o; }
                }
            }
    }
};

struct EpiPle {
    static constexpr int PM = 1; static constexpr bool AFTER_DRAIN = false, MIDK = false;
    const bf16_t* Y1; bf16_t* Y2; const float* bias; const bf16_t* pp; const float* stats; const float* lng; const float* lnb;
    __device__ __forceinline__ void operator()(const f32x4 (&acc)[2][2][4][2], const Unit& u, int wr, int wc, int fr, int fq) const {
        constexpr int LD = 4096;
        const int row0 = u.pm * BM + wr * 64 + fr, col0 = u.pn * BM + wc * 32 + 8 * fq;
        f32x4 bv[2][2], gv[2][2], cv[2][2];
#pragma unroll
        for (int bj = 0; bj < 2; ++bj)
#pragma unroll
            for (int n = 0; n < 2; ++n) { bv[bj][n] = *(const f32x4*)(bias + col0 + bj * HALF + 4 * n); gv[bj][n] = *(const f32x4*)(lng + col0 + bj * HALF + 4 * n); cv[bj][n] = *(const f32x4*)(lnb + col0 + bj * HALF + 4 * n); }
#pragma unroll
        for (int ai = 0; ai < 2; ++ai)
#pragma unroll
            for (int m = 0; m < 4; ++m) { const int row = row0 + ai * HALF + m * 16; const size_t off = (size_t)row * LD + col0;
                const f32x2 st = *(const f32x2*)(stats + 2 * (size_t)row);
                const u32x4 y0 = *(const u32x4*)(Y1 + off), y1 = *(const u32x4*)(Y1 + off + HALF), p0 = *(const u32x4*)(pp + off), p1 = *(const u32x4*)(pp + off + HALF);
#pragma unroll
                for (int bj = 0; bj < 2; ++bj) { const u32x4 yw = bj ? y1 : y0, pw = bj ? p1 : p0; u32x4 w;
#pragma unroll
                    for (int n = 0; n < 2; ++n) { const unsigned ya = n ? yw.z : yw.x, yb = n ? yw.w : yw.y, pa = n ? pw.z : pw.x, pb = n ? pw.w : pw.y;
                        const f32x4 yv = {__uint_as_float(ya << 16), __uint_as_float(ya & 0xffff0000u), __uint_as_float(yb << 16), __uint_as_float(yb & 0xffff0000u)};
                        const f32x4 pv = {__uint_as_float(pa << 16), __uint_as_float(pa & 0xffff0000u), __uint_as_float(pb << 16), __uint_as_float(pb & 0xffff0000u)};
                        const f32x4 x1 = (yv - st.x) * st.y * gv[bj][n] + cv[bj][n];
                        const f32x4 t = acc[ai][bj][m][n] + bv[bj][n]; f32x4 sg;
#pragma unroll
                        for (int j = 0; j < 4; ++j) sg[j] = __builtin_amdgcn_rcpf(1.0f + __builtin_amdgcn_exp2f(-t[j] * LOG2E));
                        const f32x4 o = x1 * ALPHA + sg * pv;
                        if (n == 0) { w.x = cvt_pk_bf16(o[0], o[1]); w.y = cvt_pk_bf16(o[2], o[3]); } else { w.z = cvt_pk_bf16(o[0], o[1]); w.w = cvt_pk_bf16(o[2], o[3]); } }
                    *(u32x4*)(Y2 + off + bj * HALF) = w; }
                asm volatile("" ::: "memory"); }
    }
};

template <class Epi, class Sched, bool ALIGN_EPI = false, bool SP2 = false, int ELT = 2, int TSPLIT = 0, int ASCALE = 0x7c7c7c7c>
__device__ __forceinline__ void gemm_phase(PG8_LAS unsigned char* lds, const Gemm g, const Sched& S, const Epi& E, int tid_in) {
    int tid_ = tid_in; asm volatile("" : "+v"(tid_));
    const int tid = tid_, wid = __builtin_amdgcn_readfirstlane(tid >> 6), lane = tid & 63, wr = wid >> 2, wc = wid & 3, fr = lane & 15, fq = lane >> 4;
    const int K = g.K, nt = K * ELT / (BK * 2);
    static_assert(SP2 || !Sched::GATHER, "the gather form is written for the SP2 loop only");
    unsigned voffB[2];
#pragma unroll
    for (int i = 0; i < 2; ++i) { int R, C; stage_rc(tid * 16 + i * 8192, R, C); const int Rb = bperm<Epi::PM>(R);
        voffB[i] = (unsigned)(Rb * K * ELT + C * 2); }
    unsigned vAc[2][2], vAn[2][2];
#define PG8_AOFFS(dst, unit) do { int aR[2], aC[2]; _Pragma("unroll") for (int i_ = 0; i_ < 2; ++i_) stage_rc(tid * 16 + i_ * 8192, aR[i_], aC[i_]);     \
        if constexpr (Sched::GATHER) { int rows_[2][2]; S.a_rows(unit, aR, rows_); _Pragma("unroll") for (int h_ = 0; h_ < 2; ++h_) _Pragma("unroll") for (int i_ = 0; i_ < 2; ++i_) \
            dst[h_][i_] = (unsigned)rows_[h_][i_] * (unsigned)(K * ELT) + (unsigned)(aC[i_] * 2); } \
        else { _Pragma("unroll") for (int h_ = 0; h_ < 2; ++h_) _Pragma("unroll") for (int i_ = 0; i_ < 2; ++i_) dst[h_][i_] = (unsigned)((h_ * HALF + aR[i_]) * K * ELT + aC[i_] * 2); } } while (0)
    const size_t kstep = (size_t)(BK * 2);
    const size_t hstep = (size_t)HALF * K * ELT;
    const size_t tstep = 2 * hstep;
    const unsigned ldsw = (unsigned)wid * 1024u;
    const int aoff = lds_byte(wr * 64 + fr, fq * 8), boff = lds_byte(wc * 32 + fr, fq * 8);
#define PG8_SA(b, h) (((b) * 2 + (h)) * HTB)
#define PG8_SB(b, h) ((4 + (b) * 2 + (h)) * HTB)
#define PG8_STAGE(bufoff, gbase, voff) do { _Pragma("unroll") for (int _i = 0; _i < 2; ++_i) \
        __builtin_amdgcn_global_load_lds((const unsigned*)((const char*)(gbase) + (voff)[_i]), (PG8_LAS unsigned*)(lds + (bufoff) + ldsw + _i * 8192), 16, 0, 0); } while (0)
#define PG8_LDA(dst, b, h) do { _Pragma("unroll") for (int m = 0; m < 4; ++m) { if constexpr (ELT == 2 || PG8_BF16T) { _Pragma("unroll") for (int k = 0; k < 2; ++k) dst[m][k] = *(const PG8_LAS bf16x8*)(lds + PG8_SA(b, h) + aoff + m * 2048 + k * 1024); } \
        else { const v4i_t lo_ = *(const PG8_LAS v4i_t*)(lds + PG8_SA(b, h) + aoff + m * 2048), hi_ = *(const PG8_LAS v4i_t*)(lds + PG8_SA(b, h) + aoff + m * 2048 + 1024); dst##8[m] = __builtin_shufflevector(lo_, hi_, 0, 1, 2, 3, 4, 5, 6, 7); } } } while (0)
#define PG8_LDB(dst, b, h) do { _Pragma("unroll") for (int n = 0; n < 2; ++n) { if constexpr (ELT == 2 || PG8_BF16T) { _Pragma("unroll") for (int k = 0; k < 2; ++k) dst[n][k] = *(const PG8_LAS bf16x8*)(lds + PG8_SB(b, h) + boff + n * 2048 + k * 1024); } \
        else { const v4i_t lo_ = *(const PG8_LAS v4i_t*)(lds + PG8_SB(b, h) + boff + n * 2048), hi_ = *(const PG8_LAS v4i_t*)(lds + PG8_SB(b, h) + boff + n * 2048 + 1024); dst##8[n] = __builtin_shufflevector(lo_, hi_, 0, 1, 2, 3, 4, 5, 6, 7); } } } while (0)
#define PG8_MMA(ai, bj, At, Bt) do { __builtin_amdgcn_s_setprio(1); \
        if constexpr (ELT == 2 || PG8_BF16T) { _Pragma("unroll") for (int m = 0; m < 4; ++m) _Pragma("unroll") for (int n = 0; n < 2; ++n) _Pragma("unroll") for (int k = 0; k < 2; ++k) \
            acc[ai][bj][m][n] = __builtin_amdgcn_mfma_f32_16x16x32_bf16(Bt[n][k], At[m][k], acc[ai][bj][m][n], 0, 0, 0); } \
        else { _Pragma("unroll") for (int m = 0; m < 4; ++m) _Pragma("unroll") for (int n = 0; n < 2; ++n) \
            asm volatile("v_mfma_scale_f32_16x16x128_f8f6f4 %0, %1, %2, %0, %3, %4 op_sel_hi:[0,0,0]" : "+v"(acc[ai][bj][m][n]) : "v"(Bt##8[n]), "v"(At##8[m]), "v"(mxscale), "v"(mxscale_a)); }     \
        __builtin_amdgcn_s_setprio(0); } while (0)
#define PG8_WAIT_V(n) asm volatile("s_waitcnt vmcnt(" #n ")" ::: "memory")
#define PG8_WAIT_L(n) asm volatile("s_waitcnt lgkmcnt(" #n ")" ::: "memory")
#define PG8_BAR __builtin_amdgcn_s_barrier()
#define PG8_SCHED __builtin_amdgcn_sched_barrier(0)
    Unit cur, nxt; int ui = 0;
    if (!S.next(0, cur)) return;
    f32x4 acc[2][2][4][2];
#pragma unroll
    for (int a = 0; a < 2; ++a)
#pragma unroll
        for (int b = 0; b < 2; ++b)
#pragma unroll
            for (int m = 0; m < 4; ++m)
#pragma unroll
                for (int n = 0; n < 2; ++n) acc[a][b][m][n] = (f32x4){0.f, 0.f, 0.f, 0.f};
    bf16x8 At[4][2], B0[2][2], B1[2][2];
    v8i_t At8[4], B08[2], B18[2];
    int mxscale = 0x7c7c7c7c; asm volatile("" : "+v"(mxscale));
    int mxscale_a = ASCALE; asm volatile("" : "+v"(mxscale_a));
    const char* cA = (const char*)g.A + (Sched::GATHER ? (size_t)0 : (size_t)cur.pm * tstep); const char* cB = (const char*)g.Bt + (size_t)cur.pn * tstep;
    S.a_ready(cur);
    if constexpr (Epi::MIDK) E.unit_begin(lds, cur, 0, wid, lane);
    PG8_AOFFS(vAc, cur);
#pragma unroll
    for (int h_ = 0; h_ < 2; ++h_)
#pragma unroll
        for (int i_ = 0; i_ < 2; ++i_) vAn[h_][i_] = vAc[h_][i_];
    if constexpr (SP2) {
        PG8_STAGE(PG8_SB(0, 0), cB, voffB); PG8_STAGE(PG8_SB(0, 1), cB + hstep, voffB); PG8_STAGE(PG8_SA(0, 0), cA, vAc[0]); PG8_STAGE(PG8_SA(0, 1), cA, vAc[1]);
        if (wr == 1) PG8_BAR;
        PG8_WAIT_V(2); PG8_BAR;
        PG8_STAGE(PG8_SB(1, 0), cB + kstep, voffB); PG8_STAGE(PG8_SA(1, 0), cA + kstep, vAc[0]); PG8_STAGE(PG8_SB(1, 1), cB + hstep + kstep, voffB);
        PG8_WAIT_V(6); PG8_BAR;
    } else {
        PG8_STAGE(PG8_SB(0, 0), cB, voffB); PG8_STAGE(PG8_SA(0, 0), cA, vAc[0]); PG8_STAGE(PG8_SB(0, 1), cB + hstep, voffB); PG8_STAGE(PG8_SA(0, 1), cA, vAc[1]);
        if (wr == 1) PG8_BAR;
        PG8_WAIT_V(4); PG8_BAR;
        PG8_STAGE(PG8_SB(1, 0), cB + kstep, voffB); PG8_STAGE(PG8_SA(1, 0), cA + kstep, vAc[0]); PG8_STAGE(PG8_SB(1, 1), cB + hstep + kstep, voffB);
        PG8_WAIT_V(6); PG8_BAR;
    }
    for (;;) {
        const bool has_next = S.next(ui + 1, nxt);
        const char* nA = (has_next && !Sched::GATHER) ? (const char*)g.A + (size_t)nxt.pm * tstep : cA; const char* nB = has_next ? (const char*)g.Bt + (size_t)nxt.pn * tstep : cB;
        if constexpr (TSPLIT > 0) { constexpr bool PG8_BF16T = true;
#pragma unroll 1
        for (int t = 0; t < TSPLIT; t += 2) {
            const bool last = (t == nt - 2);
            if constexpr (TSPLIT > 0) asm volatile("" : "+v"(voffB[0]), "+v"(voffB[1]), "+v"(vAc[0][0]), "+v"(vAc[0][1]), "+v"(vAc[1][0]), "+v"(vAc[1][1]));
            const char* a1 = cA + (size_t)(t + 1) * kstep;
            const char* a2 = last ? nA : cA + (size_t)(t + 2) * kstep; const char* b2 = last ? nB : cB + (size_t)(t + 2) * kstep;
            const char* a3 = a2 + kstep; const char* b3 = b2 + kstep;
            if (last && has_next) { S.a_ready(nxt); if constexpr (Sched::GATHER) PG8_AOFFS(vAn, nxt); if constexpr (Epi::MIDK) E.unit_begin(lds, nxt, (ui + 1) & 1, wid, lane); }
            if constexpr (Epi::MIDK) { if (t == (Epi::MIDK_T ? Epi::MIDK_T : (nt >> 1))) E.midk(acc, cur, wr, fr, lds, ui & 1); }
            if constexpr (SP2) {
            PG8_LDB(B0, 0, 0); PG8_LDB(B1, 0, 1); PG8_SCHED; PG8_LDA(At, 0, 0); PG8_STAGE(PG8_SA(1, 1), a1, vAc[1]);
            if constexpr (Sched::GATHER) { if (last) { _Pragma("unroll") for (int h_ = 0; h_ < 2; ++h_) _Pragma("unroll") for (int i_ = 0; i_ < 2; ++i_) vAc[h_][i_] = vAn[h_][i_]; } }
            PG8_WAIT_V(8); PG8_WAIT_L(0); PG8_BAR; PG8_MMA(0, 0, At, B0); PG8_MMA(0, 1, At, B1); PG8_BAR; PG8_SCHED;
            PG8_LDA(At, 0, 1); PG8_STAGE(PG8_SB(0, 0), b2, voffB); PG8_STAGE(PG8_SB(0, 1), b2 + hstep, voffB); PG8_STAGE(PG8_SA(0, 0), a2, vAc[0]);
            PG8_WAIT_V(8); PG8_WAIT_L(0); PG8_BAR; PG8_MMA(1, 0, At, B0); PG8_MMA(1, 1, At, B1); PG8_BAR; PG8_SCHED;
            PG8_LDB(B0, 1, 0); PG8_LDB(B1, 1, 1); PG8_SCHED; PG8_LDA(At, 1, 0); PG8_STAGE(PG8_SA(0, 1), a2, vAc[1]);
            PG8_WAIT_V(8); PG8_WAIT_L(0); PG8_BAR; PG8_MMA(0, 0, At, B0); PG8_MMA(0, 1, At, B1); PG8_BAR; PG8_SCHED;
            PG8_LDA(At, 1, 1); PG8_STAGE(PG8_SB(1, 0), b3, voffB); PG8_STAGE(PG8_SB(1, 1), b3 + hstep, voffB); PG8_STAGE(PG8_SA(1, 0), a3, vAc[0]);
            PG8_WAIT_V(8); PG8_WAIT_L(0); PG8_BAR; PG8_MMA(1, 0, At, B0); PG8_MMA(1, 1, At, B1); PG8_BAR; PG8_SCHED;
            } else {
            PG8_LDB(B0, 0, 0); PG8_SCHED; PG8_LDA(At, 0, 0); PG8_STAGE(PG8_SA(1, 1), a1, vAc[1]);
            PG8_WAIT_L(8); PG8_BAR; PG8_WAIT_L(0); PG8_MMA(0, 0, At, B0); PG8_BAR; PG8_SCHED;
            PG8_LDB(B1, 0, 1); PG8_STAGE(PG8_SB(0, 0), b2, voffB);
            PG8_BAR; PG8_WAIT_L(0); PG8_MMA(0, 1, At, B1); PG8_BAR;
            PG8_LDA(At, 0, 1); PG8_STAGE(PG8_SA(0, 0), a2, vAc[0]);
            PG8_BAR; PG8_WAIT_L(0); PG8_MMA(1, 0, At, B0); PG8_BAR; PG8_SCHED;
            PG8_STAGE(PG8_SB(0, 1), b2 + hstep, voffB);
            PG8_WAIT_V(6); PG8_BAR; PG8_MMA(1, 1, At, B1); PG8_BAR;
            PG8_LDB(B0, 1, 0); PG8_SCHED; PG8_LDA(At, 1, 0); PG8_STAGE(PG8_SA(0, 1), a2, vAc[1]);
            PG8_WAIT_L(8); PG8_BAR; PG8_WAIT_L(0); PG8_MMA(0, 0, At, B0); PG8_BAR; PG8_SCHED;
            PG8_LDB(B1, 1, 1); PG8_STAGE(PG8_SB(1, 0), b3, voffB);
            PG8_BAR; PG8_WAIT_L(0); PG8_MMA(0, 1, At, B1); PG8_BAR;
            PG8_LDA(At, 1, 1); PG8_STAGE(PG8_SA(1, 0), a3, vAc[0]);
            PG8_BAR; PG8_WAIT_L(0); PG8_MMA(1, 0, At, B0); PG8_BAR; PG8_SCHED;
            PG8_STAGE(PG8_SB(1, 1), b3 + hstep, voffB);
            PG8_WAIT_V(6); PG8_BAR; PG8_MMA(1, 1, At, B1); PG8_BAR;
            }
        }
        }
        { constexpr bool PG8_BF16T = false;
#pragma unroll 1
        for (int t = TSPLIT; t < nt; t += 2) {
            const bool last = (t == nt - 2);
            if constexpr (TSPLIT > 0) asm volatile("" : "+v"(voffB[0]), "+v"(voffB[1]), "+v"(vAc[0][0]), "+v"(vAc[0][1]), "+v"(vAc[1][0]), "+v"(vAc[1][1]));
            const char* a1 = cA + (size_t)(t + 1) * kstep;
            const char* a2 = last ? nA : cA + (size_t)(t + 2) * kstep; const char* b2 = last ? nB : cB + (size_t)(t + 2) * kstep;
            const char* a3 = a2 + kstep; const char* b3 = b2 + kstep;
            if (last && has_next) { S.a_ready(nxt); if constexpr (Sched::GATHER) PG8_AOFFS(vAn, nxt); if constexpr (Epi::MIDK) E.unit_begin(lds, nxt, (ui + 1) & 1, wid, lane); }
            if constexpr (Epi::MIDK) { if (t == (Epi::MIDK_T ? Epi::MIDK_T : (nt >> 1))) E.midk(acc, cur, wr, fr, lds, ui & 1); }
            if constexpr (SP2) {
            PG8_LDB(B0, 0, 0); PG8_LDB(B1, 0, 1); PG8_SCHED; PG8_LDA(At, 0, 0); PG8_STAGE(PG8_SA(1, 1), a1, vAc[1]);
            if constexpr (Sched::GATHER) { if (last) { _Pragma("unroll") for (int h_ = 0; h_ < 2; ++h_) _Pragma("unroll") for (int i_ = 0; i_ < 2; ++i_) vAc[h_][i_] = vAn[h_][i_]; } }
            PG8_WAIT_V(8); PG8_WAIT_L(0); PG8_BAR; PG8_MMA(0, 0, At, B0); PG8_MMA(0, 1, At, B1); PG8_BAR; PG8_SCHED;
            PG8_LDA(At, 0, 1); PG8_STAGE(PG8_SB(0, 0), b2, voffB); PG8_STAGE(PG8_SB(0, 1), b2 + hstep, voffB); PG8_STAGE(PG8_SA(0, 0), a2, vAc[0]);
            PG8_WAIT_V(8); PG8_WAIT_L(0); PG8_BAR; PG8_MMA(1, 0, At, B0); PG8_MMA(1, 1, At, B1); PG8_BAR; PG8_SCHED;
            PG8_LDB(B0, 1, 0); PG8_LDB(B1, 1, 1); PG8_SCHED; PG8_LDA(At, 1, 0); PG8_STAGE(PG8_SA(0, 1), a2, vAc[1]);
            PG8_WAIT_V(8); PG8_WAIT_L(0); PG8_BAR; PG8_MMA(0, 0, At, B0); PG8_MMA(0, 1, At, B1); PG8_BAR; PG8_SCHED;
            PG8_LDA(At, 1, 1); PG8_STAGE(PG8_SB(1, 0), b3, voffB); PG8_STAGE(PG8_SB(1, 1), b3 + hstep, voffB); PG8_STAGE(PG8_SA(1, 0), a3, vAc[0]);
            PG8_WAIT_V(8); PG8_WAIT_L(0); PG8_BAR; PG8_MMA(1, 0, At, B0); PG8_MMA(1, 1, At, B1); PG8_BAR; PG8_SCHED;
            } else {
            PG8_LDB(B0, 0, 0); PG8_SCHED; PG8_LDA(At, 0, 0); PG8_STAGE(PG8_SA(1, 1), a1, vAc[1]);
            PG8_WAIT_L(8); PG8_BAR; PG8_WAIT_L(0); PG8_MMA(0, 0, At, B0); PG8_BAR; PG8_SCHED;
            PG8_LDB(B1, 0, 1); PG8_STAGE(PG8_SB(0, 0), b2, voffB);
            PG8_BAR; PG8_WAIT_L(0); PG8_MMA(0, 1, At, B1); PG8_BAR;
            PG8_LDA(At, 0, 1); PG8_STAGE(PG8_SA(0, 0), a2, vAc[0]);
            PG8_BAR; PG8_WAIT_L(0); PG8_MMA(1, 0, At, B0); PG8_BAR; PG8_SCHED;
            PG8_STAGE(PG8_SB(0, 1), b2 + hstep, voffB);
            PG8_WAIT_V(6); PG8_BAR; PG8_MMA(1, 1, At, B1); PG8_BAR;
            PG8_LDB(B0, 1, 0); PG8_SCHED; PG8_LDA(At, 1, 0); PG8_STAGE(PG8_SA(0, 1), a2, vAc[1]);
            PG8_WAIT_L(8); PG8_BAR; PG8_WAIT_L(0); PG8_MMA(0, 0, At, B0); PG8_BAR; PG8_SCHED;
            PG8_LDB(B1, 1, 1); PG8_STAGE(PG8_SB(1, 0), b3, voffB);
            PG8_BAR; PG8_WAIT_L(0); PG8_MMA(0, 1, At, B1); PG8_BAR;
            PG8_LDA(At, 1, 1); PG8_STAGE(PG8_SA(1, 0), a3, vAc[0]);
            PG8_BAR; PG8_WAIT_L(0); PG8_MMA(1, 0, At, B0); PG8_BAR; PG8_SCHED;
            PG8_STAGE(PG8_SB(1, 1), b3 + hstep, voffB);
            PG8_WAIT_V(6); PG8_BAR; PG8_MMA(1, 1, At, B1); PG8_BAR;
            }
        }
        }
        if constexpr (ALIGN_EPI) { if (wr == 0) PG8_BAR; }
        if constexpr (ELT == 1) asm volatile("s_nop 15\n\ts_nop 15" ::: "memory");
        if constexpr (Epi::MIDK) { E.epi(acc, cur, wr, wc, fr, fq, lds, ui & 1); S.done(cur); }
        else if constexpr (!Epi::AFTER_DRAIN) { E(acc, cur, wr, wc, fr, fq); S.done(cur); }
        if (!has_next) break;
#pragma unroll
        for (int a = 0; a < 2; ++a)
#pragma unroll
            for (int b = 0; b < 2; ++b)
#pragma unroll
                for (int m = 0; m < 4; ++m)
#pragma unroll
                    for (int n = 0; n < 2; ++n) acc[a][b][m][n] = (f32x4){0.f, 0.f, 0.f, 0.f};
        cur = nxt; cA = nA; cB = nB; ++ui;
        if constexpr (ALIGN_EPI) { if (wr == 1) PG8_BAR; }
    }
    PG8_WAIT_V(0);
    if constexpr (!ALIGN_EPI) { if (wr == 0) PG8_BAR; }
    PG8_BAR;
    if constexpr (Epi::AFTER_DRAIN) { E.fused(acc, cur, wr, wc, fr, fq, lds, wid, lane); S.done(cur); }
#undef PG8_AOFFS
#undef PG8_SA
#undef PG8_SB
#undef PG8_STAGE
#undef PG8_LDA
#undef PG8_LDB
#undef PG8_MMA
#undef PG8_WAIT_V
#undef PG8_WAIT_L
#undef PG8_BAR
#undef PG8_SCHED
}
}

constexpr int NWAVES = 8;
#ifndef MK_N_LAUNCHES
#define MK_N_LAUNCHES 1
#endif
constexpr int N_PHASES = 9;
constexpr int N_LAUNCHES = MK_N_LAUNCHES;
static_assert(N_LAUNCHES == 1 || N_LAUNCHES == N_PHASES, "MK_N_LAUNCHES is 1 or 9");

constexpr int BATCH = 2, SEQ = 4096, DM = 4096, M = BATCH * SEQ;
constexpr int NIN = 8704;
constexpr int QA0 = 0, KA0 = 2048, VA0 = 2304, QB0 = 2560, KB0 = 4608, VB0 = 6656;
constexpr int NEXP = 32, DEXP = 512, PLE = 256, NRT = 48;
constexpr float LN_EPS = 1e-5f, RMS_EPS = 1e-6f;
constexpr float SB_STOP = 32.0f;

constexpr size_t MiB = 1u << 20;
constexpr size_t WS_CTL = 0, CTL_ZERO_BYTES = 64 * 1024;
constexpr size_t WS_CS = 1 * MiB;
constexpr size_t WS_WRT = 3 * MiB;
constexpr size_t WS_RR = 3 * MiB + 512 * 1024;
constexpr size_t WS_WTS = 3 * MiB + 640 * 1024;
constexpr size_t WS_STATS = 3 * MiB + 768 * 1024;
constexpr size_t WS_LIST = 4 * MiB;
constexpr size_t WS_WINT = 8 * MiB;
constexpr size_t WS_WOUTT = 76 * MiB;
constexpr size_t WS_WGT = 108 * MiB;
constexpr size_t WS_WPT = 140 * MiB;
constexpr size_t WS_PB = 142 * MiB;
constexpr size_t WS_WGUT = 146 * MiB;
constexpr size_t WS_WDT = 402 * MiB;
constexpr size_t WS_XB = 530 * MiB;
constexpr size_t WS_QKV = 594 * MiB;
constexpr size_t WS_XG = 530 * MiB;
constexpr size_t WS_Y1B = 594 * MiB;
constexpr size_t WS_Y2B = 658 * MiB;
constexpr size_t WS_O = 730 * MiB;
constexpr size_t WS_H = 730 * MiB;
constexpr size_t WS_X1B = 794 * MiB;
constexpr size_t WS_PP = 858 * MiB;
constexpr size_t WS_MOE = 922 * MiB;
constexpr size_t WS_END = 1050 * MiB;
constexpr int MPAD_MAX = 24576;
constexpr int CW_TMO = 0, CW_CODE = 1;
constexpr int CW_BAR = 4096;
constexpr int CW_CNT = 8192;
constexpr int CW_DONE = 12352;
constexpr int CW_Q = 12288;
static_assert((CW_CNT + 64 * NEXP) * 4 <= (int)CTL_ZERO_BYTES, "CTL words inside the memset region");
constexpr int CW_READY = 16384 + 64;

constexpr int RING_OFF = 0, RING_BYTES = 131072;
constexpr int LDS_BYTES = 163840;
constexpr int MISC_OFF = LDS_BYTES - 1024;
constexpr int TAB_OFF = MISC_OFF + 256;
constexpr int ATT_VIMG = 16384, ATT_RED = 131072, ATT_G = 133120;
constexpr int LN_ROWB = 8208, LN_RED = 131328, LN_LOG = 155904;
static_assert(LN_LOG + 3072 + 192 <= MISC_OFF && ATT_RED + 2048 <= ATT_G && ATT_G + 16384 <= MISC_OFF, "LDS map");

#define GAS __attribute__((address_space(1)))
#define LAS __attribute__((address_space(3)))
typedef unsigned short bf16;
typedef unsigned v4u __attribute__((ext_vector_type(4)));
typedef unsigned v2u __attribute__((ext_vector_type(2)));
typedef float f32x4 __attribute__((ext_vector_type(4)));
typedef float f32x2 __attribute__((ext_vector_type(2)));
typedef float f32x16 __attribute__((ext_vector_type(16)));
typedef short bf16x8 __attribute__((ext_vector_type(8)));
typedef short s16x4 __attribute__((ext_vector_type(4)));
typedef GAS unsigned gu32;
#define RLX_AGENT __ATOMIC_RELAXED, __HIP_MEMORY_SCOPE_AGENT
#define LDS_WAIT() asm volatile("s_waitcnt lgkmcnt(0)" ::: "memory")
#define VM_WAIT() asm volatile("s_waitcnt vmcnt(0)" ::: "memory")
#define MFMA32(a, b, c) __builtin_amdgcn_mfma_f32_32x32x16_bf16((a), (b), (c), 0, 0, 0)
#define MFMA16(a, b, c) __builtin_amdgcn_mfma_f32_16x16x32_bf16((a), (b), (c), 0, 0, 0)
using pg8::cvt_pk_bf16;
using pg8::LOG2E;
using pg8::OKS;
__device__ __forceinline__ float bf2f(unsigned short b) { return __uint_as_float(((unsigned)b) << 16); }

#define XB_TMO      128
#define XB_XCNT(j)  (256  + 64 * (j))
#define XB_XSUB(j)  (1280 + 64 * (j))
#define XB_XGEN(j)  (2304 + 64 * (j))
#define XB_TOP      3328
#define XB_TOPGEN   3392
#define XCD_BAR_WORDS 3456
#define XB_SPIN_CAP (1u << 18)

__device__ __forceinline__ unsigned xb_ld(unsigned* p)              { return __hip_atomic_load(p, __ATOMIC_RELAXED, __HIP_MEMORY_SCOPE_AGENT); }
__device__ __forceinline__ unsigned xb_add(unsigned* p, unsigned v) { return __hip_atomic_fetch_add(p, v, __ATOMIC_RELAXED, __HIP_MEMORY_SCOPE_AGENT); }
__device__ __forceinline__ unsigned xb_xcc_id() { return (unsigned)__builtin_amdgcn_s_getreg((3 << 11) | 20) & 0xFu; }
#define XB_SPIN(cond, bar) do { unsigned _sp = 0; while (cond) { __builtin_amdgcn_s_sleep(1); \
    if ((++_sp & 255u) == 0u) { if (xb_ld(&(bar)[XB_TMO])) break; if (_sp > XB_SPIN_CAP) { atomicAdd(&(bar)[XB_TMO], 1u); break; } } } } while (0)

struct XcdBarrier {
    unsigned* bar; unsigned x;
    volatile LAS unsigned* st;
};

__device__ __forceinline__ XcdBarrier xcd_barrier_post(unsigned* bar, volatile LAS unsigned* st, bool lead) {
    XcdBarrier b; b.bar = bar; b.x = xb_xcc_id(); b.st = st;
    if (lead) (void)xb_add(&bar[XB_XCNT(b.x)], 1u);
    return b;
}
__device__ __forceinline__ void xcd_barrier_complete(unsigned* bar, unsigned x, unsigned& nloc, unsigned& nx) {
    const unsigned G = gridDim.x * gridDim.y * gridDim.z;
    unsigned sum, cnt, mine, sp = 0u;
    for (;;) {
        sum = 0u; cnt = 0u; mine = 0u;
#pragma unroll
        for (unsigned j = 0; j < 16; ++j) { const unsigned c = xb_ld(&bar[XB_XCNT(j)]); sum += c; cnt += (c > 0u) ? 1u : 0u; mine = (j == x) ? c : mine; }
        if (sum == G) break;
        __builtin_amdgcn_s_sleep(1);
        if ((++sp & 255u) == 0u) { if (xb_ld(&bar[XB_TMO])) break; if (sp > XB_SPIN_CAP) { atomicAdd(&bar[XB_TMO], 1u); break; } }
    }
    nloc = mine > 0u ? mine : 1u; nx = cnt > 0u ? cnt : 1u;
}

__device__ __forceinline__ void xcd_barrier(const XcdBarrier& b, bool lead) {
    asm volatile("s_waitcnt vmcnt(0)" ::: "memory");
    __syncthreads();
    if (lead) {
        unsigned* bar = b.bar;
        __builtin_amdgcn_s_waitcnt(0);
        unsigned nloc = b.st[0], nx = b.st[1];
        if (nloc == 0u) { xcd_barrier_complete(bar, b.x, nloc, nx); b.st[0] = nloc; b.st[1] = nx; }
        const unsigned old = xb_add(&bar[XB_XSUB(b.x)], 1u);
        const unsigned gen = old / nloc;
        if (old + 1u == (gen + 1u) * nloc) {
            __builtin_amdgcn_fence(__ATOMIC_RELEASE, "agent");
            asm volatile("s_waitcnt vmcnt(0)" ::: "memory");
            const unsigned og = xb_add(&bar[XB_TOP], 1u);
            const unsigned tg = og / nx;
            if (og + 1u == (tg + 1u) * nx) xb_add(&bar[XB_TOPGEN], 1u);
            else XB_SPIN(xb_ld(&bar[XB_TOPGEN]) == tg, bar);
            __builtin_amdgcn_fence(__ATOMIC_ACQUIRE, "agent");
            xb_add(&bar[XB_XGEN(b.x)], 1u);
            asm volatile("s_waitcnt vmcnt(0)" ::: "memory");
        } else {
            XB_SPIN(xb_ld(&bar[XB_XGEN(b.x)]) == gen, bar);
            __builtin_amdgcn_fence(__ATOMIC_ACQUIRE, "agent");
            asm volatile("s_waitcnt vmcnt(0)" ::: "memory");
        }
    }
    __syncthreads();
}

struct Frame {
    LAS unsigned char* lds;
    volatile LAS unsigned* MISC;
    gu32* ctl;
    int tid, lane, wave, wave0;
    int vcu, G;
    const float *x, *p; const int* positions;
    const float *w_in, *b_in, *sinks, *g_a, *g_b, *w_out, *b_out, *ln1_g, *ln1_b, *w_group, *b_group, *w_er, *b_er, *w_gate, *w_up, *w_down, *w_pg, *b_pg, *w_pp, *ln2_g, *ln2_b;
    float* out;
    float *cs, *rr, *wts, *stats; int* list;
    bf16 *WrT, *WinT, *WoutT, *WpT, *PB, *XB, *QKV, *XG, *O, *PP, *MOE, *Y1B, *Y2B;
    unsigned char *Wg8, *Wgu8, *Wd8, *X18, *H8;
};

__device__ __forceinline__ float wave_sum(float v) {
#pragma unroll
    for (int o = 1; o < 64; o <<= 1) v += __shfl_xor(v, o);
    return v;
}
__device__ __forceinline__ f32x2 pair32(float v) { auto r = __builtin_amdgcn_permlane32_swap(__float_as_uint(v), __float_as_uint(v), false, false); return (f32x2){__uint_as_float(r[0]), __uint_as_float(r[1])}; }


__device__ __forceinline__ int hw_lane() { int l; asm volatile("v_mbcnt_lo_u32_b32 %0, -1, 0\n\tv_mbcnt_hi_u32_b32 %0, -1, %0" : "=v"(l)); return l; }
struct Args { const void* in[24]; float* out; unsigned char* ws; int ph_lo, ph_hi; };
typedef __attribute__((address_space(4))) const Args CArgs;
__device__ __forceinline__ void fill_ptrs(Frame& F) {
    CArgs* ap = (CArgs*)__builtin_amdgcn_kernarg_segment_ptr();
    asm volatile("" : "+s"(ap));
    { int t = F.wave0 * 64 + hw_lane(); asm volatile("" : "+v"(t)); F.tid = t; F.lane = t & 63; F.wave = __builtin_amdgcn_readfirstlane(t >> 6); }
    unsigned char* ws = ap->ws;
    F.x = (const float*)ap->in[0]; F.p = (const float*)ap->in[1]; F.positions = (const int*)ap->in[2];
    F.w_in = (const float*)ap->in[3]; F.b_in = (const float*)ap->in[4]; F.sinks = (const float*)ap->in[5]; F.g_a = (const float*)ap->in[6]; F.g_b = (const float*)ap->in[7];
    F.w_out = (const float*)ap->in[8]; F.b_out = (const float*)ap->in[9]; F.ln1_g = (const float*)ap->in[10]; F.ln1_b = (const float*)ap->in[11];
    F.w_group = (const float*)ap->in[12]; F.b_group = (const float*)ap->in[13]; F.w_er = (const float*)ap->in[14]; F.b_er = (const float*)ap->in[15];
    F.w_gate = (const float*)ap->in[16]; F.w_up = (const float*)ap->in[17]; F.w_down = (const float*)ap->in[18];
    F.w_pg = (const float*)ap->in[19]; F.b_pg = (const float*)ap->in[20]; F.w_pp = (const float*)ap->in[21]; F.ln2_g = (const float*)ap->in[22]; F.ln2_b = (const float*)ap->in[23];
    F.out = ap->out;
    F.ctl = (gu32*)(ws + WS_CTL);
    F.cs = (float*)(ws + WS_CS); F.rr = (float*)(ws + WS_RR); F.wts = (float*)(ws + WS_WTS); F.stats = (float*)(ws + WS_STATS); F.list = (int*)(ws + WS_LIST);
    F.WrT = (bf16*)(ws + WS_WRT); F.WinT = (bf16*)(ws + WS_WINT); F.WoutT = (bf16*)(ws + WS_WOUTT); F.Wg8 = ws + WS_WGT; F.WpT = (bf16*)(ws + WS_WPT); F.PB = (bf16*)(ws + WS_PB);
    F.Wgu8 = ws + WS_WGUT; F.Wd8 = ws + WS_WDT; F.XB = (bf16*)(ws + WS_XB); F.QKV = (bf16*)(ws + WS_QKV); F.XG = (bf16*)(ws + WS_XG);
    F.O = (bf16*)(ws + WS_O); F.H8 = ws + WS_H; F.X18 = ws + WS_X1B; F.PP = (bf16*)(ws + WS_PP); F.MOE = (bf16*)(ws + WS_MOE); F.Y1B = (bf16*)(ws + WS_Y1B); F.Y2B = (bf16*)(ws + WS_Y2B);
}

struct CvItem { const float* src; bf16* dst; int N, K, f8; };
__device__ __forceinline__ void cv_load(const CvItem& d, f32x4 (&v)[16], int lane) {
    if (d.f8) {
#pragma unroll
        for (int ii = 0; ii < 4; ++ii)
#pragma unroll
            for (int jj = 0; jj < 4; ++jj) v[4 * ii + jj] = *(const GAS f32x4*)(d.src + (size_t)(4 * ((lane >> 3) + 8 * ii) + jj) * d.N + 4 * (lane & 7));
        return; }
#pragma unroll
    for (int i = 0; i < 8; ++i) { const float* p = d.src + (size_t)(2 * ((lane >> 4) + 4 * i)) * d.N + 4 * (lane & 15);
        v[2 * i] = *(const GAS f32x4*)p; v[2 * i + 1] = *(const GAS f32x4*)(p + d.N); }
}
__device__ __forceinline__ void cv_finish(const CvItem& d, const f32x4 (&v)[16], LAS float* scrf, int lane) {
    LAS unsigned* scr = (LAS unsigned*)scrf;
    if (d.f8) {
#pragma unroll
        for (int ii = 0; ii < 4; ++ii) { LAS unsigned* p = scr + ((lane >> 3) + 8 * ii) * 33 + 4 * (lane & 7);
#pragma unroll
            for (int cc = 0; cc < 4; ++cc) p[cc] = pg8::cvt_pk_fp8x4(v[4 * ii][cc] * 64.0f, v[4 * ii + 1][cc] * 64.0f, v[4 * ii + 2][cc] * 64.0f, v[4 * ii + 3][cc] * 64.0f); }
        LDS_WAIT(); asm volatile("" ::: "memory");
        const int ch = lane & 7;
#pragma unroll
        for (int j = 0; j < 4; ++j) { const int n = (lane >> 3) + 8 * j; const LAS unsigned* sp = scr + (4 * ch) * 33 + n;
            v4u o; o.x = sp[0 * 33]; o.y = sp[1 * 33]; o.z = sp[2 * 33]; o.w = sp[3 * 33];
            *(GAS v4u*)((unsigned char*)d.dst + (size_t)n * d.K + 16 * ch) = o; }
        LDS_WAIT(); asm volatile("" ::: "memory");
        return; }
#pragma unroll
    for (int i = 0; i < 8; ++i) { LAS unsigned* p = scr + ((lane >> 4) + 4 * i) * 65 + 4 * (lane & 15);
#pragma unroll
        for (int j = 0; j < 4; ++j) p[j] = cvt_pk_bf16(v[2 * i][j], v[2 * i + 1][j]); }
    LDS_WAIT(); asm volatile("" ::: "memory");
    const int c = lane & 7;
#pragma unroll
    for (int j = 0; j < 8; ++j) { const int n = (lane >> 3) + 8 * j; const LAS unsigned* s = scr + (4 * c) * 65 + n;
        v4u o; o.x = s[0 * 65]; o.y = s[1 * 65]; o.z = s[2 * 65]; o.w = s[3 * 65];
        *(GAS v4u*)(d.dst + (size_t)n * d.K + 8 * c) = o; }
    LDS_WAIT(); asm volatile("" ::: "memory");
}
__device__ const double ROPE_INV_FREQ[32] = {1.0, 0.7498942093324559, 0.5623413251903491, 0.4216965034285822, 0.31622776601683794, 0.23713737056616552, 0.1778279410038923, 0.1333521432163324,
    0.1, 0.07498942093324558, 0.05623413251903491, 0.042169650342858224, 0.03162277660168379, 0.023713737056616554, 0.01778279410038923, 0.01333521432163324,
    0.01, 0.007498942093324558, 0.005623413251903491, 0.004216965034285823, 0.0031622776601683794, 0.0023713737056616554, 0.0017782794100389228, 0.001333521432163324,
    0.001, 0.0007498942093324559, 0.0005623413251903491, 0.00042169650342858224, 0.00031622776601683794, 0.00023713737056616554, 0.00017782794100389227, 0.0001333521432163324};

constexpr int I_IN = (DM / 64) * (NIN / 64), I_SQ = (DM / 64) * (DM / 64), I_PP = (PLE / 64) * (DM / 64);
constexpr int I_GU = (DM / 64) * (DEXP / 64), I_DN = (DEXP / 64) * (DM / 64);
constexpr int I_A = I_IN + I_PP, NITEMS = I_A + 2 * I_SQ + NEXP * (2 * I_GU + I_DN);
constexpr int QCHUNK = 16, NCHUNK = (NITEMS - I_A + QCHUNK - 1) / QCHUNK;
__device__ __forceinline__ CvItem cv_decode(const Frame& F, int it) {
    int r = it; CvItem d;
#define CV_SET(W, Kk, Nn, WT, nb, drow) do { const int kb_ = r / (nb), n0_ = 64 * (r % (nb)); d.src = (W) + (size_t)(64 * kb_) * (Nn) + n0_; d.dst = (WT) + (size_t)(drow) * (Kk) + 64 * kb_; d.N = (Nn); d.K = (Kk); d.f8 = 0; } while (0)
#define CV_SET8(W, Kk, Nn, WT8, nb, drow) do { const int kb_ = r / (nb), n0_ = 32 * (r % (nb)); d.src = (W) + (size_t)(128 * kb_) * (Nn) + n0_; d.dst = (bf16*)((WT8) + (size_t)(drow) * (Kk) + 128 * kb_); d.N = (Nn); d.K = (Kk); d.f8 = 1; } while (0)
    if (r < I_IN) { CV_SET(F.w_in, DM, NIN, F.WinT, NIN / 64, (size_t)n0_); return d; } r -= I_IN;
    if (r < I_PP) { CV_SET(F.w_pp, PLE, DM, F.WpT, DM / 64, (size_t)n0_); return d; } r -= I_PP;
    if (r < OKS) { CV_SET(F.w_out, pg8::ORB / 2, DM, F.WoutT, DM / 64, (size_t)n0_); return d; }
    if (r < I_SQ) { r -= OKS; CV_SET8(F.w_out + (size_t)OKS * DM, pg8::ORB, DM, (unsigned char*)F.WoutT + 2 * OKS, DM / 32, (size_t)n0_); return d; }
    r -= I_SQ;
    if (r < I_SQ) { CV_SET8(F.w_pg, DM, DM, F.Wg8, DM / 32, (size_t)n0_); return d; } r -= I_SQ;
    const int e = r / (2 * I_GU + I_DN); r -= e * (2 * I_GU + I_DN);
    if (r < 2 * I_GU) { const int up = r >= I_GU; if (up) r -= I_GU;
        CV_SET8((up ? F.w_up : F.w_gate) + (size_t)e * DM * DEXP, DM, DEXP, F.Wgu8, DEXP / 32, (size_t)e * 1024 + (size_t)(n0_ >> 7) * 256 + (up ? 128 : 0) + (n0_ & 127)); return d; }
    r -= 2 * I_GU;
    CV_SET8(F.w_down + (size_t)e * DEXP * DM, DEXP, DM, F.Wd8, DM / 32, (size_t)e * DM + n0_); return d;
#undef CV_SET
#undef CV_SET8
}
__device__ __forceinline__ void cv_run(const Frame& F, int first, int stride, int end, LAS float* scr) {
    if (first >= end) return;
    CvItem cur = cv_decode(F, first); f32x4 va[16], vb[16];
    cv_load(cur, va, F.lane);
    for (int it = first; it < end; it += stride) {
        const bool more = it + stride < end; CvItem nxt = cur;
        if (more) { nxt = cv_decode(F, it + stride); cv_load(nxt, vb, F.lane); }
        cv_finish(cur, va, scr, F.lane);
        cur = nxt;
#pragma unroll
        for (int i = 0; i < 16; ++i) va[i] = vb[i];
    }
}
__device__ __forceinline__ void conv_queue(Frame& F) {
    LAS float* scr = (LAS float*)(F.lds + RING_OFF + F.wave * 16384);
    constexpr int IPW = QCHUNK / NWAVES;
    __syncthreads();
    if (F.tid == 0) F.MISC[16] = __hip_atomic_fetch_add(F.ctl + CW_Q, 1u, RLX_AGENT);
    __syncthreads();
    int ch = (int)F.MISC[16], slot = 0, k = 0;
    if (ch >= NCHUNK) return;
    if (F.tid == 0) F.MISC[17] = __hip_atomic_fetch_add(F.ctl + CW_Q, 1u, RLX_AGENT);
#define CV_NEXT(dst) do { if (k == IPW) { __syncthreads(); slot ^= 1; ch = (int)F.MISC[16 + slot]; k = 0; \
            if (F.tid == 0 && ch < NCHUNK) F.MISC[16 + (slot ^ 1)] = __hip_atomic_fetch_add(F.ctl + CW_Q, 1u, RLX_AGENT); } \
        dst = (ch < NCHUNK) ? I_A + ch * QCHUNK + F.wave * IPW + k : -1; ++k; } while (0)
    int it0; CV_NEXT(it0);
    CvItem cur = cv_decode(F, it0); f32x4 va[16], vb[16];
    cv_load(cur, va, F.lane);
    for (;;) {
        int it1; CV_NEXT(it1);
        CvItem nxt = cur;
        if (it1 >= 0) { nxt = cv_decode(F, it1); cv_load(nxt, vb, F.lane); }
        cv_finish(cur, va, scr, F.lane);
        if (it1 < 0) break;
        cur = nxt;
#pragma unroll
        for (int i = 0; i < 16; ++i) va[i] = vb[i];
    }
    __syncthreads();
#undef CV_NEXT
}
__device__ __forceinline__ void p0_prologue(Frame& F) {
    LAS float* scr = (LAS float*)(F.lds + RING_OFF + F.wave * 16384);
    const int gw = F.vcu * NWAVES + F.wave, NGW = F.G * NWAVES;
    cv_run(F, gw, NGW, I_A, scr);
    const int gt = gw * 64 + F.lane, NGT = NGW * 64;
    for (int idx = gt; idx < NRT * DM; idx += NGT) { const int c = idx / DM, k = idx - c * DM; float v = 0.f;
        if (c < 4) v = F.w_group[(size_t)k * 4 + c]; else if (c < 36) v = F.w_er[((size_t)((c - 4) >> 3) * DM + k) * 8 + ((c - 4) & 7)];
        F.WrT[idx] = (bf16)(cvt_pk_bf16(v, 0.f) & 0xffffu); }
    for (size_t i = gt; i < (size_t)M * DM / 8; i += NGT) { const f32x4 a = *(const f32x4*)(F.x + 8 * i), b = *(const f32x4*)(F.x + 8 * i + 4);
        v4u o; o.x = cvt_pk_bf16(a[0], a[1]); o.y = cvt_pk_bf16(a[2], a[3]); o.z = cvt_pk_bf16(b[0], b[1]); o.w = cvt_pk_bf16(b[2], b[3]); *(GAS v4u*)(F.XB + 8 * i) = o; }
    for (size_t i = gt; i < (size_t)M * PLE / 8; i += NGT) { const f32x4 a = *(const f32x4*)(F.p + 8 * i), b = *(const f32x4*)(F.p + 8 * i + 4);
        v4u o; o.x = cvt_pk_bf16(a[0], a[1]); o.y = cvt_pk_bf16(a[2], a[3]); o.z = cvt_pk_bf16(b[0], b[1]); o.w = cvt_pk_bf16(b[2], b[3]); *(GAS v4u*)(F.PB + 8 * i) = o; }
    for (int idx = gt; idx < M * 32; idx += NGT) { const int m = idx >> 5, pr = idx & 31;
        const float ang = (float)F.positions[m] * (float)ROPE_INV_FREQ[pr];
        const double rev = (double)ang * 0.15915494309189535; const float fr = (float)(rev - __builtin_floor(rev));
        F.cs[2 * (size_t)idx] = __builtin_amdgcn_cosf(fr); F.cs[2 * (size_t)idx + 1] = __builtin_amdgcn_sinf(fr); }
}

__device__ __forceinline__ int crow(int r, int hi) { return (r & 3) + 8 * (r >> 2) + 4 * hi; }
__device__ __forceinline__ s16x4 tr_read(const LAS unsigned char* p) {
    typedef short v4i16_t __attribute__((ext_vector_type(4)));
    return __builtin_bit_cast(s16x4, __builtin_amdgcn_ds_read_tr16_b64_v4i16((LAS v4i16_t*)p)); }
__device__ __forceinline__ bf16x8 pack8(const f32x16& x, int s) {
    v4u p; p.x = cvt_pk_bf16(x[8 * s], x[8 * s + 1]); p.y = cvt_pk_bf16(x[8 * s + 2], x[8 * s + 3]); p.z = cvt_pk_bf16(x[8 * s + 4], x[8 * s + 5]); p.w = cvt_pk_bf16(x[8 * s + 6], x[8 * s + 7]);
    return __builtin_bit_cast(bf16x8, p); }

#define GLDS16(gptr, ldsptr) __builtin_amdgcn_global_load_lds((const unsigned*)(gptr), (LAS unsigned*)(ldsptr), 16, 0, 0)
#define ATT_WAIT_V(n) asm volatile("s_waitcnt vmcnt(" #n ")" ::: "memory")
#define ATT_WAIT_L() asm volatile("s_waitcnt lgkmcnt(0)" ::: "memory")
template <int NDQ>
__device__ __forceinline__ void att_issue(const unsigned char* base, unsigned loff, LAS unsigned char* img) {
#pragma unroll
    for (int kh = 0; kh < 2; ++kh)
#pragma unroll
        for (int dq = 0; dq < NDQ; ++dq) GLDS16(base + (size_t)kh * (16 * NIN * 2) + dq * 64 + loff, img + (kh * NDQ + dq) * 1024);
}

#define SB_ISSUE(KF, b, key0) do { const bf16* kr_ = kbase + (size_t)(key0) * NIN; \
    _Pragma("unroll") for (int s = 0; s < 8; ++s) KF[s] = *(const bf16x8*)(kr_ + 16 * s); \
    att_issue<4>(vg + (size_t)(key0) * (NIN * 2), voff, vimg + (b) * 8192); } while (0)
#define SB_TILE(KF, b, k0, NEXT) do { \
        f32x16 z; \
        _Pragma("unroll") for (int i = 0; i < 16; ++i) z[i] = 0.f; \
        _Pragma("unroll") for (int s = 0; s < 8; ++s) z = MFMA32(KF[s], qf[s], z); \
        const int cdiag = ((k0) == s0) ? c : 64;                            \
        float L[16], G[4]; \
        _Pragma("unroll") for (int i = 0; i < 16; ++i) { const float z2 = z[i], e = __builtin_amdgcn_exp2f(-__builtin_fabsf(z2)); \
            float l = __builtin_fmaxf(z2, 0.f) + __builtin_amdgcn_logf(1.0f + e);         \
            if (crow(i, hh) >= cdiag) l = 0.f;                                                 \
            L[i] = l; } \
        _Pragma("unroll") for (int g = 0; g < 4; ++g) G[g] = (L[4 * g] + L[4 * g + 1]) + (L[4 * g + 2] + L[4 * g + 3]); \
        f32x2 GP[4]; \
        _Pragma("unroll") for (int g = 0; g < 4; ++g) GP[g] = pair32(G[g]);                                   \
        float after[4]; float tail = 0.f;                                                   \
        _Pragma("unroll") for (int g = 3; g >= 0; --g) { after[g] = tail + (hh ? 0.f : GP[g].y); tail += GP[g].x + GP[g].y; } \
        f32x16 pt; \
        _Pragma("unroll") for (int g = 0; g < 4; ++g) { float run = carry + after[g]; \
            _Pragma("unroll") for (int u = 3; u >= 0; --u) { const int i = 4 * g + u; run += L[i]; \
                float a = __builtin_amdgcn_exp2f(z[i] - run); \
                if (crow(i, hh) >= cdiag) a = 0.f; \
                pt[i] = a; } } \
        carry += tail; \
        if (NEXT) ATT_WAIT_V(16); else ATT_WAIT_V(0);                       \
        const LAS unsigned char* vb = vimg + (b) * 8192 + trb; \
        _Pragma("unroll") for (int s2 = 0; s2 < 2; ++s2) { const bf16x8 pb = pack8(pt, s2); \
            _Pragma("unroll") for (int db = 0; db < 4; ++db) { \
                const s16x4 lo = tr_read(vb + (s2 * 4 + db) * 1024), hi = tr_read(vb + (s2 * 4 + db) * 1024 + 512); \
                const bf16x8 va = __builtin_shufflevector(lo, hi, 0, 1, 2, 3, 4, 5, 6, 7); \
                o[db] = MFMA32(va, pb, o[db]); } } \
    } while (0)
__device__ __forceinline__ float sb_head(const Frame& F, int m0, int s0, int h, LAS unsigned char* vimg, const LAS float* gl) {
    int lane_ = F.lane; asm volatile("" : "+v"(lane_));
    const int lane = lane_, c = lane & 31, hh = lane >> 5;
    const bf16* qrow = F.QKV + (size_t)(m0 + c) * NIN + QB0 + h * 128 + 8 * hh;
    bf16x8 qf[8];
#pragma unroll
    for (int s = 0; s < 8; ++s) qf[s] = *(const bf16x8*)(qrow + 16 * s);
    f32x16 o[4];
#pragma unroll
    for (int d = 0; d < 4; ++d)
#pragma unroll
        for (int i = 0; i < 16; ++i) o[d][i] = 0.f;
    float carry = 0.f;
    const int rowbase = m0 - s0;
    const int q4 = (lane & 15) >> 2, p4 = lane & 3, g1 = (lane >> 4) & 1;
    const int trb = (4 * hh + q4) * 64 + (16 * g1 + 4 * p4) * 2;
    const unsigned voff = (unsigned)((lane >> 2) * (NIN * 2) + (lane & 3) * 16);
    const bf16* kbase = F.QKV + (size_t)(rowbase + c) * NIN + KB0 + h * 128 + 8 * hh;
    const unsigned char* vg = (const unsigned char*)(F.QKV + (size_t)rowbase * NIN + VB0 + h * 128);
    int kt = s0 >> 5;
    bf16x8 kf[8], kn[8];
    SB_ISSUE(kf, 0, kt * 32);
    if (kt > 0) SB_ISSUE(kn, 1, kt * 32 - 32);
    for (;;) {
        SB_TILE(kf, 0, kt * 32, kt > 0);
        if (kt == 0 || __all(carry > SB_STOP)) break;
        if (kt >= 2) { ATT_WAIT_L(); SB_ISSUE(kf, 0, kt * 32 - 64); }
        --kt;
        SB_TILE(kn, 1, kt * 32, kt > 0);
        if (kt == 0 || __all(carry > SB_STOP)) break;
        if (kt >= 2) { ATT_WAIT_L(); SB_ISSUE(kn, 1, kt * 32 - 64); }
        --kt;
    }
    ATT_WAIT_V(0);
    ATT_WAIT_L();
    float ssq = 0.f;
    LAS unsigned char* ot = vimg;
    const LAS float* gp = gl + 2048 + h * 128;
    const int OCOL = 2048 + h * 128;
#pragma unroll
    for (int db = 0; db < 4; ++db)
#pragma unroll
        for (int g = 0; g < 4; ++g) { const int d0 = 32 * db + 8 * g + 4 * hh; const f32x4 gv = *(const LAS f32x4*)(gp + d0);
            const float a0 = o[db][4 * g], a1 = o[db][4 * g + 1], a2 = o[db][4 * g + 2], a3 = o[db][4 * g + 3];
            ssq += (a0 * a0 + a1 * a1) + (a2 * a2 + a3 * a3);
            if (OCOL >= OKS) *(LAS unsigned*)(ot + c * 144 + d0) = pg8::cvt_pk_fp8x4(a0 * gv[0] * 8.0f, a1 * gv[1] * 8.0f, a2 * gv[2] * 8.0f, a3 * gv[3] * 8.0f);
            else { v2u w; w.x = cvt_pk_bf16(a0 * gv[0], a1 * gv[1]); w.y = cvt_pk_bf16(a2 * gv[2], a3 * gv[3]); *(LAS v2u*)(ot + c * 272 + d0 * 2) = w; } }
    asm volatile("" ::: "memory");
    if (OCOL >= OKS) { unsigned char* ob = (unsigned char*)F.O + (size_t)(m0 + (lane >> 3)) * pg8::ORB + (2 * OKS + OCOL - OKS) + (lane & 7) * 16;
#pragma unroll
      for (int k = 0; k < 4; ++k) { const v4u val = *(const LAS v4u*)(ot + (8 * k + (lane >> 3)) * 144 + (lane & 7) * 16); *(GAS v4u*)(ob + (size_t)(8 * k) * pg8::ORB) = val; } }
    else { unsigned char* ob = (unsigned char*)F.O + (size_t)(m0 + (lane >> 4)) * pg8::ORB + 2 * OCOL + (lane & 15) * 16;
#pragma unroll
      for (int k = 0; k < 8; ++k) { const v4u val = *(const LAS v4u*)(ot + (4 * k + (lane >> 4)) * 272 + (lane & 15) * 16); *(GAS v4u*)(ob + (size_t)(4 * k) * pg8::ORB) = val; } }
    ATT_WAIT_L();
    const f32x2 sp = pair32(ssq);
    return sp.x + sp.y;
}

__device__ __forceinline__ float swa_pair(const Frame& F, int m0, int s0, int hq, LAS unsigned char* vimg, const LAS float* gl) {
    int lane_ = F.lane; asm volatile("" : "+v"(lane_));
    const int lane = lane_, c = lane & 31, hh = lane >> 5, kvh = hq >> 3;
    LAS unsigned char* kimg = vimg + 8192;
    const bf16* qrow = F.QKV + (size_t)(m0 + c) * NIN + QA0 + hq * 64 + 8 * hh;
    bf16x8 qa[4], qb[4];
#pragma unroll
    for (int s = 0; s < 4; ++s) { qa[s] = *(const bf16x8*)(qrow + 16 * s); qb[s] = *(const bf16x8*)(qrow + 64 + 16 * s); }
    f32x16 oa[2], ob[2];
#pragma unroll
    for (int d = 0; d < 2; ++d)
#pragma unroll
        for (int i = 0; i < 16; ++i) { oa[d][i] = 0.f; ob[d][i] = 0.f; }
    float mxa = F.sinks[hq] * LOG2E, mxb = F.sinks[hq + 1] * LOG2E, la = 1.0f, lb = 1.0f;
    const int rowbase = m0 - s0;
    const int q4 = (lane & 15) >> 2, p4 = lane & 3, g1 = (lane >> 4) & 1;
    const int trb = (4 * hh + q4) * 64 + (16 * g1 + 4 * p4) * 2;
    const unsigned voff = (unsigned)((lane >> 2) * (NIN * 2) + (lane & 3) * 16);
    const unsigned koff = (unsigned)((lane >> 2) * (NIN * 2) + (((lane & 3) ^ ((lane >> 4) & 3)) * 16));
    const unsigned char* kg = (const unsigned char*)(F.QKV + (size_t)rowbase * NIN + KA0 + kvh * 64);
    const unsigned char* vg = (const unsigned char*)(F.QKV + (size_t)rowbase * NIN + VA0 + kvh * 64);
    const int x4 = (c >> 2) & 3;
    const int kr0 = (c >> 4) * 2048 + (c & 15) * 64 + ((hh ^ x4) << 4), kr1 = (c >> 4) * 2048 + (c & 15) * 64 + (((2 + hh) ^ x4) << 4);
    int j = (s0 >= 128) ? 0 : (128 - s0) >> 5;
#define SWA_ISSUE(jj) do { const ptrdiff_t ko_ = (ptrdiff_t)(s0 - 128 + 32 * (jj)) * (NIN * 2); const int b_ = ((jj) & 1) * 4096; \
        att_issue<2>(kg + ko_, koff, kimg + b_); att_issue<2>(vg + ko_, voff, vimg + b_); } while (0)
    SWA_ISSUE(j);
    if (j < 4) SWA_ISSUE(j + 1);
#pragma unroll 1
    for (; j < 5; ++j) {
        const int bo = (j & 1) * 4096;
        if (j < 4) ATT_WAIT_V(8); else ATT_WAIT_V(0);
        bf16x8 kf[4];
#pragma unroll
        for (int s = 0; s < 4; ++s) kf[s] = *(const LAS bf16x8*)(kimg + bo + ((s & 1) ? kr1 : kr0) + (s >> 1) * 1024);
        f32x16 za, zb;
#pragma unroll
        for (int i = 0; i < 16; ++i) { za[i] = 0.f; zb[i] = 0.f; }
#pragma unroll
        for (int s = 0; s < 4; ++s) { za = MFMA32(kf[s], qa[s], za); zb = MFMA32(kf[s], qb[s], zb); }
        const int wlo = (j == 0) ? c : -1, whi = (j == 4) ? c : 64;
        float tma = -1e30f, tmb = -1e30f;
#pragma unroll
        for (int i = 0; i < 16; ++i) { const int r = crow(i, hh); if (r <= wlo || r > whi) { za[i] = -1e30f; zb[i] = -1e30f; }
            tma = __builtin_fmaxf(tma, za[i]); tmb = __builtin_fmaxf(tmb, zb[i]); }
        const f32x2 tpa = pair32(tma), tpb = pair32(tmb);
        const float mna = __builtin_fmaxf(mxa, __builtin_fmaxf(tpa.x, tpa.y)), ala = __builtin_amdgcn_exp2f(mxa - mna);
        const float mnb = __builtin_fmaxf(mxb, __builtin_fmaxf(tpb.x, tpb.y)), alb = __builtin_amdgcn_exp2f(mxb - mnb);
        f32x16 pa, pb; float psa = 0.f, psb = 0.f;
#pragma unroll
        for (int i = 0; i < 16; ++i) { pa[i] = __builtin_amdgcn_exp2f(za[i] - mna); psa += pa[i]; pb[i] = __builtin_amdgcn_exp2f(zb[i] - mnb); psb += pb[i]; }
        const f32x2 ppa = pair32(psa), ppb = pair32(psb);
        la = la * ala + (ppa.x + ppa.y); mxa = mna; lb = lb * alb + (ppb.x + ppb.y); mxb = mnb;
#pragma unroll
        for (int d = 0; d < 2; ++d)
#pragma unroll
            for (int i = 0; i < 16; ++i) { oa[d][i] *= ala; ob[d][i] *= alb; }
        const LAS unsigned char* vb = vimg + bo + trb;
#pragma unroll
        for (int s2 = 0; s2 < 2; ++s2) { const bf16x8 fa = pack8(pa, s2), fb = pack8(pb, s2);
#pragma unroll
            for (int db = 0; db < 2; ++db) {
                const s16x4 lo = tr_read(vb + (s2 * 2 + db) * 1024), hi = tr_read(vb + (s2 * 2 + db) * 1024 + 512);
                const bf16x8 va = __builtin_shufflevector(lo, hi, 0, 1, 2, 3, 4, 5, 6, 7);
                oa[db] = MFMA32(va, fa, oa[db]); ob[db] = MFMA32(va, fb, ob[db]); } }
        if (j < 3) { ATT_WAIT_L(); SWA_ISSUE(j + 2); }
    }
#undef SWA_ISSUE
    const float inva = 1.0f / la, invb = 1.0f / lb;
    ATT_WAIT_L();
    float ssq = 0.f;
    LAS unsigned char* ot = vimg;
    const LAS float* gp = gl + hq * 64;
    const int OCOL = hq * 64;
#pragma unroll
    for (int db = 0; db < 2; ++db)
#pragma unroll
        for (int g = 0; g < 4; ++g) { const int d0 = 32 * db + 8 * g + 4 * hh; const f32x4 gva = *(const LAS f32x4*)(gp + d0), gvb = *(const LAS f32x4*)(gp + 64 + d0);
            const float a0 = oa[db][4 * g] * inva, a1 = oa[db][4 * g + 1] * inva, a2 = oa[db][4 * g + 2] * inva, a3 = oa[db][4 * g + 3] * inva;
            const float b0 = ob[db][4 * g] * invb, b1 = ob[db][4 * g + 1] * invb, b2 = ob[db][4 * g + 2] * invb, b3 = ob[db][4 * g + 3] * invb;
            ssq += ((a0 * a0 + a1 * a1) + (a2 * a2 + a3 * a3)) + ((b0 * b0 + b1 * b1) + (b2 * b2 + b3 * b3));
            if (OCOL >= OKS) { *(LAS unsigned*)(ot + c * 144 + d0) = pg8::cvt_pk_fp8x4(a0 * gva[0] * 8.0f, a1 * gva[1] * 8.0f, a2 * gva[2] * 8.0f, a3 * gva[3] * 8.0f);
                *(LAS unsigned*)(ot + c * 144 + 64 + d0) = pg8::cvt_pk_fp8x4(b0 * gvb[0] * 8.0f, b1 * gvb[1] * 8.0f, b2 * gvb[2] * 8.0f, b3 * gvb[3] * 8.0f); }
            else { v2u w; w.x = cvt_pk_bf16(a0 * gva[0], a1 * gva[1]); w.y = cvt_pk_bf16(a2 * gva[2], a3 * gva[3]); *(LAS v2u*)(ot + c * 272 + d0 * 2) = w;
                v2u x; x.x = cvt_pk_bf16(b0 * gvb[0], b1 * gvb[1]); x.y = cvt_pk_bf16(b2 * gvb[2], b3 * gvb[3]); *(LAS v2u*)(ot + c * 272 + 128 + d0 * 2) = x; } }
    asm volatile("" ::: "memory");
    if (OCOL >= OKS) { unsigned char* obp = (unsigned char*)F.O + (size_t)(m0 + (lane >> 3)) * pg8::ORB + (2 * OKS + OCOL - OKS) + (lane & 7) * 16;
#pragma unroll
      for (int k = 0; k < 4; ++k) { const v4u val = *(const LAS v4u*)(ot + (8 * k + (lane >> 3)) * 144 + (lane & 7) * 16); *(GAS v4u*)(obp + (size_t)(8 * k) * pg8::ORB) = val; } }
    else { unsigned char* obp = (unsigned char*)F.O + (size_t)(m0 + (lane >> 4)) * pg8::ORB + 2 * OCOL + (lane & 15) * 16;
#pragma unroll
      for (int k = 0; k < 8; ++k) { const v4u val = *(const LAS v4u*)(ot + (4 * k + (lane >> 4)) * 272 + (lane & 15) * 16); *(GAS v4u*)(obp + (size_t)(4 * k) * pg8::ORB) = val; } }
    ATT_WAIT_L();
    const f32x2 sp = pair32(ssq);
    return sp.x + sp.y;
}

__device__ __forceinline__ void p2_attention(Frame& F) {
    LAS unsigned char* vimg = F.lds + F.wave * ATT_VIMG;
    LAS float* red = (LAS float*)(F.lds + ATT_RED);
    LAS float* gl = (LAS float*)(F.lds + ATT_G);
    { const int i4 = 4 * F.tid;
      *(LAS f32x4*)(gl + i4) = *(const f32x4*)(F.g_a + i4); *(LAS f32x4*)(gl + 2048 + i4) = *(const f32x4*)(F.g_b + i4); }
    __syncthreads();
    for (int u = F.vcu; u < M / 32; u += F.G) {
        const int m0 = 32 * u, s0 = m0 & (SEQ - 1);
        float sa = 0.f, sb = 0.f;
        if (F.wave >= 4) __builtin_amdgcn_s_setprio(1); else __builtin_amdgcn_s_setprio(0);
#pragma unroll 1
        for (int i = 0; i < 2; ++i) sa += swa_pair(F, m0, s0, 4 * F.wave + 2 * i, vimg, gl);
        if (F.wave >= 4) __builtin_amdgcn_s_setprio(0); else __builtin_amdgcn_s_setprio(1);
#pragma unroll 1
        for (int i = 0; i < 2; ++i) sb += sb_head(F, m0, s0, 2 * F.wave + i, vimg, gl);
        __builtin_amdgcn_s_setprio(0);
        if (F.lane < 32) { red[(F.wave * 32 + F.lane) * 2] = sa; red[(F.wave * 32 + F.lane) * 2 + 1] = sb; }
        __syncthreads();
        if (F.tid < 32) { float ta = 0.f, tb = 0.f;
#pragma unroll
            for (int w = 0; w < 8; ++w) { ta += red[(w * 32 + F.tid) * 2]; tb += red[(w * 32 + F.tid) * 2 + 1]; }
            F.rr[2 * (size_t)(m0 + F.tid)] = 1.0f / __builtin_sqrtf(ta * (1.0f / 2048.0f) + RMS_EPS);
            F.rr[2 * (size_t)(m0 + F.tid) + 1] = 1.0f / __builtin_sqrtf(tb * (1.0f / 2048.0f) + RMS_EPS); }
        __syncthreads();
    }
}

__device__ __forceinline__ void p4_ln1_router(Frame& F, float* x1dst, int cw_cnt) {
    LAS unsigned char* ximg = F.lds;
    LAS float* red = (LAS float*)(F.lds + LN_RED);
    LAS float* lg = (LAS float*)(F.lds + LN_LOG);
    LAS float* bt = (LAS float*)(F.lds + LN_LOG + 3072);
    const int lane = F.lane, w = F.wave;
    if (F.tid < NRT) bt[F.tid] = F.tid < 4 ? F.b_group[F.tid] : (F.tid < 36 ? F.b_er[F.tid - 4] : 0.f);
    for (int it = F.vcu; it < M / 16; it += F.G) {
        const int row0 = 16 * it;
        v4u raw[2][8];
#pragma unroll
        for (int r2 = 0; r2 < 2; ++r2)
#pragma unroll
            for (int j = 0; j < 8; ++j) raw[r2][j] = *(const GAS v4u*)(F.Y1B + (size_t)(row0 + 2 * w + r2) * DM + 8 * lane + 512 * j);
#define LN_DEC(wd, lo4, hi4) const f32x4 lo4 = {__uint_as_float((wd).x << 16), __uint_as_float((wd).x & 0xffff0000u), __uint_as_float((wd).y << 16), __uint_as_float((wd).y & 0xffff0000u)}, \
                                         hi4 = {__uint_as_float((wd).z << 16), __uint_as_float((wd).z & 0xffff0000u), __uint_as_float((wd).w << 16), __uint_as_float((wd).w & 0xffff0000u)}
        float mean[2], rstd[2];
#pragma unroll
        for (int r2 = 0; r2 < 2; ++r2) { float s = 0.f;
#pragma unroll
            for (int j = 0; j < 8; ++j) { LN_DEC(raw[r2][j], a, b); s += ((a[0] + a[1]) + (a[2] + a[3])) + ((b[0] + b[1]) + (b[2] + b[3])); }
            mean[r2] = wave_sum(s) * (1.0f / DM); float q = 0.f;
#pragma unroll
            for (int j = 0; j < 8; ++j) { LN_DEC(raw[r2][j], a0, b0); const f32x4 a = a0 - mean[r2], b = b0 - mean[r2]; q += ((a[0] * a[0] + a[1] * a[1]) + (a[2] * a[2] + a[3] * a[3])) + ((b[0] * b[0] + b[1] * b[1]) + (b[2] * b[2] + b[3] * b[3])); }
            rstd[r2] = 1.0f / __builtin_sqrtf(wave_sum(q) * (1.0f / DM) + LN_EPS);
            if (lane == 0) *(f32x2*)(x1dst + 2 * (size_t)(row0 + 2 * w + r2)) = (f32x2){mean[r2], rstd[r2]}; }
#pragma unroll
        for (int j = 0; j < 8; ++j) { const int col = 8 * lane + 512 * j;
            const f32x4 g0 = *(const f32x4*)(F.ln1_g + col), g1 = *(const f32x4*)(F.ln1_g + col + 4), b0 = *(const f32x4*)(F.ln1_b + col), b1 = *(const f32x4*)(F.ln1_b + col + 4);
#pragma unroll
            for (int r2 = 0; r2 < 2; ++r2) { const int lr = 2 * w + r2, row = row0 + lr;
                LN_DEC(raw[r2][j], ya, yc);
                const f32x4 xa = (ya - mean[r2]) * rstd[r2] * g0 + b0, xc = (yc - mean[r2]) * rstd[r2] * g1 + b1;
                v4u pk; pk.x = cvt_pk_bf16(xa[0], xa[1]); pk.y = cvt_pk_bf16(xa[2], xa[3]); pk.z = cvt_pk_bf16(xc[0], xc[1]); pk.w = cvt_pk_bf16(xc[2], xc[3]);
                v2u p8; p8.x = pg8::cvt_pk_fp8x4(xa[0], xa[1], xa[2], xa[3]); p8.y = pg8::cvt_pk_fp8x4(xc[0], xc[1], xc[2], xc[3]);
                *(GAS v2u*)(F.X18 + (size_t)row * DM + col) = p8;
                *(LAS v4u*)(ximg + lr * LN_ROWB + col * 2) = pk; }
            if ((j & 1) == 1) asm volatile("" ::: "memory"); }
#undef LN_DEC
        __syncthreads();
        f32x4 acc[3];
#pragma unroll
        for (int cb = 0; cb < 3; ++cb) acc[cb] = (f32x4){0.f, 0.f, 0.f, 0.f};
#pragma unroll 8
        for (int ks = 0; ks < 16; ++ks) { const int k0 = 512 * w + 32 * ks + 8 * (lane >> 4);
            const bf16x8 a = *(const LAS bf16x8*)(ximg + (lane & 15) * LN_ROWB + k0 * 2);
#pragma unroll
            for (int cb = 0; cb < 3; ++cb) { const bf16x8 b = *(const bf16x8*)(F.WrT + (size_t)(16 * cb + (lane & 15)) * DM + k0); acc[cb] = MFMA16(a, b, acc[cb]); } }
#pragma unroll
        for (int cb = 0; cb < 3; ++cb)
#pragma unroll
            for (int j = 0; j < 4; ++j) red[(w * 16 + 4 * (lane >> 4) + j) * NRT + 16 * cb + (lane & 15)] = acc[cb][j];
        __syncthreads();
        for (int idx = F.tid; idx < 16 * NRT; idx += NWAVES * 64) { float t = 0.f;
#pragma unroll
            for (int ww = 0; ww < 8; ++ww) t += red[ww * 16 * NRT + idx];
            lg[idx] = t + bt[idx % NRT]; }
        __syncthreads();
        if (F.tid < 16) {
            const int tok = row0 + F.tid; const LAS float* lp = lg + F.tid * NRT;
            float gl[4]; int gi = 0;
#pragma unroll
            for (int cgi = 0; cgi < 4; ++cgi) gl[cgi] = lp[cgi];
#pragma unroll
            for (int cgi = 1; cgi < 4; ++cgi) if (gl[cgi] > gl[gi]) gi = cgi;
            float den = 0.f;
#pragma unroll
            for (int cgi = 0; cgi < 4; ++cgi) den += __expf(gl[cgi] - gl[gi]);
            const float gw = 1.0f / den;
            float el[8];
#pragma unroll
            for (int e = 0; e < 8; ++e) el[e] = lp[4 + 8 * gi + e];
            int i0 = 0;
#pragma unroll
            for (int e = 1; e < 8; ++e) if (el[e] > el[i0]) i0 = e;
            int i1 = (i0 == 0) ? 1 : 0;
#pragma unroll
            for (int e = 0; e < 8; ++e) if (e != i0 && el[e] > el[i1]) i1 = e;
            const float w0 = 1.0f / (1.0f + __expf(el[i1] - el[i0])), w1 = 1.0f - w0;
            const int e0 = 8 * gi + i0, e1 = 8 * gi + i1;
            const unsigned sl0 = __hip_atomic_fetch_add(F.ctl + cw_cnt + 64 * e0, 1u, RLX_AGENT);
            const unsigned sl1 = __hip_atomic_fetch_add(F.ctl + cw_cnt + 64 * e1, 1u, RLX_AGENT);
            F.list[e0 * M + sl0] = 2 * tok; F.list[e1 * M + sl1] = 2 * tok + 1;
            F.wts[2 * tok] = w0 * gw; F.wts[2 * tok + 1] = w1 * gw;
        }
    }
}

__device__ __forceinline__ void build_tab(Frame& F) {
    LAS int* tab = (LAS int*)(F.lds + TAB_OFF);
    __syncthreads();
    if (F.tid < NEXP) tab[33 + F.tid] = (int)__hip_atomic_load(F.ctl + CW_CNT + 64 * F.tid, RLX_AGENT);
    __syncthreads();
    if (F.tid == 0) { int a = 0; for (int e = 0; e < NEXP; ++e) { tab[e] = a; a += (tab[33 + e] + 255) >> 8; } tab[32] = a; }
    __syncthreads();
}

__device__ __forceinline__ void p9_ln2(Frame& F, float* dst) {
    const int gw = F.vcu * NWAVES + F.wave, NGW = F.G * NWAVES, lane = F.lane;
    for (int row = gw; row < M; row += NGW) {
        const bf16* y2 = F.Y2B + (size_t)row * DM + 8 * lane;
        const bf16* m0 = F.MOE + (size_t)row * DM + 8 * lane; const bf16* m1 = m0 + (size_t)M * DM;
        f32x4 v[16]; float s = 0.f;
#pragma unroll
        for (int j = 0; j < 8; ++j) { const v4u y = *(const GAS v4u*)(y2 + 512 * j), a = *(const GAS v4u*)(m0 + 512 * j), b = *(const GAS v4u*)(m1 + 512 * j);
#define BF3(f) ((__uint_as_float((y.f) << 16) + __uint_as_float((a.f) << 16)) + __uint_as_float((b.f) << 16))
#define BF3H(f) ((__uint_as_float((y.f) & 0xffff0000u) + __uint_as_float((a.f) & 0xffff0000u)) + __uint_as_float((b.f) & 0xffff0000u))
            v[2 * j] = (f32x4){BF3(x), BF3H(x), BF3(y), BF3H(y)}; v[2 * j + 1] = (f32x4){BF3(z), BF3H(z), BF3(w), BF3H(w)};
#undef BF3
#undef BF3H
            s += ((v[2 * j][0] + v[2 * j][1]) + (v[2 * j][2] + v[2 * j][3])) + ((v[2 * j + 1][0] + v[2 * j + 1][1]) + (v[2 * j + 1][2] + v[2 * j + 1][3]));
            if ((j & 1) == 1) asm volatile("" ::: "memory"); }
        const float mean = wave_sum(s) * (1.0f / DM); float q = 0.f;
#pragma unroll
        for (int j = 0; j < 16; ++j) { v[j] = v[j] - mean; q += (v[j][0] * v[j][0] + v[j][1] * v[j][1]) + (v[j][2] * v[j][2] + v[j][3] * v[j][3]); }
        const float rstd = 1.0f / __builtin_sqrtf(wave_sum(q) * (1.0f / DM) + LN_EPS);
#pragma unroll
        for (int j = 0; j < 8; ++j) { const int col = 8 * lane + 512 * j;
            const f32x4 g0 = *(const f32x4*)(F.ln2_g + col), g1 = *(const f32x4*)(F.ln2_g + col + 4), b0 = *(const f32x4*)(F.ln2_b + col), b1 = *(const f32x4*)(F.ln2_b + col + 4);
            *(f32x4*)(dst + (size_t)row * DM + col) = v[2 * j] * rstd * g0 + b0; *(f32x4*)(dst + (size_t)row * DM + col + 4) = v[2 * j + 1] * rstd * g1 + b1;
            if ((j & 1) == 1) asm volatile("" ::: "memory"); }
    }
}

__global__ void __launch_bounds__(NWAVES * 64, 2) hymba_fwd(Args args) {
    extern __shared__ __attribute__((aligned(16))) unsigned char lds[];
    Frame F;
    F.lds = (LAS unsigned char*)lds;
    F.MISC = (volatile LAS unsigned*)(F.lds + MISC_OFF);
    F.wave0 = __builtin_amdgcn_readfirstlane((int)threadIdx.x >> 6);
#define KTID() (F.wave0 * 64 + hw_lane())
    F.tid = KTID(); F.lane = F.tid & 63; F.wave = F.wave0;
    F.G = gridDim.x; { const int bx = blockIdx.x; F.vcu = (F.G % 8 == 0) ? (bx % 8) * (F.G / 8) + bx / 8 : bx; }
    F.ctl = (gu32*)(args.ws + WS_CTL);
    for (int u = KTID(); u < (LDS_BYTES - MISC_OFF) / 4; u += NWAVES * 64) ((LAS unsigned*)(F.lds + MISC_OFF))[u] = 0u;
    __syncthreads();
    XcdBarrier bar; bar.bar = (unsigned*)(F.ctl + CW_BAR); bar.x = 0; bar.st = nullptr;
    const unsigned ctl_tag = (((unsigned)(size_t)__builtin_amdgcn_dispatch_ptr() >> 6) << 1) | 1u;
    if (N_LAUNCHES == 1 && blockIdx.x == 0) {
        for (int u = KTID(); u < (int)(CTL_ZERO_BYTES / 4); u += NWAVES * 64) __hip_atomic_store(F.ctl + u, 0u, RLX_AGENT);
        __builtin_amdgcn_fence(__ATOMIC_RELEASE, "agent");
        asm volatile("s_waitcnt vmcnt(0)" ::: "memory");
        __syncthreads();
        if (KTID() == 0) __hip_atomic_store(F.ctl + CW_READY, ctl_tag, __ATOMIC_RELEASE, __HIP_MEMORY_SCOPE_AGENT);
    }
    bool ctl_ready = (N_LAUNCHES != 1);
#define CTL_READY() do { if (!ctl_ready) { ctl_ready = true; \
        if (KTID() == 0) { unsigned sp_ = 0; while (__hip_atomic_load(F.ctl + CW_READY, __ATOMIC_ACQUIRE, __HIP_MEMORY_SCOPE_AGENT) != ctl_tag) { __builtin_amdgcn_s_sleep(2); if (++sp_ > (1u << 22)) break; } } \
        __syncthreads(); bar = xcd_barrier_post((unsigned*)(F.ctl + CW_BAR), F.MISC + 8, KTID() == 0); } } while (0)
#define GRID_BAR() do { if (N_LAUNCHES == 1) { CTL_READY(); xcd_barrier(bar, KTID() == 0); } } while (0)
    const int lo = args.ph_lo, hi = args.ph_hi;
#ifndef PH_MASK
#define PH_MASK 0x3ff
#endif
#define IN(k) (((PH_MASK >> (k)) & 1) && lo <= (k) && (k) < hi)
#define BOTH(k) (IN(k) && IN((k) + 1))
#ifndef PROBE_REP
#define PROBE_REP 0
#endif
#define REP(k) (((PROBE_REP >> (k)) & 1) ? 2 : 1)
    const LAS int* tab = (const LAS int*)(F.lds + TAB_OFF);

    if (IN(0)) { Frame P = F; fill_ptrs(P); for (int rep = 0; rep < REP(0); ++rep) p0_prologue(P); if (BOTH(0)) GRID_BAR(); }
    if (IN(1)) { Frame P = F; fill_ptrs(P);
        { pg8::Gemm g{P.PB, P.WpT, M, DM, PLE}; pg8::StaticOrder S; S.init(M, DM, F.G, (int)blockIdx.x);
          pg8::EpiPlainBf16 E{P.PP, DM};
          pg8::gemm_phase<pg8::EpiPlainBf16, pg8::StaticOrder, true, true>(F.lds + RING_OFF, g, S, E, P.tid); }
        const int NG = (F.G == 256) ? 218 : F.G;
        if ((int)blockIdx.x < NG) { pg8::Gemm g{P.XB, P.WinT, M, NIN, DM}; pg8::StaticOrder S; S.init(M, NIN, NG, (int)blockIdx.x);
          pg8::EpiProj E{P.QKV, P.b_in, P.cs};
          for (int rep = 0; rep < REP(1); ++rep) pg8::gemm_phase<pg8::EpiProj, pg8::StaticOrder, true, true>(F.lds + RING_OFF, g, S, E, P.tid); }
        conv_queue(P);
        if (BOTH(1)) GRID_BAR();
    }
    if (IN(2)) { Frame P = F; fill_ptrs(P); for (int rep = 0; rep < REP(2); ++rep) p2_attention(P); if (BOTH(2)) GRID_BAR(); }
    if (IN(3)) { Frame P = F; fill_ptrs(P);
        pg8::Gemm g{P.O, P.WoutT, M, DM, D_FP8 ? pg8::ORB : DM}; pg8::StaticOrder S; S.init(M, DM, F.G, (int)blockIdx.x);
        pg8::EpiWout E{P.XB, P.Y1B, P.b_out, P.rr};
        for (int rep = 0; rep < REP(3); ++rep) pg8::gemm_phase<pg8::EpiWout, pg8::StaticOrder, true, true, D_FP8 ? 1 : 2, pg8::O_TSPLIT, D_FP8 ? 0x79797979 : 0x7c7c7c7c>(F.lds + RING_OFF, g, S, E, P.tid);
        if (BOTH(3)) GRID_BAR();
    }
    if (IN(4)) { Frame P = F; fill_ptrs(P);
        p4_ln1_router(P, P.stats, CW_CNT); if (BOTH(4)) GRID_BAR(); }
    if (IN(5)) { Frame P = F; fill_ptrs(P);
    }
    if (IN(6)) { Frame P = F; fill_ptrs(P);
        build_tab(P);
        const int G = F.G, c = (int)blockIdx.x, U6 = 4 * tab[32]; int x = 3 * G - U6; x = x < 0 ? 0 : (x > 512 ? 512 : x);
        int n6 = 0; while (n6 < 3 && c + G * n6 < U6) ++n6;
        if (U6 > 3 * G) n6 = 1 << 20;
        { pg8::Gemm g{(const pg8::bf16_t*)P.X18, (const pg8::bf16_t*)P.Wgu8, M, NEXP * 1024, DM}; pg8::GroupedList<true> S{tab, 4, tab[32], c, G, n6, P.list};
          pg8::EpiGateUp E{P.H8};
          pg8::gemm_phase<pg8::EpiGateUp, pg8::GroupedList<true>, true, true, 1>(F.lds + RING_OFF, g, S, E, P.tid); }
        { pg8::Gemm g{(const pg8::bf16_t*)P.X18, (const pg8::bf16_t*)P.Wg8, M, DM, DM}; pg8::DenseList S; const int lf = c + G * n6 - U6;
          int n8f = 0; if (n6 <= 3) { while (lf + G * n8f < x) ++n8f; }
          S.init(M, DM, lf, G, n8f);
          pg8::EpiPle E{P.Y1B, P.Y2B, P.b_pg, P.PP, P.stats, P.ln1_g, P.ln1_b};
          pg8::gemm_phase<pg8::EpiPle, pg8::DenseList, true, true, 1>(F.lds + RING_OFF, g, S, E, P.tid); }
        if (BOTH(6)) GRID_BAR();
    }
    if (IN(7)) { Frame P = F; fill_ptrs(P);
        build_tab(P);
        const int G = F.G, c = (int)blockIdx.x, U6 = 4 * tab[32]; int x = 3 * G - U6; x = x < 0 ? 0 : (x > 512 ? 512 : x);
        const int n8 = 512 - x;
        const bool one_each = n8 <= G;
        { pg8::Gemm g{(const pg8::bf16_t*)P.X18, (const pg8::bf16_t*)P.Wg8, M, DM, DM}; pg8::DenseList S;
          if (one_each) S.init(M, DM, x + c, 1, c < n8 ? 1 : 0); else S.init(M, DM, x + c, G, 1 << 20);
          pg8::EpiPle E{P.Y1B, P.Y2B, P.b_pg, P.PP, P.stats, P.ln1_g, P.ln1_b};
          pg8::gemm_phase<pg8::EpiPle, pg8::DenseList, true, true, 1>(F.lds + RING_OFF, g, S, E, P.tid); }
        { pg8::Gemm g{(const pg8::bf16_t*)P.H8, (const pg8::bf16_t*)P.Wd8, MPAD_MAX, NEXP * DM, DEXP};
          const int nw = one_each ? (G - n8) : G;
          pg8::GroupedList<false> S{tab, 16, tab[32], one_each ? c - n8 : c, nw > 0 ? nw : 1, (one_each && (c < n8 || nw <= 0)) ? 0 : (1 << 20), nullptr};
          pg8::EpiDown E{P.MOE, P.list, P.wts, tab + 33};
          pg8::gemm_phase<pg8::EpiDown, pg8::GroupedList<false>, true, true, 1>(F.lds + RING_OFF, g, S, E, P.tid); }
        if (BOTH(7)) GRID_BAR();
    }
    if (IN(8)) { Frame P = F; fill_ptrs(P); if (REP(8) == 2) p9_ln2(P, (float*)P.XG);
        p9_ln2(P, P.out); }
    if (N_LAUNCHES == 1 && blockIdx.x == 0 && KTID() == 0) __hip_atomic_store(F.ctl + CW_READY, 0u, RLX_AGENT);
#undef IN
#undef BOTH
#undef GRID_BAR
}

extern "C" void kernel_launch(void* const* d_in, const int* in_sizes, int n_in, void* d_out, int out_size, void* d_ws, size_t ws_size, hipStream_t stream) {
    static int grid = 0;
    if (grid == 0) {
        if (n_in != 24 || in_sizes[0] != M * DM || out_size != M * DM || ws_size < WS_END) { fprintf(stderr, "kernel_launch: unexpected shapes (n_in %d, in0 %d, out %d, ws %zu < %zu); nothing launched\n", n_in, n_in > 0 ? in_sizes[0] : -1, out_size, ws_size, (size_t)WS_END); grid = -1; return; }
        int dev = 0, cus = 0, per_cu = 0;
        if (hipGetDevice(&dev) != hipSuccess || hipDeviceGetAttribute(&cus, hipDeviceAttributeMultiprocessorCount, dev) != hipSuccess) { fprintf(stderr, "kernel_launch: device query failed\n"); grid = -1; return; }
        if (hipFuncSetAttribute((const void*)hymba_fwd, hipFuncAttributeMaxDynamicSharedMemorySize, LDS_BYTES) != hipSuccess) { fprintf(stderr, "kernel_launch: hipFuncSetAttribute failed\n"); grid = -1; return; }
        if (hipOccupancyMaxActiveBlocksPerMultiprocessor(&per_cu, (const void*)hymba_fwd, NWAVES * 64, LDS_BYTES) != hipSuccess || per_cu < 1)
            fprintf(stderr, "kernel_launch: note: occupancy query reports %d workgroups per CU\n", per_cu);
        (void)hipGetLastError();
        grid = cus < 256 ? cus : 256;
    }
    if (grid < 0) return;
    if (N_LAUNCHES != 1 && hipMemsetAsync((char*)d_ws + WS_CTL, 0, CTL_ZERO_BYTES, stream) != hipSuccess) { fprintf(stderr, "kernel_launch: hipMemsetAsync failed\n"); return; }
    Args a{};
    for (int i = 0; i < 24; ++i) a.in[i] = d_in[i];
    a.out = (float*)d_out; a.ws = (unsigned char*)d_ws;
    for (int li = 0; li < N_LAUNCHES; ++li) {
        a.ph_lo = (N_LAUNCHES == 1) ? 0 : li; a.ph_hi = (N_LAUNCHES == 1) ? N_PHASES : li + 1;
        hipLaunchKernelGGL(hymba_fwd, dim3(grid), dim3(NWAVES * 64), LDS_BYTES, stream, a);
        const hipError_t le = hipPeekAtLastError();
        if (le != hipSuccess) { fprintf(stderr, "kernel_launch: launch %d failed: %s\n", li, hipGetErrorName(le)); break; }
    }
}
```

```cpp
#include <hip/hip_runtime.h>
#include <cstdio>
#include <cstdint>

namespace pg8 {
#define PG8_LAS __attribute__((address_space(3)))
typedef unsigned short bf16_t;
typedef short bf16x8 __attribute__((ext_vector_type(8)));
typedef float f32x4 __attribute__((ext_vector_type(4)));
typedef float f32x2 __attribute__((ext_vector_type(2)));
typedef unsigned u32x4 __attribute__((ext_vector_type(4)));
typedef unsigned u32x2 __attribute__((ext_vector_type(2)));
typedef __bf16 bf16x2_t __attribute__((ext_vector_type(2)));
typedef int v4i_t __attribute__((ext_vector_type(4)));
typedef int v8i_t __attribute__((ext_vector_type(8)));
constexpr int BM = 256, BK = 64, HALF = 128, HTB = HALF * BK * 2  , STAGE_BYTES = 8 * HTB, NXCD = 8, WGM = 8;

__host__ __device__ __forceinline__ int lds_byte(int r, int c) { const int st = (r >> 4) * 2 + (c >> 5), rr = r & 15, cc = c & 31, ob = rr * 64 + cc * 2; return st * 1024 + (ob ^ (((ob >> 9) & 1) << 5)); }
__host__ __device__ __forceinline__ void stage_rc(int b, int& R, int& C) { const int st = b / 1024, sb = b % 1024, swz = sb ^ (((sb >> 9) & 1) << 5); R = (st >> 1) * 16 + swz / 64; C = (st & 1) * 32 + (swz % 64) / 2; }
__host__ __device__ __forceinline__ int perm32(int rho) { const int n = rho >> 4, i = rho & 15; return 8 * (i >> 2) + 4 * n + (i & 3); }
template <int PM> __host__ __device__ __forceinline__ int bperm(int R) {
    if (PM == 1) return (R & ~31) + perm32(R & 31);
    if (PM == 2) { const int wc = R >> 5, n = (R >> 4) & 1, i = R & 15; return 64 * (wc >> 1) + 16 * (wc & 1) + i + 32 * n; }
    return R;
}

struct Unit { int pm, pn, e, lt; };
struct Gemm { const bf16_t* A; const bf16_t* Bt; int M, N, K; };

struct StaticOrder {
    static constexpr bool GATHER = false;
    int nM, nN, nwg, G, c;
    __host__ __device__ void init(int M, int N, int G_, int c_) { nM = M / BM; nN = N / BM; nwg = nM * nN; G = G_; c = c_; }
    __host__ __device__ bool next(int i, Unit& u) const {
        const long L = (long)i * G + c; if (L >= nwg) return false;
        int wgid = (int)L; { const int q = nwg / NXCD, r = nwg % NXCD, xcd = wgid % NXCD, off = wgid / NXCD; wgid = (xcd < r ? xcd * (q + 1) : r * (q + 1) + (xcd - r) * q) + off; }
        const int nig = WGM * nN, gid = wgid / nig, fm = gid * WGM, gsz = (nM - fm) < WGM ? (nM - fm) : WGM;
        u.pm = fm + ((wgid % nig) % gsz); u.pn = (wgid % nig) / gsz; u.e = 0; u.lt = 0; return true;
    }
    __device__ __forceinline__ void a_ready(const Unit&) const {}
    __device__ __forceinline__ void done(const Unit&) const {}
};
struct GroupedOrder {
    static constexpr bool GATHER = false;
    const PG8_LAS int* tstart; int nN, total, G, c;
    __device__ __forceinline__ bool next(int i, Unit& u) const {
        const int L = i * G + c; if (L >= total * nN) return false;
        const int mt = L / nN, pn = L - mt * nN; int e = 0;
        while (e < 31 && tstart[e + 1] <= mt) ++e;
        u.pm = mt; u.pn = e * nN + pn; u.e = e; u.lt = mt - tstart[e]; return true;
    }
    __device__ __forceinline__ void a_ready(const Unit&) const {}
    __device__ __forceinline__ void done(const Unit&) const {}
};

struct DenseList {
    static constexpr bool GATHER = false;
    int nM, nN, nwg, v0, stride, n;
    __device__ __forceinline__ void init(int M, int N, int v0_, int stride_, int n_) { nM = M / BM; nN = N / BM; nwg = nM * nN; v0 = v0_; stride = stride_; n = n_; }
    __device__ __forceinline__ bool next(int i, Unit& u) const {
        if (i >= n) return false;
        int wgid = v0 + stride * i; if (wgid >= nwg) return false;
        { const int q = nwg / NXCD, r = nwg % NXCD, xcd = wgid % NXCD, off = wgid / NXCD; wgid = (xcd < r ? xcd * (q + 1) : r * (q + 1) + (xcd - r) * q) + off; }
        const int nig = WGM * nN, gid = wgid / nig, fm = gid * WGM, gsz = (nM - fm) < WGM ? (nM - fm) : WGM;
        u.pm = fm + ((wgid % nig) % gsz); u.pn = (wgid % nig) / gsz; u.e = 0; u.lt = 0; return true;
    }
    __device__ __forceinline__ void a_ready(const Unit&) const {}
    __device__ __forceinline__ void done(const Unit&) const {}
};
template <bool GATHER_> struct GroupedList {
    static constexpr bool GATHER = GATHER_;
    const PG8_LAS int* tstart; int nN, total, l0, stride, n;
    const int* list;
    __device__ __forceinline__ void a_rows(const Unit& u, const int (&R)[2], int (&rows)[2][2]) const {
        const int n_e = tstart[33 + u.e];
#pragma unroll
        for (int h = 0; h < 2; ++h)
#pragma unroll
            for (int i = 0; i < 2; ++i) { const int ii = u.lt * BM + h * HALF + R[i]; rows[h][i] = ii < n_e ? (list[u.e * 8192 + ii] >> 1) : 0; }
    }
    __device__ __forceinline__ bool next(int i, Unit& u) const {
        if (i >= n) return false;
        const int L = l0 + stride * i; if (L >= total * nN) return false;
        const int mt = L / nN, pn = L - mt * nN; int e = 0;
        while (e < 31 && tstart[e + 1] <= mt) ++e;
        u.pm = mt; u.pn = e * nN + pn; u.e = e; u.lt = mt - tstart[e]; return true;
    }
    __device__ __forceinline__ void a_ready(const Unit&) const {}
    __device__ __forceinline__ void done(const Unit&) const {}
};

__device__ __forceinline__ unsigned cvt_pk_bf16(float lo, float hi) { f32x2 v = {lo, hi}; bf16x2_t b = __builtin_convertvector(v, bf16x2_t); return __builtin_bit_cast(unsigned, b); }

__device__ __forceinline__ unsigned cvt_pk_fp8x4(float a_, float b_, float c_, float d_) { int w = 0; w = __builtin_amdgcn_cvt_pk_fp8_f32(a_, b_, w, false); w = __builtin_amdgcn_cvt_pk_fp8_f32(c_, d_, w, true); return (unsigned)w; }

constexpr float LOG2E = 1.4426950408889634f;
constexpr float ALPHA = 1.189207115002721f;
constexpr float QA_SCALE = 0.18033688011112042f;
constexpr float QB_SCALE = 0.12751743082459868f;


struct EpiPlainBf16 {
    static constexpr int PM = 1; static constexpr bool AFTER_DRAIN = false, MIDK = false;
    bf16_t* O; int ldc;
    __device__ __forceinline__ void operator()(const f32x4 (&acc)[2][2][4][2], const Unit& u, int wr, int wc, int fr, int fq) const {
        const int row0 = u.pm * BM + wr * 64 + fr, col0 = u.pn * BM + wc * 32 + 8 * fq;
#pragma unroll
        for (int ai = 0; ai < 2; ++ai)
#pragma unroll
            for (int m = 0; m < 4; ++m) { bf16_t* rowp = O + (size_t)(row0 + ai * HALF + m * 16) * ldc + col0;
#pragma unroll
                for (int bj = 0; bj < 2; ++bj) { const f32x4 v0 = acc[ai][bj][m][0], v1 = acc[ai][bj][m][1];
                    u32x4 w; w.x = cvt_pk_bf16(v0[0], v0[1]); w.y = cvt_pk_bf16(v0[2], v0[3]); w.z = cvt_pk_bf16(v1[0], v1[1]); w.w = cvt_pk_bf16(v1[2], v1[3]);
                    *(u32x4*)(rowp + bj * HALF) = w; } }
    }
};

struct EpiProj {
    static constexpr int PM = 2; static constexpr bool AFTER_DRAIN = false, MIDK = false;
    bf16_t* O; const float* bias; const float* cs;
    static constexpr int ST_OFF = 131072, ST_ROWB = 272, ST_TILE = 32 * ST_ROWB;
    __device__ __forceinline__ void epi_staged(const f32x4 (&acc)[2][2][4][2], const Unit& u, int wr, int wc, int fr, int fq, PG8_LAS unsigned char* lds, int wid, int lane) const {
        constexpr int LD = 8704;
        const int row0 = u.pm * BM + wr * 64 + fr, tile = u.pn;
        const bool rope = tile < 9;
        const float sc = tile < 8 ? QA_SCALE : ((tile >= 10 && tile < 18) ? QB_SCALE : 1.0f);
        const int p0 = 16 * (wc & 1) + 4 * fq;
        const int wofs = (wr * 16 + fr) * ST_ROWB + (64 * (wc >> 1) + p0) * 2;
        const int t = wid * 64 + lane, rr_ = t >> 4, ch = t & 15; const int rofs = rr_ * ST_ROWB + ch * 16;
        bf16_t* gout = O + (size_t)(u.pm * BM + (rr_ >> 4) * 64 + (rr_ & 15)) * LD + tile * BM + ch * 8;
        int step = 0;
#pragma unroll
        for (int bj = 0; bj < 2; ++bj) {
            const int cb = tile * BM + HALF * bj + 64 * (wc >> 1) + p0;
            const f32x4 blo = *(const f32x4*)(bias + cb), bhi = *(const f32x4*)(bias + cb + 32);
#pragma unroll
            for (int ai = 0; ai < 2; ++ai)
#pragma unroll
                for (int m = 0; m < 4; ++m) {
                    const int row = row0 + ai * HALF + m * 16;
                    f32x4 a = acc[ai][bj][m][0] + blo, b = acc[ai][bj][m][1] + bhi;
                    if (rope) {
                        const f32x4 c01 = *(const f32x4*)(cs + (size_t)row * 64 + 2 * p0), c23 = *(const f32x4*)(cs + (size_t)row * 64 + 2 * p0 + 4);
                        const f32x4 co = {c01[0], c01[2], c23[0], c23[2]}, si = {c01[1], c01[3], c23[1], c23[3]};
                        const f32x4 ra = a * co - b * si, rb = b * co + a * si; a = ra; b = rb;
                    }
                    a = a * sc; b = b * sc;
                    u32x2 wa, wb; wa.x = cvt_pk_bf16(a[0], a[1]); wa.y = cvt_pk_bf16(a[2], a[3]); wb.x = cvt_pk_bf16(b[0], b[1]); wb.y = cvt_pk_bf16(b[2], b[3]);
                    PG8_LAS unsigned char* st = lds + ST_OFF + (step & 1) * ST_TILE;
                    *(PG8_LAS u32x2*)(st + wofs) = wa; *(PG8_LAS u32x2*)(st + wofs + 64) = wb;
                    asm volatile("s_waitcnt lgkmcnt(0)" ::: "memory");
                    __builtin_amdgcn_s_barrier();
                    const u32x4 v = *(const PG8_LAS u32x4*)(st + rofs);
                    *(u32x4*)(gout + (size_t)(ai * HALF + m * 16) * LD + bj * HALF) = v;
                    ++step;
                }
        }
    }
};

#ifndef D_FP8
#define D_FP8 1
#endif
#ifndef D_KSPLIT
#define D_KSPLIT 2048
#endif
constexpr int OKS = D_FP8 ? D_KSPLIT : 4096, ORB = OKS * 2 + (4096 - OKS);
constexpr int O_TSPLIT = D_FP8 ? OKS / 64 : 0, O_MIDT = !D_FP8 ? 0 : (OKS >= 2048 ? 32 : OKS / 64 + (2048 - OKS) / 128);
static_assert(OKS % 128 == 0 && OKS >= 0 && OKS <= 4096 && (O_MIDT % 2) == 0, "D_KSPLIT");
struct EpiWout {
    static constexpr int PM = 1; static constexpr bool AFTER_DRAIN = false, MIDK = true; static constexpr int MIDK_T = O_MIDT;
    const bf16_t* xb; bf16_t* Y; const float* bias; const float* rr;
    static constexpr int RRT_OFF = 131072;
    __device__ __forceinline__ void unit_begin(PG8_LAS unsigned char* lds, const Unit& u, int par, int wid, int lane) const {
        __builtin_amdgcn_global_load_lds((const unsigned*)(rr + 2 * (size_t)(u.pm * BM) + 64 * wid + lane), (PG8_LAS unsigned*)(lds + RRT_OFF + par * 2048 + wid * 256), 4, 0, 0);
    }
    __device__ __forceinline__ void midk(f32x4 (&acc)[2][2][4][2], const Unit& u, int wr, int fr, PG8_LAS unsigned char* lds, int par) const {
        const PG8_LAS float* rt = (const PG8_LAS float*)(lds + RRT_OFF + par * 2048);
#pragma unroll
        for (int ai = 0; ai < 2; ++ai)
#pragma unroll
            for (int m = 0; m < 4; ++m) { const f32x2 r = *(const PG8_LAS f32x2*)(rt + 2 * (ai * HALF + wr * 64 + m * 16 + fr));
                const float ratio = r.x / r.y;
#pragma unroll
                for (int bj = 0; bj < 2; ++bj)
#pragma unroll
                    for (int n = 0; n < 2; ++n) acc[ai][bj][m][n] = acc[ai][bj][m][n] * ratio;
                asm volatile("" : "+v"(acc[ai][0][m][0]), "+v"(acc[ai][0][m][1]), "+v"(acc[ai][1][m][0]), "+v"(acc[ai][1][m][1])); }
    }
    __device__ __forceinline__ void epi(const f32x4 (&acc)[2][2][4][2], const Unit& u, int wr, int wc, int fr, int fq, PG8_LAS unsigned char* lds, int par) const {
        constexpr int LD = 4096;
        const PG8_LAS float* rt = (const PG8_LAS float*)(lds + RRT_OFF + par * 2048);
        const int row0 = u.pm * BM + wr * 64 + fr, col0 = u.pn * BM + wc * 32 + 8 * fq;
        f32x4 bv[2][2];
#pragma unroll
        for (int bj = 0; bj < 2; ++bj)
#pragma unroll
            for (int n = 0; n < 2; ++n) bv[bj][n] = *(const f32x4*)(bias + col0 + bj * HALF + 4 * n);
        u32x4 xq[4][2][2];
#define EPW_LOAD(b_) do { _Pragma("unroll") for (int m_ = 0; m_ < 2; ++m_) { const size_t off_ = (size_t)(row0 + ((b_) >> 1) * HALF + (2 * ((b_) & 1) + m_) * 16) * LD + col0; xq[b_][m_][0] = *(const u32x4*)(xb + off_); xq[b_][m_][1] = *(const u32x4*)(xb + off_ + HALF); } } while (0)
        EPW_LOAD(0);
#pragma unroll
        for (int b = 0; b < 4; ++b) { const int ai = b >> 1;
            if (b == 0) EPW_LOAD(1); else if (b == 1) EPW_LOAD(2); else if (b == 2) EPW_LOAD(3);
            asm volatile("" ::: "memory");
#pragma unroll
            for (int mm = 0; mm < 2; ++mm) { const int m = 2 * (b & 1) + mm; const int row = row0 + ai * HALF + m * 16; const float rb = rt[2 * (ai * HALF + wr * 64 + m * 16 + fr) + 1]; const size_t off = (size_t)row * LD + col0;
#pragma unroll
                for (int bj = 0; bj < 2; ++bj) { const u32x4 xw = xq[b][mm][bj];
                    const f32x4 xa = {__uint_as_float(xw.x << 16), __uint_as_float(xw.x & 0xffff0000u), __uint_as_float(xw.y << 16), __uint_as_float(xw.y & 0xffff0000u)};
                    const f32x4 xc = {__uint_as_float(xw.z << 16), __uint_as_float(xw.z & 0xffff0000u), __uint_as_float(xw.w << 16), __uint_as_float(xw.w & 0xffff0000u)};
                    const f32x4 v0 = xa * ALPHA + acc[ai][bj][m][0] * rb + bv[bj][0], v1 = xc * ALPHA + acc[ai][bj][m][1] * rb + bv[bj][1];
                    u32x4 w; w.x = cvt_pk_bf16(v0[0], v0[1]); w.y = cvt_pk_bf16(v0[2], v0[3]); w.z = cvt_pk_bf16(v1[0], v1[1]); w.w = cvt_pk_bf16(v1[2], v1[3]);
                    *(u32x4*)(Y + off + bj * HALF) = w; } }
            asm volatile("" ::: "memory"); }
#undef EPW_LOAD
    }
};

struct EpiGateUp {
    static constexpr int PM = 1; static constexpr bool AFTER_DRAIN = false, MIDK = false;
    unsigned char* H;
    __device__ __forceinline__ void operator()(const f32x4 (&acc)[2][2][4][2], const Unit& u, int wr, int wc, int fr, int fq) const {
        constexpr int LD = 512;
        const int row0 = u.pm * BM + wr * 64 + fr, col0 = (u.pn & 3) * HALF + wc * 32 + 8 * fq;
#pragma unroll
        for (int ai = 0; ai < 2; ++ai)
#pragma unroll
            for (int m = 0; m < 4; ++m) {
                float h[8];
#pragma unroll
                for (int n = 0; n < 2; ++n)
#pragma unroll
                    for (int j = 0; j < 4; ++j) { const float g = acc[ai][0][m][n][j], up = acc[ai][1][m][n][j];
                        const float sg = __builtin_amdgcn_rcpf(1.0f + __builtin_amdgcn_exp2f(-g * LOG2E));
                        h[4 * n + j] = g * sg * up; }
                u32x2 w; w.x = cvt_pk_fp8x4(h[0], h[1], h[2], h[3]); w.y = cvt_pk_fp8x4(h[4], h[5], h[6], h[7]);
                *(u32x2*)(H + (size_t)(row0 + ai * HALF + m * 16) * LD + col0) = w;
            }
    }
};

struct EpiDown {
    static constexpr int PM = 1; static constexpr bool AFTER_DRAIN = false, MIDK = false;
    bf16_t* MOE; const int* list; const float* wts; const PG8_LAS int* cnt;
    __device__ __forceinline__ void operator()(const f32x4 (&acc)[2][2][4][2], const Unit& u, int wr, int wc, int fr, int fq) const {
        constexpr int LD = 4096, MTOK = 8192;
        const int n_e = cnt[u.e], i0 = u.lt * BM + wr * 64 + fr, col0 = (u.pn & 15) * BM + wc * 32 + 8 * fq;
#pragma unroll
        for (int ai = 0; ai < 2; ++ai)
#pragma unroll
            for (int m = 0; m < 4; ++m) {
                const int i = i0 + ai * HALF + m * 16;
                if (i < n_e) {
                    const int ent = list[u.e * MTOK + i]; const float w = wts[ent];
                    bf16_t* rowp = MOE + ((size_t)(ent & 1) * MTOK + (size_t)(ent >> 1)) * LD + col0;
#pragma unroll
                    for (int bj = 0; bj < 2; ++bj) { const f32x4 v0 = acc[ai][bj][m][0] * w, v1 = acc[ai][bj][m][1] * w;
                        u32x4 o; o.x = cvt_pk_bf16(v0[0], v0[1]); o.y = cvt_pk_bf16(v0[2], v0[3]); o.z = cvt_pk_bf16(v1[0], v1[1]); o.w = cvt_pk_bf16(v1[2], v1[3]);
                        *(u32x4*)(rowp + bj * HALF) = o; }
                }
            }
    }
};

struct EpiPle {
    static constexpr int PM = 1; static constexpr bool AFTER_DRAIN = false, MIDK = false;
    const bf16_t* Y1; bf16_t* Y2; const float* bias; const bf16_t* pp; const float* stats; const float* lng; const float* lnb;
    __device__ __forceinline__ void operator()(const f32x4 (&acc)[2][2][4][2], const Unit& u, int wr, int wc, int fr, int fq) const {
        constexpr int LD = 4096;
        const int row0 = u.pm * BM + wr * 64 + fr, col0 = u.pn * BM + wc * 32 + 8 * fq;
#pragma unroll
        for (int bj = 0; bj < 2; ++bj) {
            f32x4 bv[2], gv[2], cv[2];
#pragma unroll
            for (int n = 0; n < 2; ++n) { bv[n] = *(const f32x4*)(bias + col0 + bj * HALF + 4 * n); gv[n] = *(const f32x4*)(lng + col0 + bj * HALF + 4 * n); cv[n] = *(const f32x4*)(lnb + col0 + bj * HALF + 4 * n); }
            f32x2 stq[2]; u32x4 yq[2], pq[2];
#define EPP_LOAD(i_) do { const int row_ = row0 + ((i_) >> 2) * HALF + ((i_) & 3) * 16; const size_t off_ = (size_t)row_ * LD + col0 + bj * HALF; stq[(i_) & 1] = *(const f32x2*)(stats + 2 * (size_t)row_); \
                yq[(i_) & 1] = *(const u32x4*)(Y1 + off_); pq[(i_) & 1] = *(const u32x4*)(pp + off_); } while (0)
            EPP_LOAD(0);
#pragma unroll
            for (int i = 0; i < 8; ++i) { const int ai = i >> 2, m = i & 3; const size_t off = (size_t)(row0 + ai * HALF + m * 16) * LD + col0 + bj * HALF;
                if (i == 0) EPP_LOAD(1); else if (i == 1) EPP_LOAD(2); else if (i == 2) EPP_LOAD(3); else if (i == 3) EPP_LOAD(4); else if (i == 4) EPP_LOAD(5); else if (i == 5) EPP_LOAD(6); else if (i == 6) EPP_LOAD(7);
                asm volatile("" ::: "memory");
                const f32x2 st = stq[i & 1]; const u32x4 yw = yq[i & 1], pw = pq[i & 1]; u32x4 w;
#pragma unroll
                for (int n = 0; n < 2; ++n) { const unsigned ya = n ? yw.z : yw.x, yb = n ? yw.w : yw.y, pa = n ? pw.z : pw.x, pb = n ? pw.w : pw.y;
                    const f32x4 yv = {__uint_as_float(ya << 16), __uint_as_float(ya & 0xffff0000u), __uint_as_float(yb << 16), __uint_as_float(yb & 0xffff0000u)};
                    const f32x4 pv = {__uint_as_float(pa << 16), __uint_as_float(pa & 0xffff0000u), __uint_as_float(pb << 16), __uint_as_float(pb & 0xffff0000u)};
                    const f32x4 x1 = (yv - st.x) * st.y * gv[n] + cv[n];
                    const f32x4 t = acc[ai][bj][m][n] + bv[n]; f32x4 sg;
#pragma unroll
                    for (int j = 0; j < 4; ++j) sg[j] = __builtin_amdgcn_rcpf(1.0f + __builtin_amdgcn_exp2f(-t[j] * LOG2E));
                    const f32x4 o = x1 * ALPHA + sg * pv;
                    if (n == 0) { w.x = cvt_pk_bf16(o[0], o[1]); w.y = cvt_pk_bf16(o[2], o[3]); } else { w.z = cvt_pk_bf16(o[0], o[1]); w.w = cvt_pk_bf16(o[2], o[3]); } }
                *(u32x4*)(Y2 + off) = w;
                asm volatile("" ::: "memory"); }
#undef EPP_LOAD
        }
    }
};

template <class Epi, class Sched, bool ALIGN_EPI = false, bool SP2 = false, int ELT = 2, int TSPLIT = 0, int ASCALE = 0x7c7c7c7c>
__device__ __forceinline__ void gemm_phase(PG8_LAS unsigned char* lds, const Gemm g, const Sched& S, const Epi& E, int tid_in) {
    int tid_ = tid_in; asm volatile("" : "+v"(tid_));
    const int tid = tid_, wid = __builtin_amdgcn_readfirstlane(tid >> 6), lane = tid & 63, wr = wid >> 2, wc = wid & 3, fr = lane & 15, fq = lane >> 4;
    const int K = g.K, nt = K * ELT / (BK * 2);
    static_assert(SP2 || !Sched::GATHER, "the gather form is written for the SP2 loop only");
    unsigned voffB[2];
#pragma unroll
    for (int i = 0; i < 2; ++i) { int R, C; stage_rc(tid * 16 + i * 8192, R, C); const int Rb = bperm<Epi::PM>(R);
        voffB[i] = (unsigned)(Rb * K * ELT + C * 2); }
    unsigned vAc[2][2], vAn[2][2];
#define PG8_AOFFS(dst, unit) do { int aR[2], aC[2]; _Pragma("unroll") for (int i_ = 0; i_ < 2; ++i_) stage_rc(tid * 16 + i_ * 8192, aR[i_], aC[i_]);     \
        if constexpr (Sched::GATHER) { int rows_[2][2]; S.a_rows(unit, aR, rows_); _Pragma("unroll") for (int h_ = 0; h_ < 2; ++h_) _Pragma("unroll") for (int i_ = 0; i_ < 2; ++i_) \
            dst[h_][i_] = (unsigned)rows_[h_][i_] * (unsigned)(K * ELT) + (unsigned)(aC[i_] * 2); } \
        else { _Pragma("unroll") for (int h_ = 0; h_ < 2; ++h_) _Pragma("unroll") for (int i_ = 0; i_ < 2; ++i_) dst[h_][i_] = (unsigned)((h_ * HALF + aR[i_]) * K * ELT + aC[i_] * 2); } } while (0)
    const size_t kstep = (size_t)(BK * 2);
    const size_t hstep = (size_t)HALF * K * ELT;
    const size_t tstep = 2 * hstep;
    const unsigned ldsw = (unsigned)wid * 1024u;
    const int aoff = lds_byte(wr * 64 + fr, fq * 8), boff = lds_byte(wc * 32 + fr, fq * 8);
#define PG8_SA(b, h) (((b) * 2 + (h)) * HTB)
#define PG8_SB(b, h) ((4 + (b) * 2 + (h)) * HTB)
#define PG8_STAGE(bufoff, gbase, voff) do { _Pragma("unroll") for (int _i = 0; _i < 2; ++_i) \
        __builtin_amdgcn_global_load_lds((const unsigned*)((const char*)(gbase) + (voff)[_i]), (PG8_LAS unsigned*)(lds + (bufoff) + ldsw + _i * 8192), 16, 0, 0); } while (0)
#define PG8_LDA(dst, b, h) do { _Pragma("unroll") for (int m = 0; m < 4; ++m) { if constexpr (ELT == 2 || PG8_BF16T) { _Pragma("unroll") for (int k = 0; k < 2; ++k) dst[m][k] = *(const PG8_LAS bf16x8*)(lds + PG8_SA(b, h) + aoff + m * 2048 + k * 1024); } \
        else { const v4i_t lo_ = *(const PG8_LAS v4i_t*)(lds + PG8_SA(b, h) + aoff + m * 2048), hi_ = *(const PG8_LAS v4i_t*)(lds + PG8_SA(b, h) + aoff + m * 2048 + 1024); dst##8[m] = __builtin_shufflevector(lo_, hi_, 0, 1, 2, 3, 4, 5, 6, 7); } } } while (0)
#define PG8_LDB(dst, b, h) do { _Pragma("unroll") for (int n = 0; n < 2; ++n) { if constexpr (ELT == 2 || PG8_BF16T) { _Pragma("unroll") for (int k = 0; k < 2; ++k) dst[n][k] = *(const PG8_LAS bf16x8*)(lds + PG8_SB(b, h) + boff + n * 2048 + k * 1024); } \
        else { const v4i_t lo_ = *(const PG8_LAS v4i_t*)(lds + PG8_SB(b, h) + boff + n * 2048), hi_ = *(const PG8_LAS v4i_t*)(lds + PG8_SB(b, h) + boff + n * 2048 + 1024); dst##8[n] = __builtin_shufflevector(lo_, hi_, 0, 1, 2, 3, 4, 5, 6, 7); } } } while (0)
#define PG8_MMA(ai, bj, At, Bt) do { __builtin_amdgcn_s_setprio(1); \
        if constexpr (ELT == 2 || PG8_BF16T) { _Pragma("unroll") for (int m = 0; m < 4; ++m) _Pragma("unroll") for (int n = 0; n < 2; ++n) _Pragma("unroll") for (int k = 0; k < 2; ++k) \
            acc[ai][bj][m][n] = __builtin_amdgcn_mfma_f32_16x16x32_bf16(Bt[n][k], At[m][k], acc[ai][bj][m][n], 0, 0, 0); } \
        else { _Pragma("unroll") for (int m = 0; m < 4; ++m) _Pragma("unroll") for (int n = 0; n < 2; ++n) \
            asm volatile("v_mfma_scale_f32_16x16x128_f8f6f4 %0, %1, %2, %0, %3, %4 op_sel_hi:[0,0,0]" : "+v"(acc[ai][bj][m][n]) : "v"(Bt##8[n]), "v"(At##8[m]), "v"(mxscale), "v"(mxscale_a)); }     \
        __builtin_amdgcn_s_setprio(0); } while (0)
#define PG8_WAIT_V(n) asm volatile("s_waitcnt vmcnt(" #n ")" ::: "memory")
#define PG8_WAIT_L(n) asm volatile("s_waitcnt lgkmcnt(" #n ")" ::: "memory")
#define PG8_BAR __builtin_amdgcn_s_barrier()
#define PG8_SCHED __builtin_amdgcn_sched_barrier(0)
    Unit cur, nxt; int ui = 0;
    if (!S.next(0, cur)) return;
    f32x4 acc[2][2][4][2];
#pragma unroll
    for (int a = 0; a < 2; ++a)
#pragma unroll
        for (int b = 0; b < 2; ++b)
#pragma unroll
            for (int m = 0; m < 4; ++m)
#pragma unroll
                for (int n = 0; n < 2; ++n) acc[a][b][m][n] = (f32x4){0.f, 0.f, 0.f, 0.f};
    bf16x8 At[4][2], B0[2][2], B1[2][2];
    v8i_t At8[4], B08[2], B18[2];
    int mxscale = 0x7c7c7c7c; asm volatile("" : "+v"(mxscale));
    int mxscale_a = ASCALE; asm volatile("" : "+v"(mxscale_a));
    const char* cA = (const char*)g.A + (Sched::GATHER ? (size_t)0 : (size_t)cur.pm * tstep); const char* cB = (const char*)g.Bt + (size_t)cur.pn * tstep;
    S.a_ready(cur);
    if constexpr (Epi::MIDK) E.unit_begin(lds, cur, 0, wid, lane);
    PG8_AOFFS(vAc, cur);
#pragma unroll
    for (int h_ = 0; h_ < 2; ++h_)
#pragma unroll
        for (int i_ = 0; i_ < 2; ++i_) vAn[h_][i_] = vAc[h_][i_];
    if constexpr (SP2) {
        PG8_STAGE(PG8_SB(0, 0), cB, voffB); PG8_STAGE(PG8_SB(0, 1), cB + hstep, voffB); PG8_STAGE(PG8_SA(0, 0), cA, vAc[0]); PG8_STAGE(PG8_SA(0, 1), cA, vAc[1]);
        if (wr == 1) PG8_BAR;
        PG8_WAIT_V(2); PG8_BAR;
        PG8_STAGE(PG8_SB(1, 0), cB + kstep, voffB); PG8_STAGE(PG8_SA(1, 0), cA + kstep, vAc[0]); PG8_STAGE(PG8_SB(1, 1), cB + hstep + kstep, voffB);
        PG8_WAIT_V(6); PG8_BAR;
    } else {
        PG8_STAGE(PG8_SB(0, 0), cB, voffB); PG8_STAGE(PG8_SA(0, 0), cA, vAc[0]); PG8_STAGE(PG8_SB(0, 1), cB + hstep, voffB); PG8_STAGE(PG8_SA(0, 1), cA, vAc[1]);
        if (wr == 1) PG8_BAR;
        PG8_WAIT_V(4); PG8_BAR;
        PG8_STAGE(PG8_SB(1, 0), cB + kstep, voffB); PG8_STAGE(PG8_SA(1, 0), cA + kstep, vAc[0]); PG8_STAGE(PG8_SB(1, 1), cB + hstep + kstep, voffB);
        PG8_WAIT_V(6); PG8_BAR;
    }
    for (;;) {
        const bool has_next = S.next(ui + 1, nxt);
        const char* nA = (has_next && !Sched::GATHER) ? (const char*)g.A + (size_t)nxt.pm * tstep : cA; const char* nB = has_next ? (const char*)g.Bt + (size_t)nxt.pn * tstep : cB;
        if constexpr (TSPLIT > 0) { constexpr bool PG8_BF16T = true;
#pragma unroll 1
        for (int t = 0; t < TSPLIT; t += 2) {
            const bool last = (t == nt - 2);
            if constexpr (TSPLIT > 0) asm volatile("" : "+v"(voffB[0]), "+v"(voffB[1]), "+v"(vAc[0][0]), "+v"(vAc[0][1]), "+v"(vAc[1][0]), "+v"(vAc[1][1]));
            const char* a1 = cA + (size_t)(t + 1) * kstep;
            const char* a2 = last ? nA : cA + (size_t)(t + 2) * kstep; const char* b2 = last ? nB : cB + (size_t)(t + 2) * kstep;
            const char* a3 = a2 + kstep; const char* b3 = b2 + kstep;
            if (last && has_next) { S.a_ready(nxt); if constexpr (Sched::GATHER) PG8_AOFFS(vAn, nxt); if constexpr (Epi::MIDK) E.unit_begin(lds, nxt, (ui + 1) & 1, wid, lane); }
            if constexpr (Epi::MIDK) { if (t == (Epi::MIDK_T ? Epi::MIDK_T : (nt >> 1))) E.midk(acc, cur, wr, fr, lds, ui & 1); }
            if constexpr (SP2) {
            PG8_LDB(B0, 0, 0); PG8_LDB(B1, 0, 1); PG8_SCHED; PG8_LDA(At, 0, 0); PG8_STAGE(PG8_SA(1, 1), a1, vAc[1]);
            if constexpr (Sched::GATHER) { if (last) { _Pragma("unroll") for (int h_ = 0; h_ < 2; ++h_) _Pragma("unroll") for (int i_ = 0; i_ < 2; ++i_) vAc[h_][i_] = vAn[h_][i_]; } }
            PG8_WAIT_V(8); PG8_WAIT_L(0); PG8_BAR; PG8_MMA(0, 0, At, B0); PG8_MMA(0, 1, At, B1); PG8_BAR; PG8_SCHED;
            PG8_LDA(At, 0, 1); PG8_STAGE(PG8_SB(0, 0), b2, voffB); PG8_STAGE(PG8_SB(0, 1), b2 + hstep, voffB); PG8_STAGE(PG8_SA(0, 0), a2, vAc[0]);
            PG8_WAIT_V(8); PG8_WAIT_L(0); PG8_BAR; PG8_MMA(1, 0, At, B0); PG8_MMA(1, 1, At, B1); PG8_BAR; PG8_SCHED;
            PG8_LDB(B0, 1, 0); PG8_LDB(B1, 1, 1); PG8_SCHED; PG8_LDA(At, 1, 0); PG8_STAGE(PG8_SA(0, 1), a2, vAc[1]);
            PG8_WAIT_V(8); PG8_WAIT_L(0); PG8_BAR; PG8_MMA(0, 0, At, B0); PG8_MMA(0, 1, At, B1); PG8_BAR; PG8_SCHED;
            PG8_LDA(At, 1, 1); PG8_STAGE(PG8_SB(1, 0), b3, voffB); PG8_STAGE(PG8_SB(1, 1), b3 + hstep, voffB); PG8_STAGE(PG8_SA(1, 0), a3, vAc[0]);
            PG8_WAIT_V(8); PG8_WAIT_L(0); PG8_BAR; PG8_MMA(1, 0, At, B0); PG8_MMA(1, 1, At, B1); PG8_BAR; PG8_SCHED;
            } else {
            PG8_LDB(B0, 0, 0); PG8_SCHED; PG8_LDA(At, 0, 0); PG8_STAGE(PG8_SA(1, 1), a1, vAc[1]);
            PG8_WAIT_L(8); PG8_BAR; PG8_WAIT_L(0); PG8_MMA(0, 0, At, B0); PG8_BAR; PG8_SCHED;
            PG8_LDB(B1, 0, 1); PG8_STAGE(PG8_SB(0, 0), b2, voffB);
            PG8_BAR; PG8_WAIT_L(0); PG8_MMA(0, 1, At, B1); PG8_BAR;
            PG8_LDA(At, 0, 1); PG8_STAGE(PG8_SA(0, 0), a2, vAc[0]);
            PG8_BAR; PG8_WAIT_L(0); PG8_MMA(1, 0, At, B0); PG8_BAR; PG8_SCHED;
            PG8_STAGE(PG8_SB(0, 1), b2 + hstep, voffB);
            PG8_WAIT_V(6); PG8_BAR; PG8_MMA(1, 1, At, B1); PG8_BAR;
            PG8_LDB(B0, 1, 0); PG8_SCHED; PG8_LDA(At, 1, 0); PG8_STAGE(PG8_SA(0, 1), a2, vAc[1]);
            PG8_WAIT_L(8); PG8_BAR; PG8_WAIT_L(0); PG8_MMA(0, 0, At, B0); PG8_BAR; PG8_SCHED;
            PG8_LDB(B1, 1, 1); PG8_STAGE(PG8_SB(1, 0), b3, voffB);
            PG8_BAR; PG8_WAIT_L(0); PG8_MMA(0, 1, At, B1); PG8_BAR;
            PG8_LDA(At, 1, 1); PG8_STAGE(PG8_SA(1, 0), a3, vAc[0]);
            PG8_BAR; PG8_WAIT_L(0); PG8_MMA(1, 0, At, B0); PG8_BAR; PG8_SCHED;
            PG8_STAGE(PG8_SB(1, 1), b3 + hstep, voffB);
            PG8_WAIT_V(6); PG8_BAR; PG8_MMA(1, 1, At, B1); PG8_BAR;
            }
        }
        }
        { constexpr bool PG8_BF16T = false;
#pragma unroll 1
        for (int t = TSPLIT; t < nt; t += 2) {
            const bool last = (t == nt - 2);
            if constexpr (TSPLIT > 0) asm volatile("" : "+v"(voffB[0]), "+v"(voffB[1]), "+v"(vAc[0][0]), "+v"(vAc[0][1]), "+v"(vAc[1][0]), "+v"(vAc[1][1]));
            const char* a1 = cA + (size_t)(t + 1) * kstep;
            const char* a2 = last ? nA : cA + (size_t)(t + 2) * kstep; const char* b2 = last ? nB : cB + (size_t)(t + 2) * kstep;
            const char* a3 = a2 + kstep; const char* b3 = b2 + kstep;
            if (last && has_next) { S.a_ready(nxt); if constexpr (Sched::GATHER) PG8_AOFFS(vAn, nxt); if constexpr (Epi::MIDK) E.unit_begin(lds, nxt, (ui + 1) & 1, wid, lane); }
            if constexpr (Epi::MIDK) { if (t == (Epi::MIDK_T ? Epi::MIDK_T : (nt >> 1))) E.midk(acc, cur, wr, fr, lds, ui & 1); }
            if constexpr (SP2) {
            PG8_LDB(B0, 0, 0); PG8_LDB(B1, 0, 1); PG8_SCHED; PG8_LDA(At, 0, 0); PG8_STAGE(PG8_SA(1, 1), a1, vAc[1]);
            if constexpr (Sched::GATHER) { if (last) { _Pragma("unroll") for (int h_ = 0; h_ < 2; ++h_) _Pragma("unroll") for (int i_ = 0; i_ < 2; ++i_) vAc[h_][i_] = vAn[h_][i_]; } }
            PG8_WAIT_V(8); PG8_WAIT_L(0); PG8_BAR; PG8_MMA(0, 0, At, B0); PG8_MMA(0, 1, At, B1); PG8_BAR; PG8_SCHED;
            PG8_LDA(At, 0, 1); PG8_STAGE(PG8_SB(0, 0), b2, voffB); PG8_STAGE(PG8_SB(0, 1), b2 + hstep, voffB); PG8_STAGE(PG8_SA(0, 0), a2, vAc[0]);
            PG8_WAIT_V(8); PG8_WAIT_L(0); PG8_BAR; PG8_MMA(1, 0, At, B0); PG8_MMA(1, 1, At, B1); PG8_BAR; PG8_SCHED;
            PG8_LDB(B0, 1, 0); PG8_LDB(B1, 1, 1); PG8_SCHED; PG8_LDA(At, 1, 0); PG8_STAGE(PG8_SA(0, 1), a2, vAc[1]);
            PG8_WAIT_V(8); PG8_WAIT_L(0); PG8_BAR; PG8_MMA(0, 0, At, B0); PG8_MMA(0, 1, At, B1); PG8_BAR; PG8_SCHED;
            PG8_LDA(At, 1, 1); PG8_STAGE(PG8_SB(1, 0), b3, voffB); PG8_STAGE(PG8_SB(1, 1), b3 + hstep, voffB); PG8_STAGE(PG8_SA(1, 0), a3, vAc[0]);
            PG8_WAIT_V(8); PG8_WAIT_L(0); PG8_BAR; PG8_MMA(1, 0, At, B0); PG8_MMA(1, 1, At, B1); PG8_BAR; PG8_SCHED;
            } else {
            PG8_LDB(B0, 0, 0); PG8_SCHED; PG8_LDA(At, 0, 0); PG8_STAGE(PG8_SA(1, 1), a1, vAc[1]);
            PG8_WAIT_L(8); PG8_BAR; PG8_WAIT_L(0); PG8_MMA(0, 0, At, B0); PG8_BAR; PG8_SCHED;
            PG8_LDB(B1, 0, 1); PG8_STAGE(PG8_SB(0, 0), b2, voffB);
            PG8_BAR; PG8_WAIT_L(0); PG8_MMA(0, 1, At, B1); PG8_BAR;
            PG8_LDA(At, 0, 1); PG8_STAGE(PG8_SA(0, 0), a2, vAc[0]);
            PG8_BAR; PG8_WAIT_L(0); PG8_MMA(1, 0, At, B0); PG8_BAR; PG8_SCHED;
            PG8_STAGE(PG8_SB(0, 1), b2 + hstep, voffB);
            PG8_WAIT_V(6); PG8_BAR; PG8_MMA(1, 1, At, B1); PG8_BAR;
            PG8_LDB(B0, 1, 0); PG8_SCHED; PG8_LDA(At, 1, 0); PG8_STAGE(PG8_SA(0, 1), a2, vAc[1]);
            PG8_WAIT_L(8); PG8_BAR; PG8_WAIT_L(0); PG8_MMA(0, 0, At, B0); PG8_BAR; PG8_SCHED;
            PG8_LDB(B1, 1, 1); PG8_STAGE(PG8_SB(1, 0), b3, voffB);
            PG8_BAR; PG8_WAIT_L(0); PG8_MMA(0, 1, At, B1); PG8_BAR;
            PG8_LDA(At, 1, 1); PG8_STAGE(PG8_SA(1, 0), a3, vAc[0]);
            PG8_BAR; PG8_WAIT_L(0); PG8_MMA(1, 0, At, B0); PG8_BAR; PG8_SCHED;
            PG8_STAGE(PG8_SB(1, 1), b3 + hstep, voffB);
            PG8_WAIT_V(6); PG8_BAR; PG8_MMA(1, 1, At, B1); PG8_BAR;
            }
        }
        }
        if constexpr (ALIGN_EPI) { if (wr == 0) PG8_BAR; }
        if constexpr (ELT == 1) asm volatile("s_nop 15\n\ts_nop 15" ::: "memory");
        if constexpr (Epi::MIDK) { E.epi(acc, cur, wr, wc, fr, fq, lds, ui & 1); S.done(cur); }
        else if constexpr (Epi::PM == 2) { E.epi_staged(acc, cur, wr, wc, fr, fq, lds, wid, lane); S.done(cur); }
        else if constexpr (!Epi::AFTER_DRAIN) { E(acc, cur, wr, wc, fr, fq); S.done(cur); }
        if (!has_next) break;
#pragma unroll
        for (int a = 0; a < 2; ++a)
#pragma unroll
            for (int b = 0; b < 2; ++b)
#pragma unroll
                for (int m = 0; m < 4; ++m)
#pragma unroll
                    for (int n = 0; n < 2; ++n) acc[a][b][m][n] = (f32x4){0.f, 0.f, 0.f, 0.f};
        cur = nxt; cA = nA; cB = nB; ++ui;
        if constexpr (ALIGN_EPI) { if (wr == 1) PG8_BAR; }
    }
    PG8_WAIT_V(0);
    if constexpr (!ALIGN_EPI) { if (wr == 0) PG8_BAR; }
    PG8_BAR;
    if constexpr (Epi::AFTER_DRAIN) { E.fused(acc, cur, wr, wc, fr, fq, lds, wid, lane); S.done(cur); }
#undef PG8_AOFFS
#undef PG8_SA
#undef PG8_SB
#undef PG8_STAGE
#undef PG8_LDA
#undef PG8_LDB
#undef PG8_MMA
#undef PG8_WAIT_V
#undef PG8_WAIT_L
#undef PG8_BAR
#undef PG8_SCHED
}
}

constexpr int NWAVES = 8;
#ifndef MK_N_LAUNCHES
#define MK_N_LAUNCHES 1
#endif
constexpr int N_PHASES = 9;
constexpr int N_LAUNCHES = MK_N_LAUNCHES;
static_assert(N_LAUNCHES == 1 || N_LAUNCHES == N_PHASES, "MK_N_LAUNCHES is 1 or 9");

constexpr int BATCH = 2, SEQ = 4096, DM = 4096, M = BATCH * SEQ;
constexpr int NIN = 8704;
constexpr int QA0 = 0, KA0 = 2048, VA0 = 2304, QB0 = 2560, KB0 = 4608, VB0 = 6656;
constexpr int NEXP = 32, DEXP = 512, PLE = 256, NRT = 48;
constexpr float LN_EPS = 1e-5f, RMS_EPS = 1e-6f;
constexpr float SB_STOP = 32.0f;

constexpr size_t MiB = 1u << 20;
constexpr size_t WS_CTL = 0, CTL_ZERO_BYTES = 64 * 1024;
constexpr size_t WS_CS = 1 * MiB;
constexpr size_t WS_WRT = 3 * MiB;
constexpr size_t WS_RR = 3 * MiB + 512 * 1024;
constexpr size_t WS_WTS = 3 * MiB + 640 * 1024;
constexpr size_t WS_STATS = 3 * MiB + 768 * 1024;
constexpr size_t WS_LIST = 4 * MiB;
constexpr size_t WS_WINT = 8 * MiB;
constexpr size_t WS_WOUTT = 76 * MiB;
constexpr size_t WS_WGT = 108 * MiB;
constexpr size_t WS_WPT = 140 * MiB;
constexpr size_t WS_PB = 142 * MiB;
constexpr size_t WS_WGUT = 146 * MiB;
constexpr size_t WS_WDT = 402 * MiB;
constexpr size_t WS_XB = 530 * MiB;
constexpr size_t WS_QKV = 594 * MiB;
constexpr size_t WS_XG = 530 * MiB;
constexpr size_t WS_Y1B = 594 * MiB;
constexpr size_t WS_Y2B = 658 * MiB;
constexpr size_t WS_O = 730 * MiB;
constexpr size_t WS_H = 730 * MiB;
constexpr size_t WS_X1B = 794 * MiB;
constexpr size_t WS_PP = 858 * MiB;
constexpr size_t WS_MOE = 922 * MiB;
constexpr size_t WS_END = 1050 * MiB;
constexpr int MPAD_MAX = 24576;
constexpr int CW_TMO = 0, CW_CODE = 1;
constexpr int CW_BAR = 4096;
constexpr int CW_CNT = 8192;
constexpr int CW_DONE = 12352;
constexpr int CW_Q = 12288;
static_assert((CW_CNT + 64 * NEXP) * 4 <= (int)CTL_ZERO_BYTES, "CTL words inside the memset region");
constexpr int CW_READY = 16384 + 64;

constexpr int RING_OFF = 0, RING_BYTES = 131072;
constexpr int LDS_BYTES = 163840;
constexpr int MISC_OFF = LDS_BYTES - 1024;
constexpr int TAB_OFF = MISC_OFF + 256;
constexpr int ATT_VIMG = 16384, ATT_RED = 131072, ATT_G = 133120;
constexpr int LN_ROWB = 8208, LN_RED = 131328, LN_LOG = 155904;
static_assert(LN_LOG + 3072 + 192 <= MISC_OFF && ATT_RED + 2048 <= ATT_G && ATT_G + 16384 <= MISC_OFF, "LDS map");

#define GAS __attribute__((address_space(1)))
#define LAS __attribute__((address_space(3)))
typedef unsigned short bf16;
typedef unsigned v4u __attribute__((ext_vector_type(4)));
typedef unsigned v2u __attribute__((ext_vector_type(2)));
typedef float f32x4 __attribute__((ext_vector_type(4)));
typedef float f32x2 __attribute__((ext_vector_type(2)));
typedef float f32x16 __attribute__((ext_vector_type(16)));
typedef short bf16x8 __attribute__((ext_vector_type(8)));
typedef short s16x4 __attribute__((ext_vector_type(4)));
typedef GAS unsigned gu32;
#define RLX_AGENT __ATOMIC_RELAXED, __HIP_MEMORY_SCOPE_AGENT
#define LDS_WAIT() asm volatile("s_waitcnt lgkmcnt(0)" ::: "memory")
#define VM_WAIT() asm volatile("s_waitcnt vmcnt(0)" ::: "memory")
#define MFMA32(a, b, c) __builtin_amdgcn_mfma_f32_32x32x16_bf16((a), (b), (c), 0, 0, 0)
#define MFMA16(a, b, c) __builtin_amdgcn_mfma_f32_16x16x32_bf16((a), (b), (c), 0, 0, 0)
using pg8::cvt_pk_bf16;
using pg8::LOG2E;
using pg8::OKS;
__device__ __forceinline__ float bf2f(unsigned short b) { return __uint_as_float(((unsigned)b) << 16); }

#define XB_TMO      128
#define XB_XCNT(j)  (256  + 64 * (j))
#define XB_XSUB(j)  (1280 + 64 * (j))
#define XB_XGEN(j)  (2304 + 64 * (j))
#define XB_TOP      3328
#define XB_TOPGEN   3392
#define XCD_BAR_WORDS 3456
#define XB_SPIN_CAP (1u << 18)

__device__ __forceinline__ unsigned xb_ld(unsigned* p)              { return __hip_atomic_load(p, __ATOMIC_RELAXED, __HIP_MEMORY_SCOPE_AGENT); }
__device__ __forceinline__ unsigned xb_add(unsigned* p, unsigned v) { return __hip_atomic_fetch_add(p, v, __ATOMIC_RELAXED, __HIP_MEMORY_SCOPE_AGENT); }
__device__ __forceinline__ unsigned xb_xcc_id() { return (unsigned)__builtin_amdgcn_s_getreg((3 << 11) | 20) & 0xFu; }
#define XB_SPIN(cond, bar) do { unsigned _sp = 0; while (cond) { __builtin_amdgcn_s_sleep(1); \
    if ((++_sp & 255u) == 0u) { if (xb_ld(&(bar)[XB_TMO])) break; if (_sp > XB_SPIN_CAP) { atomicAdd(&(bar)[XB_TMO], 1u); break; } } } } while (0)

struct XcdBarrier {
    unsigned* bar; unsigned x;
    volatile LAS unsigned* st;
};

__device__ __forceinline__ XcdBarrier xcd_barrier_post(unsigned* bar, volatile LAS unsigned* st, bool lead) {
    XcdBarrier b; b.bar = bar; b.x = xb_xcc_id(); b.st = st;
    if (lead) (void)xb_add(&bar[XB_XCNT(b.x)], 1u);
    return b;
}
__device__ __forceinline__ void xcd_barrier_complete(unsigned* bar, unsigned x, unsigned& nloc, unsigned& nx) {
    const unsigned G = gridDim.x * gridDim.y * gridDim.z;
    unsigned sum, cnt, mine, sp = 0u;
    for (;;) {
        sum = 0u; cnt = 0u; mine = 0u;
#pragma unroll
        for (unsigned j = 0; j < 16; ++j) { const unsigned c = xb_ld(&bar[XB_XCNT(j)]); sum += c; cnt += (c > 0u) ? 1u : 0u; mine = (j == x) ? c : mine; }
        if (sum == G) break;
        __builtin_amdgcn_s_sleep(1);
        if ((++sp & 255u) == 0u) { if (xb_ld(&bar[XB_TMO])) break; if (sp > XB_SPIN_CAP) { atomicAdd(&bar[XB_TMO], 1u); break; } }
    }
    nloc = mine > 0u ? mine : 1u; nx = cnt > 0u ? cnt : 1u;
}

__device__ __forceinline__ void xcd_barrier(const XcdBarrier& b, bool lead) {
    asm volatile("s_waitcnt vmcnt(0)" ::: "memory");
    __syncthreads();
    if (lead) {
        unsigned* bar = b.bar;
        __builtin_amdgcn_s_waitcnt(0);
        unsigned nloc = b.st[0], nx = b.st[1];
        if (nloc == 0u) { xcd_barrier_complete(bar, b.x, nloc, nx); b.st[0] = nloc; b.st[1] = nx; }
        const unsigned old = xb_add(&bar[XB_XSUB(b.x)], 1u);
        const unsigned gen = old / nloc;
        if (old + 1u == (gen + 1u) * nloc) {
            __builtin_amdgcn_fence(__ATOMIC_RELEASE, "agent");
            asm volatile("s_waitcnt vmcnt(0)" ::: "memory");
            const unsigned og = xb_add(&bar[XB_TOP], 1u);
            const unsigned tg = og / nx;
            if (og + 1u == (tg + 1u) * nx) xb_add(&bar[XB_TOPGEN], 1u);
            else XB_SPIN(xb_ld(&bar[XB_TOPGEN]) == tg, bar);
            __builtin_amdgcn_fence(__ATOMIC_ACQUIRE, "agent");
            xb_add(&bar[XB_XGEN(b.x)], 1u);
            asm volatile("s_waitcnt vmcnt(0)" ::: "memory");
        } else {
            XB_SPIN(xb_ld(&bar[XB_XGEN(b.x)]) == gen, bar);
            __builtin_amdgcn_fence(__ATOMIC_ACQUIRE, "agent");
            asm volatile("s_waitcnt vmcnt(0)" ::: "memory");
        }
    }
    __syncthreads();
}

struct Frame {
    LAS unsigned char* lds;
    volatile LAS unsigned* MISC;
    gu32* ctl;
    int tid, lane, wave, wave0;
    int vcu, G;
    const float *x, *p; const int* positions;
    const float *w_in, *b_in, *sinks, *g_a, *g_b, *w_out, *b_out, *ln1_g, *ln1_b, *w_group, *b_group, *w_er, *b_er, *w_gate, *w_up, *w_down, *w_pg, *b_pg, *w_pp, *ln2_g, *ln2_b;
    float* out;
    float *cs, *rr, *wts, *stats; int* list;
    bf16 *WrT, *WinT, *WoutT, *WpT, *PB, *XB, *QKV, *XG, *O, *PP, *MOE, *Y1B, *Y2B;
    unsigned char *Wg8, *Wgu8, *Wd8, *X18, *H8;
};

__device__ __forceinline__ float wave_sum(float v) {
#pragma unroll
    for (int o = 1; o < 64; o <<= 1) v += __shfl_xor(v, o);
    return v;
}
__device__ __forceinline__ f32x2 pair32(float v) { auto r = __builtin_amdgcn_permlane32_swap(__float_as_uint(v), __float_as_uint(v), false, false); return (f32x2){__uint_as_float(r[0]), __uint_as_float(r[1])}; }


__device__ __forceinline__ int hw_lane() { int l; asm volatile("v_mbcnt_lo_u32_b32 %0, -1, 0\n\tv_mbcnt_hi_u32_b32 %0, -1, %0" : "=v"(l)); return l; }
struct Args { const void* in[24]; float* out; unsigned char* ws; int ph_lo, ph_hi; };
typedef __attribute__((address_space(4))) const Args CArgs;
__device__ __forceinline__ void fill_ptrs(Frame& F) {
    CArgs* ap = (CArgs*)__builtin_amdgcn_kernarg_segment_ptr();
    asm volatile("" : "+s"(ap));
    { int t = F.wave0 * 64 + hw_lane(); asm volatile("" : "+v"(t)); F.tid = t; F.lane = t & 63; F.wave = __builtin_amdgcn_readfirstlane(t >> 6); }
    unsigned char* ws = ap->ws;
    F.x = (const float*)ap->in[0]; F.p = (const float*)ap->in[1]; F.positions = (const int*)ap->in[2];
    F.w_in = (const float*)ap->in[3]; F.b_in = (const float*)ap->in[4]; F.sinks = (const float*)ap->in[5]; F.g_a = (const float*)ap->in[6]; F.g_b = (const float*)ap->in[7];
    F.w_out = (const float*)ap->in[8]; F.b_out = (const float*)ap->in[9]; F.ln1_g = (const float*)ap->in[10]; F.ln1_b = (const float*)ap->in[11];
    F.w_group = (const float*)ap->in[12]; F.b_group = (const float*)ap->in[13]; F.w_er = (const float*)ap->in[14]; F.b_er = (const float*)ap->in[15];
    F.w_gate = (const float*)ap->in[16]; F.w_up = (const float*)ap->in[17]; F.w_down = (const float*)ap->in[18];
    F.w_pg = (const float*)ap->in[19]; F.b_pg = (const float*)ap->in[20]; F.w_pp = (const float*)ap->in[21]; F.ln2_g = (const float*)ap->in[22]; F.ln2_b = (const float*)ap->in[23];
    F.out = ap->out;
    F.ctl = (gu32*)(ws + WS_CTL);
    F.cs = (float*)(ws + WS_CS); F.rr = (float*)(ws + WS_RR); F.wts = (float*)(ws + WS_WTS); F.stats = (float*)(ws + WS_STATS); F.list = (int*)(ws + WS_LIST);
    F.WrT = (bf16*)(ws + WS_WRT); F.WinT = (bf16*)(ws + WS_WINT); F.WoutT = (bf16*)(ws + WS_WOUTT); F.Wg8 = ws + WS_WGT; F.WpT = (bf16*)(ws + WS_WPT); F.PB = (bf16*)(ws + WS_PB);
    F.Wgu8 = ws + WS_WGUT; F.Wd8 = ws + WS_WDT; F.XB = (bf16*)(ws + WS_XB); F.QKV = (bf16*)(ws + WS_QKV); F.XG = (bf16*)(ws + WS_XG);
    F.O = (bf16*)(ws + WS_O); F.H8 = ws + WS_H; F.X18 = ws + WS_X1B; F.PP = (bf16*)(ws + WS_PP); F.MOE = (bf16*)(ws + WS_MOE); F.Y1B = (bf16*)(ws + WS_Y1B); F.Y2B = (bf16*)(ws + WS_Y2B);
}

struct CvItem { const float* src; bf16* dst; int N, K, f8; };
__device__ __forceinline__ void cv_load(const CvItem& d, f32x4 (&v)[16], int lane) {
    if (d.f8) {
#pragma unroll
        for (int ii = 0; ii < 4; ++ii)
#pragma unroll
            for (int jj = 0; jj < 4; ++jj) v[4 * ii + jj] = *(const GAS f32x4*)(d.src + (size_t)(4 * ((lane >> 3) + 8 * ii) + jj) * d.N + 4 * (lane & 7));
        return; }
#pragma unroll
    for (int i = 0; i < 8; ++i) { const float* p = d.src + (size_t)(2 * ((lane >> 4) + 4 * i)) * d.N + 4 * (lane & 15);
        v[2 * i] = *(const GAS f32x4*)p; v[2 * i + 1] = *(const GAS f32x4*)(p + d.N); }
}
__device__ __forceinline__ void cv_finish(const CvItem& d, const f32x4 (&v)[16], LAS float* scrf, int lane) {
    LAS unsigned* scr = (LAS unsigned*)scrf;
    if (d.f8) {
#pragma unroll
        for (int ii = 0; ii < 4; ++ii) { LAS unsigned* p = scr + ((lane >> 3) + 8 * ii) * 33 + 4 * (lane & 7);
#pragma unroll
            for (int cc = 0; cc < 4; ++cc) p[cc] = pg8::cvt_pk_fp8x4(v[4 * ii][cc] * 64.0f, v[4 * ii + 1][cc] * 64.0f, v[4 * ii + 2][cc] * 64.0f, v[4 * ii + 3][cc] * 64.0f); }
        LDS_WAIT(); asm volatile("" ::: "memory");
        const int ch = lane & 7;
#pragma unroll
        for (int j = 0; j < 4; ++j) { const int n = (lane >> 3) + 8 * j; const LAS unsigned* sp = scr + (4 * ch) * 33 + n;
            v4u o; o.x = sp[0 * 33]; o.y = sp[1 * 33]; o.z = sp[2 * 33]; o.w = sp[3 * 33];
            *(GAS v4u*)((unsigned char*)d.dst + (size_t)n * d.K + 16 * ch) = o; }
        LDS_WAIT(); asm volatile("" ::: "memory");
        return; }
#pragma unroll
    for (int i = 0; i < 8; ++i) { LAS unsigned* p = scr + ((lane >> 4) + 4 * i) * 65 + 4 * (lane & 15);
#pragma unroll
        for (int j = 0; j < 4; ++j) p[j] = cvt_pk_bf16(v[2 * i][j], v[2 * i + 1][j]); }
    LDS_WAIT(); asm volatile("" ::: "memory");
    const int c = lane & 7;
#pragma unroll
    for (int j = 0; j < 8; ++j) { const int n = (lane >> 3) + 8 * j; const LAS unsigned* s = scr + (4 * c) * 65 + n;
        v4u o; o.x = s[0 * 65]; o.y = s[1 * 65]; o.z = s[2 * 65]; o.w = s[3 * 65];
        *(GAS v4u*)(d.dst + (size_t)n * d.K + 8 * c) = o; }
    LDS_WAIT(); asm volatile("" ::: "memory");
}
__device__ const double ROPE_INV_FREQ[32] = {1.0, 0.7498942093324559, 0.5623413251903491, 0.4216965034285822, 0.31622776601683794, 0.23713737056616552, 0.1778279410038923, 0.1333521432163324,
    0.1, 0.07498942093324558, 0.05623413251903491, 0.042169650342858224, 0.03162277660168379, 0.023713737056616554, 0.01778279410038923, 0.01333521432163324,
    0.01, 0.007498942093324558, 0.005623413251903491, 0.004216965034285823, 0.0031622776601683794, 0.0023713737056616554, 0.0017782794100389228, 0.001333521432163324,
    0.001, 0.0007498942093324559, 0.0005623413251903491, 0.00042169650342858224, 0.00031622776601683794, 0.00023713737056616554, 0.00017782794100389227, 0.0001333521432163324};

constexpr int I_IN = (DM / 64) * (NIN / 64), I_SQ = (DM / 64) * (DM / 64), I_PP = (PLE / 64) * (DM / 64);
constexpr int I_GU = (DM / 64) * (DEXP / 64), I_DN = (DEXP / 64) * (DM / 64);
constexpr int I_A = I_IN + I_PP, NITEMS = I_A + 2 * I_SQ + NEXP * (2 * I_GU + I_DN);
constexpr int QCHUNK = 16, NCHUNK = (NITEMS - I_A + QCHUNK - 1) / QCHUNK;
__device__ __forceinline__ CvItem cv_decode(const Frame& F, int it) {
    int r = it; CvItem d;
#define CV_SET(W, Kk, Nn, WT, nb, drow) do { const int kb_ = r / (nb), n0_ = 64 * (r % (nb)); d.src = (W) + (size_t)(64 * kb_) * (Nn) + n0_; d.dst = (WT) + (size_t)(drow) * (Kk) + 64 * kb_; d.N = (Nn); d.K = (Kk); d.f8 = 0; } while (0)
#define CV_SET8(W, Kk, Nn, WT8, nb, drow) do { const int kb_ = r / (nb), n0_ = 32 * (r % (nb)); d.src = (W) + (size_t)(128 * kb_) * (Nn) + n0_; d.dst = (bf16*)((WT8) + (size_t)(drow) * (Kk) + 128 * kb_); d.N = (Nn); d.K = (Kk); d.f8 = 1; } while (0)
    if (r < I_IN) { CV_SET(F.w_in, DM, NIN, F.WinT, NIN / 64, (size_t)n0_); return d; } r -= I_IN;
    if (r < I_PP) { CV_SET(F.w_pp, PLE, DM, F.WpT, DM / 64, (size_t)n0_); return d; } r -= I_PP;
    if (r < OKS) { CV_SET(F.w_out, pg8::ORB / 2, DM, F.WoutT, DM / 64, (size_t)n0_); return d; }
    if (r < I_SQ) { r -= OKS; CV_SET8(F.w_out + (size_t)OKS * DM, pg8::ORB, DM, (unsigned char*)F.WoutT + 2 * OKS, DM / 32, (size_t)n0_); return d; }
    r -= I_SQ;
    if (r < I_SQ) { CV_SET8(F.w_pg, DM, DM, F.Wg8, DM / 32, (size_t)n0_); return d; } r -= I_SQ;
    const int e = r / (2 * I_GU + I_DN); r -= e * (2 * I_GU + I_DN);
    if (r < 2 * I_GU) { const int up = r >= I_GU; if (up) r -= I_GU;
        CV_SET8((up ? F.w_up : F.w_gate) + (size_t)e * DM * DEXP, DM, DEXP, F.Wgu8, DEXP / 32, (size_t)e * 1024 + (size_t)(n0_ >> 7) * 256 + (up ? 128 : 0) + (n0_ & 127)); return d; }
    r -= 2 * I_GU;
    CV_SET8(F.w_down + (size_t)e * DEXP * DM, DEXP, DM, F.Wd8, DM / 32, (size_t)e * DM + n0_); return d;
#undef CV_SET
#undef CV_SET8
}
__device__ __forceinline__ void cv_run(const Frame& F, int first, int stride, int end, LAS float* scr) {
    if (first >= end) return;
    CvItem cur = cv_decode(F, first); f32x4 va[16], vb[16];
    cv_load(cur, va, F.lane);
    for (int it = first; it < end; it += stride) {
        const bool more = it + stride < end; CvItem nxt = cur;
        if (more) { nxt = cv_decode(F, it + stride); cv_load(nxt, vb, F.lane); }
        cv_finish(cur, va, scr, F.lane);
        cur = nxt;
#pragma unroll
        for (int i = 0; i < 16; ++i) va[i] = vb[i];
    }
}
__device__ __forceinline__ void conv_queue(Frame& F) {
    LAS float* scr = (LAS float*)(F.lds + RING_OFF + F.wave * 16384);
    constexpr int IPW = QCHUNK / NWAVES;
    __syncthreads();
    if (F.tid == 0) F.MISC[16] = __hip_atomic_fetch_add(F.ctl + CW_Q, 1u, RLX_AGENT);
    __syncthreads();
    int ch = (int)F.MISC[16], slot = 0, k = 0;
    if (ch >= NCHUNK) return;
    if (F.tid == 0) F.MISC[17] = __hip_atomic_fetch_add(F.ctl + CW_Q, 1u, RLX_AGENT);
#define CV_NEXT(dst) do { if (k == IPW) { __syncthreads(); slot ^= 1; ch = (int)F.MISC[16 + slot]; k = 0; \
            if (F.tid == 0 && ch < NCHUNK) F.MISC[16 + (slot ^ 1)] = __hip_atomic_fetch_add(F.ctl + CW_Q, 1u, RLX_AGENT); } \
        dst = (ch < NCHUNK) ? I_A + ch * QCHUNK + F.wave * IPW + k : -1; ++k; } while (0)
    int it0; CV_NEXT(it0);
    CvItem cur = cv_decode(F, it0); f32x4 va[16], vb[16];
    cv_load(cur, va, F.lane);
    for (;;) {
        int it1; CV_NEXT(it1);
        CvItem nxt = cur;
        if (it1 >= 0) { nxt = cv_decode(F, it1); cv_load(nxt, vb, F.lane); }
        cv_finish(cur, va, scr, F.lane);
        if (it1 < 0) break;
        cur = nxt;
#pragma unroll
        for (int i = 0; i < 16; ++i) va[i] = vb[i];
    }
    __syncthreads();
#undef CV_NEXT
}
__device__ __forceinline__ void p0_prologue(Frame& F) {
    LAS float* scr = (LAS float*)(F.lds + RING_OFF + F.wave * 16384);
    const int gw = F.vcu * NWAVES + F.wave, NGW = F.G * NWAVES;
    cv_run(F, gw, NGW, I_A, scr);
    const int gt = gw * 64 + F.lane, NGT = NGW * 64;
    for (int idx = gt; idx < NRT * DM; idx += NGT) { const int c = idx / DM, k = idx - c * DM; float v = 0.f;
        if (c < 4) v = F.w_group[(size_t)k * 4 + c]; else if (c < 36) v = F.w_er[((size_t)((c - 4) >> 3) * DM + k) * 8 + ((c - 4) & 7)];
        F.WrT[idx] = (bf16)(cvt_pk_bf16(v, 0.f) & 0xffffu); }
    for (size_t i = gt; i < (size_t)M * DM / 8; i += NGT) { const f32x4 a = *(const f32x4*)(F.x + 8 * i), b = *(const f32x4*)(F.x + 8 * i + 4);
        v4u o; o.x = cvt_pk_bf16(a[0], a[1]); o.y = cvt_pk_bf16(a[2], a[3]); o.z = cvt_pk_bf16(b[0], b[1]); o.w = cvt_pk_bf16(b[2], b[3]); *(GAS v4u*)(F.XB + 8 * i) = o; }
    for (size_t i = gt; i < (size_t)M * PLE / 8; i += NGT) { const f32x4 a = *(const f32x4*)(F.p + 8 * i), b = *(const f32x4*)(F.p + 8 * i + 4);
        v4u o; o.x = cvt_pk_bf16(a[0], a[1]); o.y = cvt_pk_bf16(a[2], a[3]); o.z = cvt_pk_bf16(b[0], b[1]); o.w = cvt_pk_bf16(b[2], b[3]); *(GAS v4u*)(F.PB + 8 * i) = o; }
    for (int idx = gt; idx < M * 32; idx += NGT) { const int m = idx >> 5, pr = idx & 31;
        const float ang = (float)F.positions[m] * (float)ROPE_INV_FREQ[pr];
        const double rev = (double)ang * 0.15915494309189535; const float fr = (float)(rev - __builtin_floor(rev));
        F.cs[2 * (size_t)idx] = __builtin_amdgcn_cosf(fr); F.cs[2 * (size_t)idx + 1] = __builtin_amdgcn_sinf(fr); }
}

__device__ __forceinline__ int crow(int r, int hi) { return (r & 3) + 8 * (r >> 2) + 4 * hi; }
__device__ __forceinline__ s16x4 tr_read(const LAS unsigned char* p) {
    typedef short v4i16_t __attribute__((ext_vector_type(4)));
    return __builtin_bit_cast(s16x4, __builtin_amdgcn_ds_read_tr16_b64_v4i16((LAS v4i16_t*)p)); }
__device__ __forceinline__ bf16x8 pack8(const f32x16& x, int s) {
    v4u p; p.x = cvt_pk_bf16(x[8 * s], x[8 * s + 1]); p.y = cvt_pk_bf16(x[8 * s + 2], x[8 * s + 3]); p.z = cvt_pk_bf16(x[8 * s + 4], x[8 * s + 5]); p.w = cvt_pk_bf16(x[8 * s + 6], x[8 * s + 7]);
    return __builtin_bit_cast(bf16x8, p); }

#define GLDS16(gptr, ldsptr) __builtin_amdgcn_global_load_lds((const unsigned*)(gptr), (LAS unsigned*)(ldsptr), 16, 0, 0)
#define ATT_WAIT_V(n) asm volatile("s_waitcnt vmcnt(" #n ")" ::: "memory")
#define ATT_WAIT_L() asm volatile("s_waitcnt lgkmcnt(0)" ::: "memory")
template <int NDQ>
__device__ __forceinline__ void att_issue(const unsigned char* base, unsigned loff, LAS unsigned char* img) {
#pragma unroll
    for (int kh = 0; kh < 2; ++kh)
#pragma unroll
        for (int dq = 0; dq < NDQ; ++dq) GLDS16(base + (size_t)kh * (16 * NIN * 2) + dq * 64 + loff, img + (kh * NDQ + dq) * 1024);
}

#define SB_ISSUE(KF, b, key0) do { const bf16* kr_ = kbase + (size_t)(key0) * NIN; \
    _Pragma("unroll") for (int s = 0; s < 8; ++s) KF[s] = *(const bf16x8*)(kr_ + 16 * s); \
    att_issue<4>(vg + (size_t)(key0) * (NIN * 2), voff, vimg + (b) * 8192); } while (0)
#define SB_TILE(KF, b, k0, NEXT) do { \
        f32x16 z; \
        _Pragma("unroll") for (int i = 0; i < 16; ++i) z[i] = 0.f; \
        _Pragma("unroll") for (int s = 0; s < 8; ++s) z = MFMA32(KF[s], qf[s], z); \
        const int cdiag = ((k0) == s0) ? c : 64;                            \
        float L[16], G[4]; \
        _Pragma("unroll") for (int i = 0; i < 16; ++i) { const float z2 = z[i], e = __builtin_amdgcn_exp2f(-__builtin_fabsf(z2)); \
            float l = __builtin_fmaxf(z2, 0.f) + __builtin_amdgcn_logf(1.0f + e);         \
            if (crow(i, hh) >= cdiag) l = 0.f;                                                 \
            L[i] = l; } \
        _Pragma("unroll") for (int g = 0; g < 4; ++g) G[g] = (L[4 * g] + L[4 * g + 1]) + (L[4 * g + 2] + L[4 * g + 3]); \
        f32x2 GP[4]; \
        _Pragma("unroll") for (int g = 0; g < 4; ++g) GP[g] = pair32(G[g]);                                   \
        float after[4]; float tail = 0.f;                                                   \
        _Pragma("unroll") for (int g = 3; g >= 0; --g) { after[g] = tail + (hh ? 0.f : GP[g].y); tail += GP[g].x + GP[g].y; } \
        f32x16 pt; \
        _Pragma("unroll") for (int g = 0; g < 4; ++g) { float run = carry + after[g]; \
            _Pragma("unroll") for (int u = 3; u >= 0; --u) { const int i = 4 * g + u; run += L[i]; \
                float a = __builtin_amdgcn_exp2f(z[i] - run); \
                if (crow(i, hh) >= cdiag) a = 0.f; \
                pt[i] = a; } } \
        carry += tail; \
        if (NEXT) ATT_WAIT_V(16); else ATT_WAIT_V(0);                       \
        const LAS unsigned char* vb = vimg + (b) * 8192 + trb; \
        _Pragma("unroll") for (int s2 = 0; s2 < 2; ++s2) { const bf16x8 pb = pack8(pt, s2); \
            _Pragma("unroll") for (int db = 0; db < 4; ++db) { \
                const s16x4 lo = tr_read(vb + (s2 * 4 + db) * 1024), hi = tr_read(vb + (s2 * 4 + db) * 1024 + 512); \
                const bf16x8 va = __builtin_shufflevector(lo, hi, 0, 1, 2, 3, 4, 5, 6, 7); \
                o[db] = MFMA32(va, pb, o[db]); } } \
    } while (0)
__device__ __forceinline__ float sb_head(const Frame& F, int m0, int s0, int h, LAS unsigned char* vimg, const LAS float* gl) {
    int lane_ = F.lane; asm volatile("" : "+v"(lane_));
    const int lane = lane_, c = lane & 31, hh = lane >> 5;
    const bf16* qrow = F.QKV + (size_t)(m0 + c) * NIN + QB0 + h * 128 + 8 * hh;
    bf16x8 qf[8];
#pragma unroll
    for (int s = 0; s < 8; ++s) qf[s] = *(const bf16x8*)(qrow + 16 * s);
    f32x16 o[4];
#pragma unroll
    for (int d = 0; d < 4; ++d)
#pragma unroll
        for (int i = 0; i < 16; ++i) o[d][i] = 0.f;
    float carry = 0.f;
    const int rowbase = m0 - s0;
    const int q4 = (lane & 15) >> 2, p4 = lane & 3, g1 = (lane >> 4) & 1;
    const int trb = (4 * hh + q4) * 64 + (16 * g1 + 4 * p4) * 2;
    const unsigned voff = (unsigned)((lane >> 2) * (NIN * 2) + (lane & 3) * 16);
    const bf16* kbase = F.QKV + (size_t)(rowbase + c) * NIN + KB0 + h * 128 + 8 * hh;
    const unsigned char* vg = (const unsigned char*)(F.QKV + (size_t)rowbase * NIN + VB0 + h * 128);
    int kt = s0 >> 5;
    bf16x8 kf[8], kn[8];
    SB_ISSUE(kf, 0, kt * 32);
    if (kt > 0) SB_ISSUE(kn, 1, kt * 32 - 32);
    for (;;) {
        SB_TILE(kf, 0, kt * 32, kt > 0);
        if (kt == 0 || __all(carry > SB_STOP)) break;
        if (kt >= 2) { ATT_WAIT_L(); SB_ISSUE(kf, 0, kt * 32 - 64); }
        --kt;
        SB_TILE(kn, 1, kt * 32, kt > 0);
        if (kt == 0 || __all(carry > SB_STOP)) break;
        if (kt >= 2) { ATT_WAIT_L(); SB_ISSUE(kn, 1, kt * 32 - 64); }
        --kt;
    }
    ATT_WAIT_V(0);
    ATT_WAIT_L();
    float ssq = 0.f;
    LAS unsigned char* ot = vimg;
    const LAS float* gp = gl + 2048 + h * 128;
    const int OCOL = 2048 + h * 128;
#pragma unroll
    for (int db = 0; db < 4; ++db)
#pragma unroll
        for (int g = 0; g < 4; ++g) { const int d0 = 32 * db + 8 * g + 4 * hh; const f32x4 gv = *(const LAS f32x4*)(gp + d0);
            const float a0 = o[db][4 * g], a1 = o[db][4 * g + 1], a2 = o[db][4 * g + 2], a3 = o[db][4 * g + 3];
            ssq += (a0 * a0 + a1 * a1) + (a2 * a2 + a3 * a3);
            if (OCOL >= OKS) *(LAS unsigned*)(ot + c * 144 + d0) = pg8::cvt_pk_fp8x4(a0 * gv[0] * 8.0f, a1 * gv[1] * 8.0f, a2 * gv[2] * 8.0f, a3 * gv[3] * 8.0f);
            else { v2u w; w.x = cvt_pk_bf16(a0 * gv[0], a1 * gv[1]); w.y = cvt_pk_bf16(a2 * gv[2], a3 * gv[3]); *(LAS v2u*)(ot + c * 272 + d0 * 2) = w; } }
    asm volatile("" ::: "memory");
    if (OCOL >= OKS) { unsigned char* ob = (unsigned char*)F.O + (size_t)(m0 + (lane >> 3)) * pg8::ORB + (2 * OKS + OCOL - OKS) + (lane & 7) * 16;
#pragma unroll
      for (int k = 0; k < 4; ++k) { const v4u val = *(const LAS v4u*)(ot + (8 * k + (lane >> 3)) * 144 + (lane & 7) * 16); *(GAS v4u*)(ob + (size_t)(8 * k) * pg8::ORB) = val; } }
    else { unsigned char* ob = (unsigned char*)F.O + (size_t)(m0 + (lane >> 4)) * pg8::ORB + 2 * OCOL + (lane & 15) * 16;
#pragma unroll
      for (int k = 0; k < 8; ++k) { const v4u val = *(const LAS v4u*)(ot + (4 * k + (lane >> 4)) * 272 + (lane & 15) * 16); *(GAS v4u*)(ob + (size_t)(4 * k) * pg8::ORB) = val; } }
    ATT_WAIT_L();
    const f32x2 sp = pair32(ssq);
    return sp.x + sp.y;
}

__device__ __forceinline__ float swa_pair(const Frame& F, int m0, int s0, int hq, LAS unsigned char* vimg, const LAS float* gl) {
    int lane_ = F.lane; asm volatile("" : "+v"(lane_));
    const int lane = lane_, c = lane & 31, hh = lane >> 5, kvh = hq >> 3;
    LAS unsigned char* kimg = vimg + 8192;
    const bf16* qrow = F.QKV + (size_t)(m0 + c) * NIN + QA0 + hq * 64 + 8 * hh;
    bf16x8 qa[4], qb[4];
#pragma unroll
    for (int s = 0; s < 4; ++s) { qa[s] = *(const bf16x8*)(qrow + 16 * s); qb[s] = *(const bf16x8*)(qrow + 64 + 16 * s); }
    f32x16 oa[2], ob[2];
#pragma unroll
    for (int d = 0; d < 2; ++d)
#pragma unroll
        for (int i = 0; i < 16; ++i) { oa[d][i] = 0.f; ob[d][i] = 0.f; }
    float mxa = F.sinks[hq] * LOG2E, mxb = F.sinks[hq + 1] * LOG2E, la = 1.0f, lb = 1.0f;
    const int rowbase = m0 - s0;
    const int q4 = (lane & 15) >> 2, p4 = lane & 3, g1 = (lane >> 4) & 1;
    const int trb = (4 * hh + q4) * 64 + (16 * g1 + 4 * p4) * 2;
    const unsigned voff = (unsigned)((lane >> 2) * (NIN * 2) + (lane & 3) * 16);
    const unsigned koff = (unsigned)((lane >> 2) * (NIN * 2) + (((lane & 3) ^ ((lane >> 4) & 3)) * 16));
    const unsigned char* kg = (const unsigned char*)(F.QKV + (size_t)rowbase * NIN + KA0 + kvh * 64);
    const unsigned char* vg = (const unsigned char*)(F.QKV + (size_t)rowbase * NIN + VA0 + kvh * 64);
    const int x4 = (c >> 2) & 3;
    const int kr0 = (c >> 4) * 2048 + (c & 15) * 64 + ((hh ^ x4) << 4), kr1 = (c >> 4) * 2048 + (c & 15) * 64 + (((2 + hh) ^ x4) << 4);
    int j = (s0 >= 128) ? 0 : (128 - s0) >> 5;
#define SWA_ISSUE(jj) do { const ptrdiff_t ko_ = (ptrdiff_t)(s0 - 128 + 32 * (jj)) * (NIN * 2); const int b_ = ((jj) & 1) * 4096; \
        att_issue<2>(kg + ko_, koff, kimg + b_); att_issue<2>(vg + ko_, voff, vimg + b_); } while (0)
    SWA_ISSUE(j);
    if (j < 4) SWA_ISSUE(j + 1);
#pragma unroll 1
    for (; j < 5; ++j) {
        const int bo = (j & 1) * 4096;
        if (j < 4) ATT_WAIT_V(8); else ATT_WAIT_V(0);
        bf16x8 kf[4];
#pragma unroll
        for (int s = 0; s < 4; ++s) kf[s] = *(const LAS bf16x8*)(kimg + bo + ((s & 1) ? kr1 : kr0) + (s >> 1) * 1024);
        f32x16 za, zb;
#pragma unroll
        for (int i = 0; i < 16; ++i) { za[i] = 0.f; zb[i] = 0.f; }
#pragma unroll
        for (int s = 0; s < 4; ++s) { za = MFMA32(kf[s], qa[s], za); zb = MFMA32(kf[s], qb[s], zb); }
        const int wlo = (j == 0) ? c : -1, whi = (j == 4) ? c : 64;
        float tma = -1e30f, tmb = -1e30f;
#pragma unroll
        for (int i = 0; i < 16; ++i) { const int r = crow(i, hh); if (r <= wlo || r > whi) { za[i] = -1e30f; zb[i] = -1e30f; }
            tma = __builtin_fmaxf(tma, za[i]); tmb = __builtin_fmaxf(tmb, zb[i]); }
        const f32x2 tpa = pair32(tma), tpb = pair32(tmb);
        const float mna = __builtin_fmaxf(mxa, __builtin_fmaxf(tpa.x, tpa.y)), ala = __builtin_amdgcn_exp2f(mxa - mna);
        const float mnb = __builtin_fmaxf(mxb, __builtin_fmaxf(tpb.x, tpb.y)), alb = __builtin_amdgcn_exp2f(mxb - mnb);
        f32x16 pa, pb; float psa = 0.f, psb = 0.f;
#pragma unroll
        for (int i = 0; i < 16; ++i) { pa[i] = __builtin_amdgcn_exp2f(za[i] - mna); psa += pa[i]; pb[i] = __builtin_amdgcn_exp2f(zb[i] - mnb); psb += pb[i]; }
        const f32x2 ppa = pair32(psa), ppb = pair32(psb);
        la = la * ala + (ppa.x + ppa.y); mxa = mna; lb = lb * alb + (ppb.x + ppb.y); mxb = mnb;
#pragma unroll
        for (int d = 0; d < 2; ++d)
#pragma unroll
            for (int i = 0; i < 16; ++i) { oa[d][i] *= ala; ob[d][i] *= alb; }
        const LAS unsigned char* vb = vimg + bo + trb;
#pragma unroll
        for (int s2 = 0; s2 < 2; ++s2) { const bf16x8 fa = pack8(pa, s2), fb = pack8(pb, s2);
#pragma unroll
            for (int db = 0; db < 2; ++db) {
                const s16x4 lo = tr_read(vb + (s2 * 2 + db) * 1024), hi = tr_read(vb + (s2 * 2 + db) * 1024 + 512);
                const bf16x8 va = __builtin_shufflevector(lo, hi, 0, 1, 2, 3, 4, 5, 6, 7);
                oa[db] = MFMA32(va, fa, oa[db]); ob[db] = MFMA32(va, fb, ob[db]); } }
        if (j < 3) { ATT_WAIT_L(); SWA_ISSUE(j + 2); }
    }
#undef SWA_ISSUE
    const float inva = 1.0f / la, invb = 1.0f / lb;
    ATT_WAIT_L();
    float ssq = 0.f;
    LAS unsigned char* ot = vimg;
    const LAS float* gp = gl + hq * 64;
    const int OCOL = hq * 64;
#pragma unroll
    for (int db = 0; db < 2; ++db)
#pragma unroll
        for (int g = 0; g < 4; ++g) { const int d0 = 32 * db + 8 * g + 4 * hh; const f32x4 gva = *(const LAS f32x4*)(gp + d0), gvb = *(const LAS f32x4*)(gp + 64 + d0);
            const float a0 = oa[db][4 * g] * inva, a1 = oa[db][4 * g + 1] * inva, a2 = oa[db][4 * g + 2] * inva, a3 = oa[db][4 * g + 3] * inva;
            const float b0 = ob[db][4 * g] * invb, b1 = ob[db][4 * g + 1] * invb, b2 = ob[db][4 * g + 2] * invb, b3 = ob[db][4 * g + 3] * invb;
            ssq += ((a0 * a0 + a1 * a1) + (a2 * a2 + a3 * a3)) + ((b0 * b0 + b1 * b1) + (b2 * b2 + b3 * b3));
            if (OCOL >= OKS) { *(LAS unsigned*)(ot + c * 144 + d0) = pg8::cvt_pk_fp8x4(a0 * gva[0] * 8.0f, a1 * gva[1] * 8.0f, a2 * gva[2] * 8.0f, a3 * gva[3] * 8.0f);
                *(LAS unsigned*)(ot + c * 144 + 64 + d0) = pg8::cvt_pk_fp8x4(b0 * gvb[0] * 8.0f, b1 * gvb[1] * 8.0f, b2 * gvb[2] * 8.0f, b3 * gvb[3] * 8.0f); }
            else { v2u w; w.x = cvt_pk_bf16(a0 * gva[0], a1 * gva[1]); w.y = cvt_pk_bf16(a2 * gva[2], a3 * gva[3]); *(LAS v2u*)(ot + c * 272 + d0 * 2) = w;
                v2u x; x.x = cvt_pk_bf16(b0 * gvb[0], b1 * gvb[1]); x.y = cvt_pk_bf16(b2 * gvb[2], b3 * gvb[3]); *(LAS v2u*)(ot + c * 272 + 128 + d0 * 2) = x; } }
    asm volatile("" ::: "memory");
    if (OCOL >= OKS) { unsigned char* obp = (unsigned char*)F.O + (size_t)(m0 + (lane >> 3)) * pg8::ORB + (2 * OKS + OCOL - OKS) + (lane & 7) * 16;
#pragma unroll
      for (int k = 0; k < 4; ++k) { const v4u val = *(const LAS v4u*)(ot + (8 * k + (lane >> 3)) * 144 + (lane & 7) * 16); *(GAS v4u*)(obp + (size_t)(8 * k) * pg8::ORB) = val; } }
    else { unsigned char* obp = (unsigned char*)F.O + (size_t)(m0 + (lane >> 4)) * pg8::ORB + 2 * OCOL + (lane & 15) * 16;
#pragma unroll
      for (int k = 0; k < 8; ++k) { const v4u val = *(const LAS v4u*)(ot + (4 * k + (lane >> 4)) * 272 + (lane & 15) * 16); *(GAS v4u*)(obp + (size_t)(4 * k) * pg8::ORB) = val; } }
    ATT_WAIT_L();
    const f32x2 sp = pair32(ssq);
    return sp.x + sp.y;
}

__device__ __forceinline__ void p2_attention(Frame& F) {
    LAS unsigned char* vimg = F.lds + F.wave * ATT_VIMG;
    LAS float* red = (LAS float*)(F.lds + ATT_RED);
    LAS float* gl = (LAS float*)(F.lds + ATT_G);
    { const int i4 = 4 * F.tid;
      *(LAS f32x4*)(gl + i4) = *(const f32x4*)(F.g_a + i4); *(LAS f32x4*)(gl + 2048 + i4) = *(const f32x4*)(F.g_b + i4); }
    __syncthreads();
    for (int u = F.vcu; u < M / 32; u += F.G) {
        const int m0 = 32 * u, s0 = m0 & (SEQ - 1);
        float sa = 0.f, sb = 0.f;
        if (F.wave >= 4) __builtin_amdgcn_s_setprio(1); else __builtin_amdgcn_s_setprio(0);
#pragma unroll 1
        for (int i = 0; i < 2; ++i) sa += swa_pair(F, m0, s0, 4 * F.wave + 2 * i, vimg, gl);
        if (F.wave >= 4) __builtin_amdgcn_s_setprio(0); else __builtin_amdgcn_s_setprio(1);
#pragma unroll 1
        for (int i = 0; i < 2; ++i) sb += sb_head(F, m0, s0, 2 * F.wave + i, vimg, gl);
        __builtin_amdgcn_s_setprio(0);
        if (F.lane < 32) { red[(F.wave * 32 + F.lane) * 2] = sa; red[(F.wave * 32 + F.lane) * 2 + 1] = sb; }
        __syncthreads();
        if (F.tid < 32) { float ta = 0.f, tb = 0.f;
#pragma unroll
            for (int w = 0; w < 8; ++w) { ta += red[(w * 32 + F.tid) * 2]; tb += red[(w * 32 + F.tid) * 2 + 1]; }
            F.rr[2 * (size_t)(m0 + F.tid)] = 1.0f / __builtin_sqrtf(ta * (1.0f / 2048.0f) + RMS_EPS);
            F.rr[2 * (size_t)(m0 + F.tid) + 1] = 1.0f / __builtin_sqrtf(tb * (1.0f / 2048.0f) + RMS_EPS); }
        __syncthreads();
    }
}

__device__ __forceinline__ void p4_ln1_router(Frame& F, float* x1dst, int cw_cnt) {
    LAS unsigned char* ximg = F.lds;
    LAS float* red = (LAS float*)(F.lds + LN_RED);
    LAS float* lg = (LAS float*)(F.lds + LN_LOG);
    LAS float* bt = (LAS float*)(F.lds + LN_LOG + 3072);
    const int lane = F.lane, w = F.wave;
    if (F.tid < NRT) bt[F.tid] = F.tid < 4 ? F.b_group[F.tid] : (F.tid < 36 ? F.b_er[F.tid - 4] : 0.f);
    for (int it = F.vcu; it < M / 16; it += F.G) {
        const int row0 = 16 * it;
        v4u raw[2][8];
#pragma unroll
        for (int r2 = 0; r2 < 2; ++r2)
#pragma unroll
            for (int j = 0; j < 8; ++j) raw[r2][j] = *(const GAS v4u*)(F.Y1B + (size_t)(row0 + 2 * w + r2) * DM + 8 * lane + 512 * j);
#define LN_DEC(wd, lo4, hi4) const f32x4 lo4 = {__uint_as_float((wd).x << 16), __uint_as_float((wd).x & 0xffff0000u), __uint_as_float((wd).y << 16), __uint_as_float((wd).y & 0xffff0000u)}, \
                                         hi4 = {__uint_as_float((wd).z << 16), __uint_as_float((wd).z & 0xffff0000u), __uint_as_float((wd).w << 16), __uint_as_float((wd).w & 0xffff0000u)}
        float mean[2], rstd[2];
#pragma unroll
        for (int r2 = 0; r2 < 2; ++r2) { float s = 0.f;
#pragma unroll
            for (int j = 0; j < 8; ++j) { LN_DEC(raw[r2][j], a, b); s += ((a[0] + a[1]) + (a[2] + a[3])) + ((b[0] + b[1]) + (b[2] + b[3])); }
            mean[r2] = wave_sum(s) * (1.0f / DM); float q = 0.f;
#pragma unroll
            for (int j = 0; j < 8; ++j) { LN_DEC(raw[r2][j], a0, b0); const f32x4 a = a0 - mean[r2], b = b0 - mean[r2]; q += ((a[0] * a[0] + a[1] * a[1]) + (a[2] * a[2] + a[3] * a[3])) + ((b[0] * b[0] + b[1] * b[1]) + (b[2] * b[2] + b[3] * b[3])); }
            rstd[r2] = 1.0f / __builtin_sqrtf(wave_sum(q) * (1.0f / DM) + LN_EPS);
            if (lane == 0) *(f32x2*)(x1dst + 2 * (size_t)(row0 + 2 * w + r2)) = (f32x2){mean[r2], rstd[r2]}; }
#pragma unroll
        for (int j = 0; j < 8; ++j) { const int col = 8 * lane + 512 * j;
            const f32x4 g0 = *(const f32x4*)(F.ln1_g + col), g1 = *(const f32x4*)(F.ln1_g + col + 4), b0 = *(const f32x4*)(F.ln1_b + col), b1 = *(const f32x4*)(F.ln1_b + col + 4);
#pragma unroll
            for (int r2 = 0; r2 < 2; ++r2) { const int lr = 2 * w + r2, row = row0 + lr;
                LN_DEC(raw[r2][j], ya, yc);
                const f32x4 xa = (ya - mean[r2]) * rstd[r2] * g0 + b0, xc = (yc - mean[r2]) * rstd[r2] * g1 + b1;
                v4u pk; pk.x = cvt_pk_bf16(xa[0], xa[1]); pk.y = cvt_pk_bf16(xa[2], xa[3]); pk.z = cvt_pk_bf16(xc[0], xc[1]); pk.w = cvt_pk_bf16(xc[2], xc[3]);
                v2u p8; p8.x = pg8::cvt_pk_fp8x4(xa[0], xa[1], xa[2], xa[3]); p8.y = pg8::cvt_pk_fp8x4(xc[0], xc[1], xc[2], xc[3]);
                *(GAS v2u*)(F.X18 + (size_t)row * DM + col) = p8;
                *(LAS v4u*)(ximg + lr * LN_ROWB + col * 2) = pk; }
            if ((j & 1) == 1) asm volatile("" ::: "memory"); }
#undef LN_DEC
        __syncthreads();
        f32x4 acc[3];
#pragma unroll
        for (int cb = 0; cb < 3; ++cb) acc[cb] = (f32x4){0.f, 0.f, 0.f, 0.f};
#pragma unroll 8
        for (int ks = 0; ks < 16; ++ks) { const int k0 = 512 * w + 32 * ks + 8 * (lane >> 4);
            const bf16x8 a = *(const LAS bf16x8*)(ximg + (lane & 15) * LN_ROWB + k0 * 2);
#pragma unroll
            for (int cb = 0; cb < 3; ++cb) { const bf16x8 b = *(const bf16x8*)(F.WrT + (size_t)(16 * cb + (lane & 15)) * DM + k0); acc[cb] = MFMA16(a, b, acc[cb]); } }
#pragma unroll
        for (int cb = 0; cb < 3; ++cb)
#pragma unroll
            for (int j = 0; j < 4; ++j) red[(w * 16 + 4 * (lane >> 4) + j) * NRT + 16 * cb + (lane & 15)] = acc[cb][j];
        __syncthreads();
        for (int idx = F.tid; idx < 16 * NRT; idx += NWAVES * 64) { float t = 0.f;
#pragma unroll
            for (int ww = 0; ww < 8; ++ww) t += red[ww * 16 * NRT + idx];
            lg[idx] = t + bt[idx % NRT]; }
        __syncthreads();
        if (F.tid < 16) {
            const int tok = row0 + F.tid; const LAS float* lp = lg + F.tid * NRT;
            float gl[4]; int gi = 0;
#pragma unroll
            for (int cgi = 0; cgi < 4; ++cgi) gl[cgi] = lp[cgi];
#pragma unroll
            for (int cgi = 1; cgi < 4; ++cgi) if (gl[cgi] > gl[gi]) gi = cgi;
            float den = 0.f;
#pragma unroll
            for (int cgi = 0; cgi < 4; ++cgi) den += __expf(gl[cgi] - gl[gi]);
            const float gw = 1.0f / den;
            float el[8];
#pragma unroll
            for (int e = 0; e < 8; ++e) el[e] = lp[4 + 8 * gi + e];
            int i0 = 0;
#pragma unroll
            for (int e = 1; e < 8; ++e) if (el[e] > el[i0]) i0 = e;
            int i1 = (i0 == 0) ? 1 : 0;
#pragma unroll
            for (int e = 0; e < 8; ++e) if (e != i0 && el[e] > el[i1]) i1 = e;
            const float w0 = 1.0f / (1.0f + __expf(el[i1] - el[i0])), w1 = 1.0f - w0;
            const int e0 = 8 * gi + i0, e1 = 8 * gi + i1;
            const unsigned sl0 = __hip_atomic_fetch_add(F.ctl + cw_cnt + 64 * e0, 1u, RLX_AGENT);
            const unsigned sl1 = __hip_atomic_fetch_add(F.ctl + cw_cnt + 64 * e1, 1u, RLX_AGENT);
            F.list[e0 * M + sl0] = 2 * tok; F.list[e1 * M + sl1] = 2 * tok + 1;
            F.wts[2 * tok] = w0 * gw; F.wts[2 * tok + 1] = w1 * gw;
        }
    }
}

__device__ __forceinline__ void build_tab(Frame& F) {
    LAS int* tab = (LAS int*)(F.lds + TAB_OFF);
    __syncthreads();
    if (F.tid < NEXP) tab[33 + F.tid] = (int)__hip_atomic_load(F.ctl + CW_CNT + 64 * F.tid, RLX_AGENT);
    __syncthreads();
    if (F.tid == 0) { int a = 0; for (int e = 0; e < NEXP; ++e) { tab[e] = a; a += (tab[33 + e] + 255) >> 8; } tab[32] = a; }
    __syncthreads();
}

__device__ __forceinline__ void p9_ln2(Frame& F, float* dst) {
    const int gw = F.vcu * NWAVES + F.wave, NGW = F.G * NWAVES, lane = F.lane;
    for (int row = gw; row < M; row += NGW) {
        const bf16* y2 = F.Y2B + (size_t)row * DM + 8 * lane;
        const bf16* m0 = F.MOE + (size_t)row * DM + 8 * lane; const bf16* m1 = m0 + (size_t)M * DM;
        f32x4 v[16]; float s = 0.f;
#pragma unroll
        for (int j = 0; j < 8; ++j) { const v4u y = *(const GAS v4u*)(y2 + 512 * j), a = *(const GAS v4u*)(m0 + 512 * j), b = *(const GAS v4u*)(m1 + 512 * j);
#define BF3(f) ((__uint_as_float((y.f) << 16) + __uint_as_float((a.f) << 16)) + __uint_as_float((b.f) << 16))
#define BF3H(f) ((__uint_as_float((y.f) & 0xffff0000u) + __uint_as_float((a.f) & 0xffff0000u)) + __uint_as_float((b.f) & 0xffff0000u))
            v[2 * j] = (f32x4){BF3(x), BF3H(x), BF3(y), BF3H(y)}; v[2 * j + 1] = (f32x4){BF3(z), BF3H(z), BF3(w), BF3H(w)};
#undef BF3
#undef BF3H
            s += ((v[2 * j][0] + v[2 * j][1]) + (v[2 * j][2] + v[2 * j][3])) + ((v[2 * j + 1][0] + v[2 * j + 1][1]) + (v[2 * j + 1][2] + v[2 * j + 1][3]));
            if ((j & 1) == 1) asm volatile("" ::: "memory"); }
        const float mean = wave_sum(s) * (1.0f / DM); float q = 0.f;
#pragma unroll
        for (int j = 0; j < 16; ++j) { v[j] = v[j] - mean; q += (v[j][0] * v[j][0] + v[j][1] * v[j][1]) + (v[j][2] * v[j][2] + v[j][3] * v[j][3]); }
        const float rstd = 1.0f / __builtin_sqrtf(wave_sum(q) * (1.0f / DM) + LN_EPS);
#pragma unroll
        for (int j = 0; j < 8; ++j) { const int col = 8 * lane + 512 * j;
            const f32x4 g0 = *(const f32x4*)(F.ln2_g + col), g1 = *(const f32x4*)(F.ln2_g + col + 4), b0 = *(const f32x4*)(F.ln2_b + col), b1 = *(const f32x4*)(F.ln2_b + col + 4);
            *(f32x4*)(dst + (size_t)row * DM + col) = v[2 * j] * rstd * g0 + b0; *(f32x4*)(dst + (size_t)row * DM + col + 4) = v[2 * j + 1] * rstd * g1 + b1;
            if ((j & 1) == 1) asm volatile("" ::: "memory"); }
    }
}

__global__ void __launch_bounds__(NWAVES * 64, 2) hymba_fwd(Args args) {
    extern __shared__ __attribute__((aligned(16))) unsigned char lds[];
    Frame F;
    F.lds = (LAS unsigned char*)lds;
    F.MISC = (volatile LAS unsigned*)(F.lds + MISC_OFF);
    F.wave0 = __builtin_amdgcn_readfirstlane((int)threadIdx.x >> 6);
#define KTID() (F.wave0 * 64 + hw_lane())
    F.tid = KTID(); F.lane = F.tid & 63; F.wave = F.wave0;
    F.G = gridDim.x; { const int bx = blockIdx.x; F.vcu = (F.G % 8 == 0) ? (bx % 8) * (F.G / 8) + bx / 8 : bx; }
    F.ctl = (gu32*)(args.ws + WS_CTL);
    for (int u = KTID(); u < (LDS_BYTES - MISC_OFF) / 4; u += NWAVES * 64) ((LAS unsigned*)(F.lds + MISC_OFF))[u] = 0u;
    __syncthreads();
    XcdBarrier bar; bar.bar = (unsigned*)(F.ctl + CW_BAR); bar.x = 0; bar.st = nullptr;
    const unsigned ctl_tag = (((unsigned)(size_t)__builtin_amdgcn_dispatch_ptr() >> 6) << 1) | 1u;
    if (N_LAUNCHES == 1 && blockIdx.x == 0) {
        for (int u = KTID(); u < (int)(CTL_ZERO_BYTES / 4); u += NWAVES * 64) __hip_atomic_store(F.ctl + u, 0u, RLX_AGENT);
        __builtin_amdgcn_fence(__ATOMIC_RELEASE, "agent");
        asm volatile("s_waitcnt vmcnt(0)" ::: "memory");
        __syncthreads();
        if (KTID() == 0) __hip_atomic_store(F.ctl + CW_READY, ctl_tag, __ATOMIC_RELEASE, __HIP_MEMORY_SCOPE_AGENT);
    }
    bool ctl_ready = (N_LAUNCHES != 1);
#define CTL_READY() do { if (!ctl_ready) { ctl_ready = true; \
        if (KTID() == 0) { unsigned sp_ = 0; while (__hip_atomic_load(F.ctl + CW_READY, __ATOMIC_ACQUIRE, __HIP_MEMORY_SCOPE_AGENT) != ctl_tag) { __builtin_amdgcn_s_sleep(2); if (++sp_ > (1u << 22)) break; } } \
        __syncthreads(); bar = xcd_barrier_post((unsigned*)(F.ctl + CW_BAR), F.MISC + 8, KTID() == 0); } } while (0)
#define GRID_BAR() do { if (N_LAUNCHES == 1) { CTL_READY(); xcd_barrier(bar, KTID() == 0); } } while (0)
    const int lo = args.ph_lo, hi = args.ph_hi;
#ifndef PH_MASK
#define PH_MASK 0x3ff
#endif
#define IN(k) (((PH_MASK >> (k)) & 1) && lo <= (k) && (k) < hi)
#define BOTH(k) (IN(k) && IN((k) + 1))
#ifndef PROBE_REP
#define PROBE_REP 0
#endif
#define REP(k) (((PROBE_REP >> (k)) & 1) ? 2 : 1)
    const LAS int* tab = (const LAS int*)(F.lds + TAB_OFF);

    if (IN(0)) { Frame P = F; fill_ptrs(P); for (int rep = 0; rep < REP(0); ++rep) p0_prologue(P); if (BOTH(0)) GRID_BAR(); }
    if (IN(1)) { Frame P = F; fill_ptrs(P);
        { pg8::Gemm g{P.PB, P.WpT, M, DM, PLE}; pg8::StaticOrder S; S.init(M, DM, F.G, (int)blockIdx.x);
          pg8::EpiPlainBf16 E{P.PP, DM};
          pg8::gemm_phase<pg8::EpiPlainBf16, pg8::StaticOrder, true, true>(F.lds + RING_OFF, g, S, E, P.tid); }
        const int NG = (F.G == 256) ? 218 : F.G;
        if ((int)blockIdx.x < NG) { pg8::Gemm g{P.XB, P.WinT, M, NIN, DM}; pg8::StaticOrder S; S.init(M, NIN, NG, (int)blockIdx.x);
          pg8::EpiProj E{P.QKV, P.b_in, P.cs};
          for (int rep = 0; rep < REP(1); ++rep) pg8::gemm_phase<pg8::EpiProj, pg8::StaticOrder, true, true>(F.lds + RING_OFF, g, S, E, P.tid); }
        conv_queue(P);
        if (BOTH(1)) GRID_BAR();
    }
    if (IN(2)) { Frame P = F; fill_ptrs(P); for (int rep = 0; rep < REP(2); ++rep) p2_attention(P); if (BOTH(2)) GRID_BAR(); }
    if (IN(3)) { Frame P = F; fill_ptrs(P);
        pg8::Gemm g{P.O, P.WoutT, M, DM, D_FP8 ? pg8::ORB : DM}; pg8::StaticOrder S; S.init(M, DM, F.G, (int)blockIdx.x);
        pg8::EpiWout E{P.XB, P.Y1B, P.b_out, P.rr};
        for (int rep = 0; rep < REP(3); ++rep) pg8::gemm_phase<pg8::EpiWout, pg8::StaticOrder, true, true, D_FP8 ? 1 : 2, pg8::O_TSPLIT, D_FP8 ? 0x79797979 : 0x7c7c7c7c>(F.lds + RING_OFF, g, S, E, P.tid);
        if (BOTH(3)) GRID_BAR();
    }
    if (IN(4)) { Frame P = F; fill_ptrs(P);
        p4_ln1_router(P, P.stats, CW_CNT); if (BOTH(4)) GRID_BAR(); }
    if (IN(5)) { Frame P = F; fill_ptrs(P);
    }
    if (IN(6)) { Frame P = F; fill_ptrs(P);
        build_tab(P);
        const int G = F.G, c = (int)blockIdx.x, U6 = 4 * tab[32]; int x = 3 * G - U6; x = x < 0 ? 0 : (x > 512 ? 512 : x);
        int n6 = 0; while (n6 < 3 && c + G * n6 < U6) ++n6;
        if (U6 > 3 * G) n6 = 1 << 20;
        { pg8::Gemm g{(const pg8::bf16_t*)P.X18, (const pg8::bf16_t*)P.Wgu8, M, NEXP * 1024, DM}; pg8::GroupedList<true> S{tab, 4, tab[32], c, G, n6, P.list};
          pg8::EpiGateUp E{P.H8};
          pg8::gemm_phase<pg8::EpiGateUp, pg8::GroupedList<true>, true, true, 1>(F.lds + RING_OFF, g, S, E, P.tid); }
        { pg8::Gemm g{(const pg8::bf16_t*)P.X18, (const pg8::bf16_t*)P.Wg8, M, DM, DM}; pg8::DenseList S; const int lf = c + G * n6 - U6;
          int n8f = 0; if (n6 <= 3) { while (lf + G * n8f < x) ++n8f; }
          S.init(M, DM, lf, G, n8f);
          pg8::EpiPle E{P.Y1B, P.Y2B, P.b_pg, P.PP, P.stats, P.ln1_g, P.ln1_b};
          pg8::gemm_phase<pg8::EpiPle, pg8::DenseList, true, true, 1>(F.lds + RING_OFF, g, S, E, P.tid); }
        if (BOTH(6)) GRID_BAR();
    }
    if (IN(7)) { Frame P = F; fill_ptrs(P);
        build_tab(P);
        const int G = F.G, c = (int)blockIdx.x, U6 = 4 * tab[32]; int x = 3 * G - U6; x = x < 0 ? 0 : (x > 512 ? 512 : x);
        const int n8 = 512 - x;
        const bool one_each = n8 <= G;
        { pg8::Gemm g{(const pg8::bf16_t*)P.X18, (const pg8::bf16_t*)P.Wg8, M, DM, DM}; pg8::DenseList S;
          if (one_each) S.init(M, DM, x + c, 1, c < n8 ? 1 : 0); else S.init(M, DM, x + c, G, 1 << 20);
          pg8::EpiPle E{P.Y1B, P.Y2B, P.b_pg, P.PP, P.stats, P.ln1_g, P.ln1_b};
          pg8::gemm_phase<pg8::EpiPle, pg8::DenseList, true, true, 1>(F.lds + RING_OFF, g, S, E, P.tid); }
        { pg8::Gemm g{(const pg8::bf16_t*)P.H8, (const pg8::bf16_t*)P.Wd8, MPAD_MAX, NEXP * DM, DEXP};
          const int nw = one_each ? (G - n8) : G;
          pg8::GroupedList<false> S{tab, 16, tab[32], one_each ? c - n8 : c, nw > 0 ? nw : 1, (one_each && (c < n8 || nw <= 0)) ? 0 : (1 << 20), nullptr};
          pg8::EpiDown E{P.MOE, P.list, P.wts, tab + 33};
          pg8::gemm_phase<pg8::EpiDown, pg8::GroupedList<false>, true, true, 1>(F.lds + RING_OFF, g, S, E, P.tid); }
        if (BOTH(7)) GRID_BAR();
    }
    if (IN(8)) { Frame P = F; fill_ptrs(P); if (REP(8) == 2) p9_ln2(P, (float*)P.XG);
        p9_ln2(P, P.out); }
    if (N_LAUNCHES == 1 && blockIdx.x == 0 && KTID() == 0) __hip_atomic_store(F.ctl + CW_READY, 0u, RLX_AGENT);
#undef IN
#undef BOTH
#undef GRID_BAR
}

extern "C" void kernel_launch(void* const* d_in, const int* in_sizes, int n_in, void* d_out, int out_size, void* d_ws, size_t ws_size, hipStream_t stream) {
    static int grid = 0;
    if (grid == 0) {
        if (n_in != 24 || in_sizes[0] != M * DM || out_size != M * DM || ws_size < WS_END) { fprintf(stderr, "kernel_launch: unexpected shapes (n_in %d, in0 %d, out %d, ws %zu < %zu); nothing launched\n", n_in, n_in > 0 ? in_sizes[0] : -1, out_size, ws_size, (size_t)WS_END); grid = -1; return; }
        int dev = 0, cus = 0, per_cu = 0;
        if (hipGetDevice(&dev) != hipSuccess || hipDeviceGetAttribute(&cus, hipDeviceAttributeMultiprocessorCount, dev) != hipSuccess) { fprintf(stderr, "kernel_launch: device query failed\n"); grid = -1; return; }
        if (hipFuncSetAttribute((const void*)hymba_fwd, hipFuncAttributeMaxDynamicSharedMemorySize, LDS_BYTES) != hipSuccess) { fprintf(stderr, "kernel_launch: hipFuncSetAttribute failed\n"); grid = -1; return; }
        if (hipOccupancyMaxActiveBlocksPerMultiprocessor(&per_cu, (const void*)hymba_fwd, NWAVES * 64, LDS_BYTES) != hipSuccess || per_cu < 1)
            fprintf(stderr, "kernel_launch: note: occupancy query reports %d workgroups per CU\n", per_cu);
        (void)hipGetLastError();
        grid = cus < 256 ? cus : 256;
    }
    if (grid < 0) return;
    if (N_LAUNCHES != 1 && hipMemsetAsync((char*)d_ws + WS_CTL, 0, CTL_ZERO_BYTES, stream) != hipSuccess) { fprintf(stderr, "kernel_launch: hipMemsetAsync failed\n"); return; }
    Args a{};
    for (int i = 0; i < 24; ++i) a.in[i] = d_in[i];
    a.out = (float*)d_out; a.ws = (unsigned char*)d_ws;
    for (int li = 0; li < N_LAUNCHES; ++li) {
        a.ph_lo = (N_LAUNCHES == 1) ? 0 : li; a.ph_hi = (N_LAUNCHES == 1) ? N_PHASES : li + 1;
        hipLaunchKernelGGL(hymba_fwd, dim3(grid), dim3(NWAVES * 64), LDS_BYTES, stream, a);
        const hipError_t le = hipPeekAtLastError();
        if (le != hipSuccess) { fprintf(stderr, "kernel_launch: launch %d failed: %s\n", li, hipGetErrorName(le)); break; }
    }
}
```

```cpp
#include <hip/hip_runtime.h>
#include <cstdio>
#include <cstdint>

namespace pg8 {
#define PG8_LAS __attribute__((address_space(3)))
typedef unsigned short bf16_t;
typedef short bf16x8 __attribute__((ext_vector_type(8)));
typedef float f32x4 __attribute__((ext_vector_type(4)));
typedef float f32x2 __attribute__((ext_vector_type(2)));
typedef unsigned u32x4 __attribute__((ext_vector_type(4)));
typedef unsigned u32x2 __attribute__((ext_vector_type(2)));
typedef __bf16 bf16x2_t __attribute__((ext_vector_type(2)));
typedef int v4i_t __attribute__((ext_vector_type(4)));
typedef int v8i_t __attribute__((ext_vector_type(8)));
constexpr int BM = 256, BK = 64, HALF = 128, HTB = HALF * BK * 2  , STAGE_BYTES = 8 * HTB, NXCD = 8, WGM = 8;

__host__ __device__ __forceinline__ int lds_byte(int r, int c) { const int st = (r >> 4) * 2 + (c >> 5), rr = r & 15, cc = c & 31, ob = rr * 64 + cc * 2; return st * 1024 + (ob ^ (((ob >> 9) & 1) << 5)); }
__host__ __device__ __forceinline__ void stage_rc(int b, int& R, int& C) { const int st = b / 1024, sb = b % 1024, swz = sb ^ (((sb >> 9) & 1) << 5); R = (st >> 1) * 16 + swz / 64; C = (st & 1) * 32 + (swz % 64) / 2; }
__host__ __device__ __forceinline__ int perm32(int rho) { const int n = rho >> 4, i = rho & 15; return 8 * (i >> 2) + 4 * n + (i & 3); }
template <int PM> __host__ __device__ __forceinline__ int bperm(int R) {
    if (PM == 1) return (R & ~31) + perm32(R & 31);
    if (PM == 2) { const int wc = R >> 5, n = (R >> 4) & 1, i = R & 15; return 64 * (wc >> 1) + 16 * (wc & 1) + i + 32 * n; }
    return R;
}

struct Unit { int pm, pn, e, lt; };
struct Gemm { const bf16_t* A; const bf16_t* Bt; int M, N, K; };

struct StaticOrder {
    static constexpr bool GATHER = false;
    int nM, nN, nwg, G, c;
    __host__ __device__ void init(int M, int N, int G_, int c_) { nM = M / BM; nN = N / BM; nwg = nM * nN; G = G_; c = c_; }
    __host__ __device__ bool next(int i, Unit& u) const {
        const long L = (long)i * G + c; if (L >= nwg) return false;
        int wgid = (int)L; { const int q = nwg / NXCD, r = nwg % NXCD, xcd = wgid % NXCD, off = wgid / NXCD; wgid = (xcd < r ? xcd * (q + 1) : r * (q + 1) + (xcd - r) * q) + off; }
        const int nig = WGM * nN, gid = wgid / nig, fm = gid * WGM, gsz = (nM - fm) < WGM ? (nM - fm) : WGM;
        u.pm = fm + ((wgid % nig) % gsz); u.pn = (wgid % nig) / gsz; u.e = 0; u.lt = 0; return true;
    }
    __device__ __forceinline__ void a_ready(const Unit&) const {}
    __device__ __forceinline__ void done(const Unit&) const {}
};
struct GroupedOrder {
    static constexpr bool GATHER = false;
    const PG8_LAS int* tstart; int nN, total, G, c;
    __device__ __forceinline__ bool next(int i, Unit& u) const {
        const int L = i * G + c; if (L >= total * nN) return false;
        const int mt = L / nN, pn = L - mt * nN; int e = 0;
        while (e < 31 && tstart[e + 1] <= mt) ++e;
        u.pm = mt; u.pn = e * nN + pn; u.e = e; u.lt = mt - tstart[e]; return true;
    }
    __device__ __forceinline__ void a_ready(const Unit&) const {}
    __device__ __forceinline__ void done(const Unit&) const {}
};

struct DenseList {
    static constexpr bool GATHER = false;
    int nM, nN, nwg, v0, stride, n;
    __device__ __forceinline__ void init(int M, int N, int v0_, int stride_, int n_) { nM = M / BM; nN = N / BM; nwg = nM * nN; v0 = v0_; stride = stride_; n = n_; }
    __device__ __forceinline__ bool next(int i, Unit& u) const {
        if (i >= n) return false;
        int wgid = v0 + stride * i; if (wgid >= nwg) return false;
        { const int q = nwg / NXCD, r = nwg % NXCD, xcd = wgid % NXCD, off = wgid / NXCD; wgid = (xcd < r ? xcd * (q + 1) : r * (q + 1) + (xcd - r) * q) + off; }
        const int nig = WGM * nN, gid = wgid / nig, fm = gid * WGM, gsz = (nM - fm) < WGM ? (nM - fm) : WGM;
        u.pm = fm + ((wgid % nig) % gsz); u.pn = (wgid % nig) / gsz; u.e = 0; u.lt = 0; return true;
    }
    __device__ __forceinline__ void a_ready(const Unit&) const {}
    __device__ __forceinline__ void done(const Unit&) const {}
};
template <bool GATHER_> struct GroupedList {
    static constexpr bool GATHER = GATHER_;
    const PG8_LAS int* tstart; int nN, total, l0, stride, n;
    const int* list;
    __device__ __forceinline__ void a_rows(const Unit& u, const int (&R)[2], int (&rows)[2][2]) const {
        const int n_e = tstart[33 + u.e];
#pragma unroll
        for (int h = 0; h < 2; ++h)
#pragma unroll
            for (int i = 0; i < 2; ++i) { const int ii = u.lt * BM + h * HALF + R[i]; rows[h][i] = ii < n_e ? (list[u.e * 8192 + ii] >> 1) : 0; }
    }
    __device__ __forceinline__ bool next(int i, Unit& u) const {
        if (i >= n) return false;
        const int L = l0 + stride * i; if (L >= total * nN) return false;
        const int mt = L / nN, pn = L - mt * nN; int e = 0;
        while (e < 31 && tstart[e + 1] <= mt) ++e;
        u.pm = mt; u.pn = e * nN + pn; u.e = e; u.lt = mt - tstart[e]; return true;
    }
    __device__ __forceinline__ void a_ready(const Unit&) const {}
    __device__ __forceinline__ void done(const Unit&) const {}
};

__device__ __forceinline__ unsigned cvt_pk_bf16(float lo, float hi) { f32x2 v = {lo, hi}; bf16x2_t b = __builtin_convertvector(v, bf16x2_t); return __builtin_bit_cast(unsigned, b); }

__device__ __forceinline__ unsigned cvt_pk_fp8x4(float a_, float b_, float c_, float d_) { int w = 0; w = __builtin_amdgcn_cvt_pk_fp8_f32(a_, b_, w, false); w = __builtin_amdgcn_cvt_pk_fp8_f32(c_, d_, w, true); return (unsigned)w; }

constexpr float LOG2E = 1.4426950408889634f;
constexpr float ALPHA = 1.189207115002721f;
constexpr float QA_SCALE = 0.18033688011112042f;
constexpr float QB_SCALE = 0.12751743082459868f;


struct EpiPlainBf16 {
    static constexpr int PM = 1; static constexpr bool AFTER_DRAIN = false, MIDK = false;
    bf16_t* O; int ldc;
    __device__ __forceinline__ void operator()(const f32x4 (&acc)[2][2][4][2], const Unit& u, int wr, int wc, int fr, int fq) const {
        const int row0 = u.pm * BM + wr * 64 + fr, col0 = u.pn * BM + wc * 32 + 8 * fq;
#pragma unroll
        for (int ai = 0; ai < 2; ++ai)
#pragma unroll
            for (int m = 0; m < 4; ++m) { bf16_t* rowp = O + (size_t)(row0 + ai * HALF + m * 16) * ldc + col0;
#pragma unroll
                for (int bj = 0; bj < 2; ++bj) { const f32x4 v0 = acc[ai][bj][m][0], v1 = acc[ai][bj][m][1];
                    u32x4 w; w.x = cvt_pk_bf16(v0[0], v0[1]); w.y = cvt_pk_bf16(v0[2], v0[3]); w.z = cvt_pk_bf16(v1[0], v1[1]); w.w = cvt_pk_bf16(v1[2], v1[3]);
                    *(u32x4*)(rowp + bj * HALF) = w; } }
    }
};

struct EpiProj {
    static constexpr int PM = 2; static constexpr bool AFTER_DRAIN = false, MIDK = false;
    bf16_t* O; const float* bias; const float* cs;
    static constexpr int ST_OFF = 131072, ST_ROWB = 272, ST_TILE = 32 * ST_ROWB;
    __device__ __forceinline__ void epi_staged(const f32x4 (&acc)[2][2][4][2], const Unit& u, int wr, int wc, int fr, int fq, PG8_LAS unsigned char* lds, int wid, int lane) const {
        constexpr int LD = 8704;
        const int row0 = u.pm * BM + wr * 64 + fr, tile = u.pn;
        const bool rope = tile < 9;
        const float sc = tile < 8 ? QA_SCALE : ((tile >= 10 && tile < 18) ? QB_SCALE : 1.0f);
        const int p0 = 16 * (wc & 1) + 4 * fq;
        const int wofs = (wr * 16 + fr) * ST_ROWB + (64 * (wc >> 1) + p0) * 2;
        const int t = wid * 64 + lane, rr_ = t >> 4, ch = t & 15; const int rofs = rr_ * ST_ROWB + ch * 16;
        bf16_t* gout = O + (size_t)(u.pm * BM + (rr_ >> 4) * 64 + (rr_ & 15)) * LD + tile * BM + ch * 8;
        int step = 0;
#pragma unroll
        for (int bj = 0; bj < 2; ++bj) {
            const int cb = tile * BM + HALF * bj + 64 * (wc >> 1) + p0;
            const f32x4 blo = *(const f32x4*)(bias + cb), bhi = *(const f32x4*)(bias + cb + 32);
#pragma unroll
            for (int ai = 0; ai < 2; ++ai)
#pragma unroll
                for (int m = 0; m < 4; ++m) {
                    const int row = row0 + ai * HALF + m * 16;
                    f32x4 a = acc[ai][bj][m][0] + blo, b = acc[ai][bj][m][1] + bhi;
                    if (rope) {
                        const f32x4 c01 = *(const f32x4*)(cs + (size_t)row * 64 + 2 * p0), c23 = *(const f32x4*)(cs + (size_t)row * 64 + 2 * p0 + 4);
                        const f32x4 co = {c01[0], c01[2], c23[0], c23[2]}, si = {c01[1], c01[3], c23[1], c23[3]};
                        const f32x4 ra = a * co - b * si, rb = b * co + a * si; a = ra; b = rb;
                    }
                    a = a * sc; b = b * sc;
                    u32x2 wa, wb; wa.x = cvt_pk_bf16(a[0], a[1]); wa.y = cvt_pk_bf16(a[2], a[3]); wb.x = cvt_pk_bf16(b[0], b[1]); wb.y = cvt_pk_bf16(b[2], b[3]);
                    PG8_LAS unsigned char* st = lds + ST_OFF + (step & 1) * ST_TILE;
                    *(PG8_LAS u32x2*)(st + wofs) = wa; *(PG8_LAS u32x2*)(st + wofs + 64) = wb;
                    asm volatile("s_waitcnt lgkmcnt(0)" ::: "memory");
                    __builtin_amdgcn_s_barrier();
                    const u32x4 v = *(const PG8_LAS u32x4*)(st + rofs);
                    *(u32x4*)(gout + (size_t)(ai * HALF + m * 16) * LD + bj * HALF) = v;
                    ++step;
                }
        }
    }
};

#ifndef D_FP8
#define D_FP8 1
#endif
#ifndef D_KSPLIT
#define D_KSPLIT 1024
#endif
constexpr int OKS = D_FP8 ? D_KSPLIT : 4096, ORB = OKS * 2 + (4096 - OKS);
constexpr int O_TSPLIT = D_FP8 ? OKS / 64 : 0, O_MIDT = !D_FP8 ? 0 : (OKS >= 2048 ? 32 : OKS / 64 + (2048 - OKS) / 128);
static_assert(OKS % 128 == 0 && OKS >= 0 && OKS <= 4096 && (O_MIDT % 2) == 0, "D_KSPLIT");
struct EpiWout {
    static constexpr int PM = 1; static constexpr bool AFTER_DRAIN = false, MIDK = true; static constexpr int MIDK_T = O_MIDT;
    const bf16_t* xb; bf16_t* Y; const float* bias; const float* rr;
    static constexpr int RRT_OFF = 131072;
    __device__ __forceinline__ void unit_begin(PG8_LAS unsigned char* lds, const Unit& u, int par, int wid, int lane) const {
        __builtin_amdgcn_global_load_lds((const unsigned*)(rr + 2 * (size_t)(u.pm * BM) + 64 * wid + lane), (PG8_LAS unsigned*)(lds + RRT_OFF + par * 2048 + wid * 256), 4, 0, 0);
    }
    __device__ __forceinline__ void midk(f32x4 (&acc)[2][2][4][2], const Unit& u, int wr, int fr, PG8_LAS unsigned char* lds, int par) const {
        const PG8_LAS float* rt = (const PG8_LAS float*)(lds + RRT_OFF + par * 2048);
#pragma unroll
        for (int ai = 0; ai < 2; ++ai)
#pragma unroll
            for (int m = 0; m < 4; ++m) { const f32x2 r = *(const PG8_LAS f32x2*)(rt + 2 * (ai * HALF + wr * 64 + m * 16 + fr));
                const float ratio = r.x / r.y;
#pragma unroll
                for (int bj = 0; bj < 2; ++bj)
#pragma unroll
                    for (int n = 0; n < 2; ++n) acc[ai][bj][m][n] = acc[ai][bj][m][n] * ratio;
                asm volatile("" : "+v"(acc[ai][0][m][0]), "+v"(acc[ai][0][m][1]), "+v"(acc[ai][1][m][0]), "+v"(acc[ai][1][m][1])); }
    }
    __device__ __forceinline__ void epi(const f32x4 (&acc)[2][2][4][2], const Unit& u, int wr, int wc, int fr, int fq, PG8_LAS unsigned char* lds, int par) const {
        constexpr int LD = 4096;
        const PG8_LAS float* rt = (const PG8_LAS float*)(lds + RRT_OFF + par * 2048);
        const int row0 = u.pm * BM + wr * 64 + fr, col0 = u.pn * BM + wc * 32 + 8 * fq;
        f32x4 bv[2][2];
#pragma unroll
        for (int bj = 0; bj < 2; ++bj)
#pragma unroll
            for (int n = 0; n < 2; ++n) bv[bj][n] = *(const f32x4*)(bias + col0 + bj * HALF + 4 * n);
        u32x4 xq[4][2][2];
#define EPW_LOAD(b_) do { _Pragma("unroll") for (int m_ = 0; m_ < 2; ++m_) { const size_t off_ = (size_t)(row0 + ((b_) >> 1) * HALF + (2 * ((b_) & 1) + m_) * 16) * LD + col0; xq[b_][m_][0] = *(const u32x4*)(xb + off_); xq[b_][m_][1] = *(const u32x4*)(xb + off_ + HALF); } } while (0)
        EPW_LOAD(0);
#pragma unroll
        for (int b = 0; b < 4; ++b) { const int ai = b >> 1;
            if (b == 0) EPW_LOAD(1); else if (b == 1) EPW_LOAD(2); else if (b == 2) EPW_LOAD(3);
            asm volatile("" ::: "memory");
#pragma unroll
            for (int mm = 0; mm < 2; ++mm) { const int m = 2 * (b & 1) + mm; const int row = row0 + ai * HALF + m * 16; const float rb = rt[2 * (ai * HALF + wr * 64 + m * 16 + fr) + 1]; const size_t off = (size_t)row * LD + col0;
#pragma unroll
                for (int bj = 0; bj < 2; ++bj) { const u32x4 xw = xq[b][mm][bj];
                    const f32x4 xa = {__uint_as_float(xw.x << 16), __uint_as_float(xw.x & 0xffff0000u), __uint_as_float(xw.y << 16), __uint_as_float(xw.y & 0xffff0000u)};
                    const f32x4 xc = {__uint_as_float(xw.z << 16), __uint_as_float(xw.z & 0xffff0000u), __uint_as_float(xw.w << 16), __uint_as_float(xw.w & 0xffff0000u)};
                    const f32x4 v0 = xa * ALPHA + acc[ai][bj][m][0] * rb + bv[bj][0], v1 = xc * ALPHA + acc[ai][bj][m][1] * rb + bv[bj][1];
                    u32x4 w; w.x = cvt_pk_bf16(v0[0], v0[1]); w.y = cvt_pk_bf16(v0[2], v0[3]); w.z = cvt_pk_bf16(v1[0], v1[1]); w.w = cvt_pk_bf16(v1[2], v1[3]);
                    *(u32x4*)(Y + off + bj * HALF) = w; } }
            asm volatile("" ::: "memory"); }
#undef EPW_LOAD
    }
};

struct EpiGateUp {
    static constexpr int PM = 1; static constexpr bool AFTER_DRAIN = false, MIDK = false;
    unsigned char* H;
    __device__ __forceinline__ void operator()(const f32x4 (&acc)[2][2][4][2], const Unit& u, int wr, int wc, int fr, int fq) const {
        constexpr int LD = 512;
        const int row0 = u.pm * BM + wr * 64 + fr, col0 = (u.pn & 3) * HALF + wc * 32 + 8 * fq;
#pragma unroll
        for (int ai = 0; ai < 2; ++ai)
#pragma unroll
            for (int m = 0; m < 4; ++m) {
                float h[8];
#pragma unroll
                for (int n = 0; n < 2; ++n)
#pragma unroll
                    for (int j = 0; j < 4; ++j) { const float g = acc[ai][0][m][n][j], up = acc[ai][1][m][n][j];
                        const float sg = __builtin_amdgcn_rcpf(1.0f + __builtin_amdgcn_exp2f(-g * LOG2E));
                        h[4 * n + j] = g * sg * up; }
                u32x2 w; w.x = cvt_pk_fp8x4(h[0], h[1], h[2], h[3]); w.y = cvt_pk_fp8x4(h[4], h[5], h[6], h[7]);
                *(u32x2*)(H + (size_t)(row0 + ai * HALF + m * 16) * LD + col0) = w;
            }
    }
};

struct EpiDown {
    static constexpr int PM = 1; static constexpr bool AFTER_DRAIN = false, MIDK = false;
    bf16_t* MOE; const int* list; const float* wts; const PG8_LAS int* cnt;
    __device__ __forceinline__ void operator()(const f32x4 (&acc)[2][2][4][2], const Unit& u, int wr, int wc, int fr, int fq) const {
        constexpr int LD = 4096, MTOK = 8192;
        const int n_e = cnt[u.e], i0 = u.lt * BM + wr * 64 + fr, col0 = (u.pn & 15) * BM + wc * 32 + 8 * fq;
        int entv[2][4]; float wv[2][4];
#pragma unroll
        for (int ai = 0; ai < 2; ++ai)
#pragma unroll
            for (int m = 0; m < 4; ++m) { const int i = i0 + ai * HALF + m * 16; entv[ai][m] = list[u.e * MTOK + (i < n_e ? i : 0)]; }
#pragma unroll
        for (int ai = 0; ai < 2; ++ai)
#pragma unroll
            for (int m = 0; m < 4; ++m) wv[ai][m] = wts[entv[ai][m]];
#pragma unroll
        for (int ai = 0; ai < 2; ++ai)
#pragma unroll
            for (int m = 0; m < 4; ++m) {
                const int i = i0 + ai * HALF + m * 16;
                if (i < n_e) {
                    const int ent = entv[ai][m]; const float w = wv[ai][m];
                    bf16_t* rowp = MOE + ((size_t)(ent & 1) * MTOK + (size_t)(ent >> 1)) * LD + col0;
#pragma unroll
                    for (int bj = 0; bj < 2; ++bj) { const f32x4 v0 = acc[ai][bj][m][0] * w, v1 = acc[ai][bj][m][1] * w;
                        u32x4 o; o.x = cvt_pk_bf16(v0[0], v0[1]); o.y = cvt_pk_bf16(v0[2], v0[3]); o.z = cvt_pk_bf16(v1[0], v1[1]); o.w = cvt_pk_bf16(v1[2], v1[3]);
                        *(u32x4*)(rowp + bj * HALF) = o; }
                }
            }
    }
};

struct EpiPle {
    static constexpr int PM = 1; static constexpr bool AFTER_DRAIN = false, MIDK = false;
    const bf16_t* Y1; bf16_t* Y2; const float* bias; const bf16_t* pp; const float* stats; const float* lng; const float* lnb;
    __device__ __forceinline__ void operator()(const f32x4 (&acc)[2][2][4][2], const Unit& u, int wr, int wc, int fr, int fq) const {
        constexpr int LD = 4096;
        const int row0 = u.pm * BM + wr * 64 + fr, col0 = u.pn * BM + wc * 32 + 8 * fq;
#pragma unroll
        for (int bj = 0; bj < 2; ++bj) {
            f32x4 bv[2], gv[2], cv[2];
#pragma unroll
            for (int n = 0; n < 2; ++n) { bv[n] = *(const f32x4*)(bias + col0 + bj * HALF + 4 * n); gv[n] = *(const f32x4*)(lng + col0 + bj * HALF + 4 * n); cv[n] = *(const f32x4*)(lnb + col0 + bj * HALF + 4 * n); }
            f32x2 stq[2]; u32x4 yq[2], pq[2];
#define EPP_LOAD(i_) do { const int row_ = row0 + ((i_) >> 2) * HALF + ((i_) & 3) * 16; const size_t off_ = (size_t)row_ * LD + col0 + bj * HALF; stq[(i_) & 1] = *(const f32x2*)(stats + 2 * (size_t)row_); \
                yq[(i_) & 1] = *(const u32x4*)(Y1 + off_); pq[(i_) & 1] = *(const u32x4*)(pp + off_); } while (0)
            EPP_LOAD(0);
#pragma unroll
            for (int i = 0; i < 8; ++i) { const int ai = i >> 2, m = i & 3; const size_t off = (size_t)(row0 + ai * HALF + m * 16) * LD + col0 + bj * HALF;
                if (i == 0) EPP_LOAD(1); else if (i == 1) EPP_LOAD(2); else if (i == 2) EPP_LOAD(3); else if (i == 3) EPP_LOAD(4); else if (i == 4) EPP_LOAD(5); else if (i == 5) EPP_LOAD(6); else if (i == 6) EPP_LOAD(7);
                asm volatile("" ::: "memory");
                const f32x2 st = stq[i & 1]; const u32x4 yw = yq[i & 1], pw = pq[i & 1]; u32x4 w;
#pragma unroll
                for (int n = 0; n < 2; ++n) { const unsigned ya = n ? yw.z : yw.x, yb = n ? yw.w : yw.y, pa = n ? pw.z : pw.x, pb = n ? pw.w : pw.y;
                    const f32x4 yv = {__uint_as_float(ya << 16), __uint_as_float(ya & 0xffff0000u), __uint_as_float(yb << 16), __uint_as_float(yb & 0xffff0000u)};
                    const f32x4 pv = {__uint_as_float(pa << 16), __uint_as_float(pa & 0xffff0000u), __uint_as_float(pb << 16), __uint_as_float(pb & 0xffff0000u)};
                    const f32x4 x1 = (yv - st.x) * st.y * gv[n] + cv[n];
                    const f32x4 t = acc[ai][bj][m][n] + bv[n]; f32x4 sg;
#pragma unroll
                    for (int j = 0; j < 4; ++j) sg[j] = __builtin_amdgcn_rcpf(1.0f + __builtin_amdgcn_exp2f(-t[j] * LOG2E));
                    const f32x4 o = x1 * ALPHA + sg * pv;
                    if (n == 0) { w.x = cvt_pk_bf16(o[0], o[1]); w.y = cvt_pk_bf16(o[2], o[3]); } else { w.z = cvt_pk_bf16(o[0], o[1]); w.w = cvt_pk_bf16(o[2], o[3]); } }
                *(u32x4*)(Y2 + off) = w;
                asm volatile("" ::: "memory"); }
#undef EPP_LOAD
        }
    }
};

template <class Epi, class Sched, bool ALIGN_EPI = false, bool SP2 = false, int ELT = 2, int TSPLIT = 0, int ASCALE = 0x7c7c7c7c>
__device__ __forceinline__ void gemm_phase(PG8_LAS unsigned char* lds, const Gemm g, const Sched& S, const Epi& E, int tid_in) {
    int tid_ = tid_in; asm volatile("" : "+v"(tid_));
    const int tid = tid_, wid = __builtin_amdgcn_readfirstlane(tid >> 6), lane = tid & 63, wr = wid >> 2, wc = wid & 3, fr = lane & 15, fq = lane >> 4;
    const int K = g.K, nt = K * ELT / (BK * 2);
    static_assert(SP2 || !Sched::GATHER, "the gather form is written for the SP2 loop only");
    unsigned voffB[2];
#pragma unroll
    for (int i = 0; i < 2; ++i) { int R, C; stage_rc(tid * 16 + i * 8192, R, C); const int Rb = bperm<Epi::PM>(R);
        voffB[i] = (unsigned)(Rb * K * ELT + C * 2); }
    unsigned vAc[2][2], vAn[2][2];
#define PG8_AOFFS(dst, unit) do { int aR[2], aC[2]; _Pragma("unroll") for (int i_ = 0; i_ < 2; ++i_) stage_rc(tid * 16 + i_ * 8192, aR[i_], aC[i_]);     \
        if constexpr (Sched::GATHER) { int rows_[2][2]; S.a_rows(unit, aR, rows_); _Pragma("unroll") for (int h_ = 0; h_ < 2; ++h_) _Pragma("unroll") for (int i_ = 0; i_ < 2; ++i_) \
            dst[h_][i_] = (unsigned)rows_[h_][i_] * (unsigned)(K * ELT) + (unsigned)(aC[i_] * 2); } \
        else { _Pragma("unroll") for (int h_ = 0; h_ < 2; ++h_) _Pragma("unroll") for (int i_ = 0; i_ < 2; ++i_) dst[h_][i_] = (unsigned)((h_ * HALF + aR[i_]) * K * ELT + aC[i_] * 2); } } while (0)
    const size_t kstep = (size_t)(BK * 2);
    const size_t hstep = (size_t)HALF * K * ELT;
    const size_t tstep = 2 * hstep;
    const unsigned ldsw = (unsigned)wid * 1024u;
    const int aoff = lds_byte(wr * 64 + fr, fq * 8), boff = lds_byte(wc * 32 + fr, fq * 8);
#define PG8_SA(b, h) (((b) * 2 + (h)) * HTB)
#define PG8_SB(b, h) ((4 + (b) * 2 + (h)) * HTB)
#define PG8_STAGE(bufoff, gbase, voff) do { _Pragma("unroll") for (int _i = 0; _i < 2; ++_i) \
        __builtin_amdgcn_global_load_lds((const unsigned*)((const char*)(gbase) + (voff)[_i]), (PG8_LAS unsigned*)(lds + (bufoff) + ldsw + _i * 8192), 16, 0, 0); } while (0)
#define PG8_LDA(dst, b, h) do { _Pragma("unroll") for (int m = 0; m < 4; ++m) { if constexpr (ELT == 2 || PG8_BF16T) { _Pragma("unroll") for (int k = 0; k < 2; ++k) dst[m][k] = *(const PG8_LAS bf16x8*)(lds + PG8_SA(b, h) + aoff + m * 2048 + k * 1024); } \
        else { const v4i_t lo_ = *(const PG8_LAS v4i_t*)(lds + PG8_SA(b, h) + aoff + m * 2048), hi_ = *(const PG8_LAS v4i_t*)(lds + PG8_SA(b, h) + aoff + m * 2048 + 1024); dst##8[m] = __builtin_shufflevector(lo_, hi_, 0, 1, 2, 3, 4, 5, 6, 7); } } } while (0)
#define PG8_LDB(dst, b, h) do { _Pragma("unroll") for (int n = 0; n < 2; ++n) { if constexpr (ELT == 2 || PG8_BF16T) { _Pragma("unroll") for (int k = 0; k < 2; ++k) dst[n][k] = *(const PG8_LAS bf16x8*)(lds + PG8_SB(b, h) + boff + n * 2048 + k * 1024); } \
        else { const v4i_t lo_ = *(const PG8_LAS v4i_t*)(lds + PG8_SB(b, h) + boff + n * 2048), hi_ = *(const PG8_LAS v4i_t*)(lds + PG8_SB(b, h) + boff + n * 2048 + 1024); dst##8[n] = __builtin_shufflevector(lo_, hi_, 0, 1, 2, 3, 4, 5, 6, 7); } } } while (0)
#define PG8_MMA(ai, bj, At, Bt) do { __builtin_amdgcn_s_setprio(1); \
        if constexpr (ELT == 2 || PG8_BF16T) { _Pragma("unroll") for (int m = 0; m < 4; ++m) _Pragma("unroll") for (int n = 0; n < 2; ++n) _Pragma("unroll") for (int k = 0; k < 2; ++k) \
            acc[ai][bj][m][n] = __builtin_amdgcn_mfma_f32_16x16x32_bf16(Bt[n][k], At[m][k], acc[ai][bj][m][n], 0, 0, 0); } \
        else { _Pragma("unroll") for (int m = 0; m < 4; ++m) _Pragma("unroll") for (int n = 0; n < 2; ++n) \
            asm volatile("v_mfma_scale_f32_16x16x128_f8f6f4 %0, %1, %2, %0, %3, %4 op_sel_hi:[0,0,0]" : "+v"(acc[ai][bj][m][n]) : "v"(Bt##8[n]), "v"(At##8[m]), "v"(mxscale), "v"(mxscale_a)); }     \
        __builtin_amdgcn_s_setprio(0); } while (0)
#define PG8_WAIT_V(n) asm volatile("s_waitcnt vmcnt(" #n ")" ::: "memory")
#define PG8_WAIT_L(n) asm volatile("s_waitcnt lgkmcnt(" #n ")" ::: "memory")
#define PG8_BAR __builtin_amdgcn_s_barrier()
#define PG8_SCHED __builtin_amdgcn_sched_barrier(0)
    Unit cur, nxt; int ui = 0;
    if (!S.next(0, cur)) return;
    f32x4 acc[2][2][4][2];
#pragma unroll
    for (int a = 0; a < 2; ++a)
#pragma unroll
        for (int b = 0; b < 2; ++b)
#pragma unroll
            for (int m = 0; m < 4; ++m)
#pragma unroll
                for (int n = 0; n < 2; ++n) acc[a][b][m][n] = (f32x4){0.f, 0.f, 0.f, 0.f};
    bf16x8 At[4][2], B0[2][2], B1[2][2];
    v8i_t At8[4], B08[2], B18[2];
    int mxscale = 0x7c7c7c7c; asm volatile("" : "+v"(mxscale));
    int mxscale_a = ASCALE; asm volatile("" : "+v"(mxscale_a));
    const char* cA = (const char*)g.A + (Sched::GATHER ? (size_t)0 : (size_t)cur.pm * tstep); const char* cB = (const char*)g.Bt + (size_t)cur.pn * tstep;
    S.a_ready(cur);
    if constexpr (Epi::MIDK) E.unit_begin(lds, cur, 0, wid, lane);
    PG8_AOFFS(vAc, cur);
#pragma unroll
    for (int h_ = 0; h_ < 2; ++h_)
#pragma unroll
        for (int i_ = 0; i_ < 2; ++i_) vAn[h_][i_] = vAc[h_][i_];
    if constexpr (SP2) {
        PG8_STAGE(PG8_SB(0, 0), cB, voffB); PG8_STAGE(PG8_SB(0, 1), cB + hstep, voffB); PG8_STAGE(PG8_SA(0, 0), cA, vAc[0]); PG8_STAGE(PG8_SA(0, 1), cA, vAc[1]);
        if (wr == 1) PG8_BAR;
        PG8_WAIT_V(2); PG8_BAR;
        PG8_STAGE(PG8_SB(1, 0), cB + kstep, voffB); PG8_STAGE(PG8_SA(1, 0), cA + kstep, vAc[0]); PG8_STAGE(PG8_SB(1, 1), cB + hstep + kstep, voffB);
        PG8_WAIT_V(6); PG8_BAR;
    } else {
        PG8_STAGE(PG8_SB(0, 0), cB, voffB); PG8_STAGE(PG8_SA(0, 0), cA, vAc[0]); PG8_STAGE(PG8_SB(0, 1), cB + hstep, voffB); PG8_STAGE(PG8_SA(0, 1), cA, vAc[1]);
        if (wr == 1) PG8_BAR;
        PG8_WAIT_V(4); PG8_BAR;
        PG8_STAGE(PG8_SB(1, 0), cB + kstep, voffB); PG8_STAGE(PG8_SA(1, 0), cA + kstep, vAc[0]); PG8_STAGE(PG8_SB(1, 1), cB + hstep + kstep, voffB);
        PG8_WAIT_V(6); PG8_BAR;
    }
    for (;;) {
        const bool has_next = S.next(ui + 1, nxt);
        const char* nA = (has_next && !Sched::GATHER) ? (const char*)g.A + (size_t)nxt.pm * tstep : cA; const char* nB = has_next ? (const char*)g.Bt + (size_t)nxt.pn * tstep : cB;
        if constexpr (TSPLIT > 0) { constexpr bool PG8_BF16T = true;
#pragma unroll 1
        for (int t = 0; t < TSPLIT; t += 2) {
            const bool last = (t == nt - 2);
            if constexpr (TSPLIT > 0) asm volatile("" : "+v"(voffB[0]), "+v"(voffB[1]), "+v"(vAc[0][0]), "+v"(vAc[0][1]), "+v"(vAc[1][0]), "+v"(vAc[1][1]));
            const char* a1 = cA + (size_t)(t + 1) * kstep;
            const char* a2 = last ? nA : cA + (size_t)(t + 2) * kstep; const char* b2 = last ? nB : cB + (size_t)(t + 2) * kstep;
            const char* a3 = a2 + kstep; const char* b3 = b2 + kstep;
            if (last && has_next) { S.a_ready(nxt); if constexpr (Sched::GATHER) PG8_AOFFS(vAn, nxt); if constexpr (Epi::MIDK) E.unit_begin(lds, nxt, (ui + 1) & 1, wid, lane); }
            if constexpr (Epi::MIDK) { if (t == (Epi::MIDK_T ? Epi::MIDK_T : (nt >> 1))) E.midk(acc, cur, wr, fr, lds, ui & 1); }
            if constexpr (SP2) {
            PG8_LDB(B0, 0, 0); PG8_LDB(B1, 0, 1); PG8_SCHED; PG8_LDA(At, 0, 0); PG8_STAGE(PG8_SA(1, 1), a1, vAc[1]);
            if constexpr (Sched::GATHER) { if (last) { _Pragma("unroll") for (int h_ = 0; h_ < 2; ++h_) _Pragma("unroll") for (int i_ = 0; i_ < 2; ++i_) vAc[h_][i_] = vAn[h_][i_]; } }
            PG8_WAIT_V(8); PG8_WAIT_L(0); PG8_BAR; PG8_MMA(0, 0, At, B0); PG8_MMA(0, 1, At, B1); PG8_BAR; PG8_SCHED;
            PG8_LDA(At, 0, 1); PG8_STAGE(PG8_SB(0, 0), b2, voffB); PG8_STAGE(PG8_SB(0, 1), b2 + hstep, voffB); PG8_STAGE(PG8_SA(0, 0), a2, vAc[0]);
            PG8_WAIT_V(8); PG8_WAIT_L(0); PG8_BAR; PG8_MMA(1, 0, At, B0); PG8_MMA(1, 1, At, B1); PG8_BAR; PG8_SCHED;
            PG8_LDB(B0, 1, 0); PG8_LDB(B1, 1, 1); PG8_SCHED; PG8_LDA(At, 1, 0); PG8_STAGE(PG8_SA(0, 1), a2, vAc[1]);
            PG8_WAIT_V(8); PG8_WAIT_L(0); PG8_BAR; PG8_MMA(0, 0, At, B0); PG8_MMA(0, 1, At, B1); PG8_BAR; PG8_SCHED;
            PG8_LDA(At, 1, 1); PG8_STAGE(PG8_SB(1, 0), b3, voffB); PG8_STAGE(PG8_SB(1, 1), b3 + hstep, voffB); PG8_STAGE(PG8_SA(1, 0), a3, vAc[0]);
            PG8_WAIT_V(8); PG8_WAIT_L(0); PG8_BAR; PG8_MMA(1, 0, At, B0); PG8_MMA(1, 1, At, B1); PG8_BAR; PG8_SCHED;
            } else {
            PG8_LDB(B0, 0, 0); PG8_SCHED; PG8_LDA(At, 0, 0); PG8_STAGE(PG8_SA(1, 1), a1, vAc[1]);
            PG8_WAIT_L(8); PG8_BAR; PG8_WAIT_L(0); PG8_MMA(0, 0, At, B0); PG8_BAR; PG8_SCHED;
            PG8_LDB(B1, 0, 1); PG8_STAGE(PG8_SB(0, 0), b2, voffB);
            PG8_BAR; PG8_WAIT_L(0); PG8_MMA(0, 1, At, B1); PG8_BAR;
            PG8_LDA(At, 0, 1); PG8_STAGE(PG8_SA(0, 0), a2, vAc[0]);
            PG8_BAR; PG8_WAIT_L(0); PG8_MMA(1, 0, At, B0); PG8_BAR; PG8_SCHED;
            PG8_STAGE(PG8_SB(0, 1), b2 + hstep, voffB);
            PG8_WAIT_V(6); PG8_BAR; PG8_MMA(1, 1, At, B1); PG8_BAR;
            PG8_LDB(B0, 1, 0); PG8_SCHED; PG8_LDA(At, 1, 0); PG8_STAGE(PG8_SA(0, 1), a2, vAc[1]);
            PG8_WAIT_L(8); PG8_BAR; PG8_WAIT_L(0); PG8_MMA(0, 0, At, B0); PG8_BAR; PG8_SCHED;
            PG8_LDB(B1, 1, 1); PG8_STAGE(PG8_SB(1, 0), b3, voffB);
            PG8_BAR; PG8_WAIT_L(0); PG8_MMA(0, 1, At, B1); PG8_BAR;
            PG8_LDA(At, 1, 1); PG8_STAGE(PG8_SA(1, 0), a3, vAc[0]);
            PG8_BAR; PG8_WAIT_L(0); PG8_MMA(1, 0, At, B0); PG8_BAR; PG8_SCHED;
            PG8_STAGE(PG8_SB(1, 1), b3 + hstep, voffB);
            PG8_WAIT_V(6); PG8_BAR; PG8_MMA(1, 1, At, B1); PG8_BAR;
            }
        }
        }
        { constexpr bool PG8_BF16T = false;
#pragma unroll 1
        for (int t = TSPLIT; t < nt; t += 2) {
            const bool last = (t == nt - 2);
            if constexpr (TSPLIT > 0) asm volatile("" : "+v"(voffB[0]), "+v"(voffB[1]), "+v"(vAc[0][0]), "+v"(vAc[0][1]), "+v"(vAc[1][0]), "+v"(vAc[1][1]));
            const char* a1 = cA + (size_t)(t + 1) * kstep;
            const char* a2 = last ? nA : cA + (size_t)(t + 2) * kstep; const char* b2 = last ? nB : cB + (size_t)(t + 2) * kstep;
            const char* a3 = a2 + kstep; const char* b3 = b2 + kstep;
            if (last && has_next) { S.a_ready(nxt); if constexpr (Sched::GATHER) PG8_AOFFS(vAn, nxt); if constexpr (Epi::MIDK) E.unit_begin(lds, nxt, (ui + 1) & 1, wid, lane); }
            if constexpr (Epi::MIDK) { if (t == (Epi::MIDK_T ? Epi::MIDK_T : (nt >> 1))) E.midk(acc, cur, wr, fr, lds, ui & 1); }
            if constexpr (SP2) {
            PG8_LDB(B0, 0, 0); PG8_LDB(B1, 0, 1); PG8_SCHED; PG8_LDA(At, 0, 0); PG8_STAGE(PG8_SA(1, 1), a1, vAc[1]);
            if constexpr (Sched::GATHER) { if (last) { _Pragma("unroll") for (int h_ = 0; h_ < 2; ++h_) _Pragma("unroll") for (int i_ = 0; i_ < 2; ++i_) vAc[h_][i_] = vAn[h_][i_]; } }
            PG8_WAIT_V(8); PG8_WAIT_L(0); PG8_BAR; PG8_MMA(0, 0, At, B0); PG8_MMA(0, 1, At, B1); PG8_BAR; PG8_SCHED;
            PG8_LDA(At, 0, 1); PG8_STAGE(PG8_SB(0, 0), b2, voffB); PG8_STAGE(PG8_SB(0, 1), b2 + hstep, voffB); PG8_STAGE(PG8_SA(0, 0), a2, vAc[0]);
            PG8_WAIT_V(8); PG8_WAIT_L(0); PG8_BAR; PG8_MMA(1, 0, At, B0); PG8_MMA(1, 1, At, B1); PG8_BAR; PG8_SCHED;
            PG8_LDB(B0, 1, 0); PG8_LDB(B1, 1, 1); PG8_SCHED; PG8_LDA(At, 1, 0); PG8_STAGE(PG8_SA(0, 1), a2, vAc[1]);
            PG8_WAIT_V(8); PG8_WAIT_L(0); PG8_BAR; PG8_MMA(0, 0, At, B0); PG8_MMA(0, 1, At, B1); PG8_BAR; PG8_SCHED;
            PG8_LDA(At, 1, 1); PG8_STAGE(PG8_SB(1, 0), b3, voffB); PG8_STAGE(PG8_SB(1, 1), b3 + hstep, voffB); PG8_STAGE(PG8_SA(1, 0), a3, vAc[0]);
            PG8_WAIT_V(8); PG8_WAIT_L(0); PG8_BAR; PG8_MMA(1, 0, At, B0); PG8_MMA(1, 1, At, B1); PG8_BAR; PG8_SCHED;
            } else {
            PG8_LDB(B0, 0, 0); PG8_SCHED; PG8_LDA(At, 0, 0); PG8_STAGE(PG8_SA(1, 1), a1, vAc[1]);
            PG8_WAIT_L(8); PG8_BAR; PG8_WAIT_L(0); PG8_MMA(0, 0, At, B0); PG8_BAR; PG8_SCHED;
            PG8_LDB(B1, 0, 1); PG8_STAGE(PG8_SB(0, 0), b2, voffB);
            PG8_BAR; PG8_WAIT_L(0); PG8_MMA(0, 1, At, B1); PG8_BAR;
            PG8_LDA(At, 0, 1); PG8_STAGE(PG8_SA(0, 0), a2, vAc[0]);
            PG8_BAR; PG8_WAIT_L(0); PG8_MMA(1, 0, At, B0); PG8_BAR; PG8_SCHED;
            PG8_STAGE(PG8_SB(0, 1), b2 + hstep, voffB);
            PG8_WAIT_V(6); PG8_BAR; PG8_MMA(1, 1, At, B1); PG8_BAR;
            PG8_LDB(B0, 1, 0); PG8_SCHED; PG8_LDA(At, 1, 0); PG8_STAGE(PG8_SA(0, 1), a2, vAc[1]);
            PG8_WAIT_L(8); PG8_BAR; PG8_WAIT_L(0); PG8_MMA(0, 0, At, B0); PG8_BAR; PG8_SCHED;
            PG8_LDB(B1, 1, 1); PG8_STAGE(PG8_SB(1, 0), b3, voffB);
            PG8_BAR; PG8_WAIT_L(0); PG8_MMA(0, 1, At, B1); PG8_BAR;
            PG8_LDA(At, 1, 1); PG8_STAGE(PG8_SA(1, 0), a3, vAc[0]);
            PG8_BAR; PG8_WAIT_L(0); PG8_MMA(1, 0, At, B0); PG8_BAR; PG8_SCHED;
            PG8_STAGE(PG8_SB(1, 1), b3 + hstep, voffB);
            PG8_WAIT_V(6); PG8_BAR; PG8_MMA(1, 1, At, B1); PG8_BAR;
            }
        }
        }
        if constexpr (ALIGN_EPI) { if (wr == 0) PG8_BAR; }
        if constexpr (ELT == 1) asm volatile("s_nop 15\n\ts_nop 15" ::: "memory");
        if constexpr (Epi::MIDK) { E.epi(acc, cur, wr, wc, fr, fq, lds, ui & 1); S.done(cur); }
        else if constexpr (Epi::PM == 2) { E.epi_staged(acc, cur, wr, wc, fr, fq, lds, wid, lane); S.done(cur); }
        else if constexpr (!Epi::AFTER_DRAIN) { E(acc, cur, wr, wc, fr, fq); S.done(cur); }
        if (!has_next) break;
#pragma unroll
        for (int a = 0; a < 2; ++a)
#pragma unroll
            for (int b = 0; b < 2; ++b)
#pragma unroll
                for (int m = 0; m < 4; ++m)
#pragma unroll
                    for (int n = 0; n < 2; ++n) acc[a][b][m][n] = (f32x4){0.f, 0.f, 0.f, 0.f};
        cur = nxt; cA = nA; cB = nB; ++ui;
        if constexpr (ALIGN_EPI) { if (wr == 1) PG8_BAR; }
    }
    PG8_WAIT_V(0);
    if constexpr (!ALIGN_EPI) { if (wr == 0) PG8_BAR; }
    PG8_BAR;
    if constexpr (Epi::AFTER_DRAIN) { E.fused(acc, cur, wr, wc, fr, fq, lds, wid, lane); S.done(cur); }
#undef PG8_AOFFS
#undef PG8_SA
#undef PG8_SB
#undef PG8_STAGE
#undef PG8_LDA
#undef PG8_LDB
#undef PG8_MMA
#undef PG8_WAIT_V
#undef PG8_WAIT_L
#undef PG8_BAR
#undef PG8_SCHED
}
}

constexpr int NWAVES = 8;
#ifndef MK_N_LAUNCHES
#define MK_N_LAUNCHES 1
#endif
constexpr int N_PHASES = 9;
#ifndef NT_STREAMS
#define NT_STREAMS 1
#endif
#ifndef G_BALANCE
#define G_BALANCE 1
#endif
constexpr int N_LAUNCHES = MK_N_LAUNCHES;
static_assert(N_LAUNCHES == 1 || N_LAUNCHES == N_PHASES, "MK_N_LAUNCHES is 1 or 9");

constexpr int BATCH = 2, SEQ = 4096, DM = 4096, M = BATCH * SEQ;
constexpr int NIN = 8704;
constexpr int QA0 = 0, KA0 = 2048, VA0 = 2304, QB0 = 2560, KB0 = 4608, VB0 = 6656;
constexpr int NEXP = 32, DEXP = 512, PLE = 256, NRT = 48;
constexpr float LN_EPS = 1e-5f, RMS_EPS = 1e-6f;
constexpr float SB_STOP = 32.0f;

constexpr size_t MiB = 1u << 20;
constexpr size_t WS_CTL = 0, CTL_ZERO_BYTES = 64 * 1024;
constexpr size_t WS_CS = 1 * MiB;
constexpr size_t WS_WRT = 3 * MiB;
constexpr size_t WS_RR = 3 * MiB + 512 * 1024;
constexpr size_t WS_WTS = 3 * MiB + 640 * 1024;
constexpr size_t WS_STATS = 3 * MiB + 768 * 1024;
constexpr size_t WS_LIST = 4 * MiB;
constexpr size_t WS_WINT = 8 * MiB;
constexpr size_t WS_WOUTT = 76 * MiB;
constexpr size_t WS_WGT = 108 * MiB;
constexpr size_t WS_WPT = 140 * MiB;
constexpr size_t WS_PB = 142 * MiB;
constexpr size_t WS_WGUT = 146 * MiB;
constexpr size_t WS_WDT = 402 * MiB;
constexpr size_t WS_XB = 530 * MiB;
constexpr size_t WS_QKV = 594 * MiB;
constexpr size_t WS_XG = 530 * MiB;
constexpr size_t WS_Y1B = 594 * MiB;
constexpr size_t WS_Y2B = 658 * MiB;
constexpr size_t WS_O = 730 * MiB;
constexpr size_t WS_H = 730 * MiB;
constexpr size_t WS_X1B = 794 * MiB;
constexpr size_t WS_PP = 858 * MiB;
constexpr size_t WS_MOE = 922 * MiB;
constexpr size_t WS_END = 1050 * MiB;
constexpr int MPAD_MAX = 24576;
constexpr int CW_TMO = 0, CW_CODE = 1;
constexpr int CW_BAR = 4096;
constexpr int CW_CNT = 8192;
constexpr int CW_DONE = 12352;
constexpr int CW_Q = 12288;
static_assert((CW_CNT + 64 * NEXP) * 4 <= (int)CTL_ZERO_BYTES, "CTL words inside the memset region");
constexpr int CW_READY = 16384 + 64;

constexpr int RING_OFF = 0, RING_BYTES = 131072;
constexpr int LDS_BYTES = 163840;
constexpr int MISC_OFF = LDS_BYTES - 1024;
constexpr int TAB_OFF = MISC_OFF + 256;
constexpr int ATT_VIMG = 16384, ATT_RED = 131072, ATT_G = 133120;
constexpr int LN_ROWB = 8208, LN_RED = 131328, LN_LOG = 155904;
static_assert(LN_LOG + 3072 + 192 <= MISC_OFF && ATT_RED + 2048 <= ATT_G && ATT_G + 16384 <= MISC_OFF, "LDS map");

#define GAS __attribute__((address_space(1)))
#define LAS __attribute__((address_space(3)))
typedef unsigned short bf16;
typedef unsigned v4u __attribute__((ext_vector_type(4)));
typedef unsigned v2u __attribute__((ext_vector_type(2)));
typedef float f32x4 __attribute__((ext_vector_type(4)));
typedef float f32x2 __attribute__((ext_vector_type(2)));
typedef float f32x16 __attribute__((ext_vector_type(16)));
typedef short bf16x8 __attribute__((ext_vector_type(8)));
typedef short s16x4 __attribute__((ext_vector_type(4)));
typedef GAS unsigned gu32;
#define RLX_AGENT __ATOMIC_RELAXED, __HIP_MEMORY_SCOPE_AGENT
#define LDS_WAIT() asm volatile("s_waitcnt lgkmcnt(0)" ::: "memory")
#define VM_WAIT() asm volatile("s_waitcnt vmcnt(0)" ::: "memory")
#define MFMA32(a, b, c) __builtin_amdgcn_mfma_f32_32x32x16_bf16((a), (b), (c), 0, 0, 0)
#define MFMA16(a, b, c) __builtin_amdgcn_mfma_f32_16x16x32_bf16((a), (b), (c), 0, 0, 0)
using pg8::cvt_pk_bf16;
using pg8::LOG2E;
#if NT_STREAMS
#define NT_LD(p) __builtin_nontemporal_load(p)
#define NT_ST(v, p) __builtin_nontemporal_store((v), (p))
#else
#define NT_LD(p) (*(p))
#define NT_ST(v, p) (*(p) = (v))
#endif
using pg8::OKS;
__device__ __forceinline__ float bf2f(unsigned short b) { return __uint_as_float(((unsigned)b) << 16); }

#define XB_TMO      128
#define XB_XCNT(j)  (256  + 64 * (j))
#define XB_XSUB(j)  (1280 + 64 * (j))
#define XB_XGEN(j)  (2304 + 64 * (j))
#define XB_TOP      3328
#define XB_TOPGEN   3392
#define XCD_BAR_WORDS 3456
#define XB_SPIN_CAP (1u << 18)

__device__ __forceinline__ unsigned xb_ld(unsigned* p)              { return __hip_atomic_load(p, __ATOMIC_RELAXED, __HIP_MEMORY_SCOPE_AGENT); }
__device__ __forceinline__ unsigned xb_add(unsigned* p, unsigned v) { return __hip_atomic_fetch_add(p, v, __ATOMIC_RELAXED, __HIP_MEMORY_SCOPE_AGENT); }
__device__ __forceinline__ unsigned xb_xcc_id() { return (unsigned)__builtin_amdgcn_s_getreg((3 << 11) | 20) & 0xFu; }
#define XB_SPIN(cond, bar) do { unsigned _sp = 0; while (cond) { __builtin_amdgcn_s_sleep(1); \
    if ((++_sp & 255u) == 0u) { if (xb_ld(&(bar)[XB_TMO])) break; if (_sp > XB_SPIN_CAP) { atomicAdd(&(bar)[XB_TMO], 1u); break; } } } } while (0)

struct XcdBarrier {
    unsigned* bar; unsigned x;
    volatile LAS unsigned* st;
};

__device__ __forceinline__ XcdBarrier xcd_barrier_post(unsigned* bar, volatile LAS unsigned* st, bool lead) {
    XcdBarrier b; b.bar = bar; b.x = xb_xcc_id(); b.st = st;
    if (lead) (void)xb_add(&bar[XB_XCNT(b.x)], 1u);
    return b;
}
__device__ __forceinline__ void xcd_barrier_complete(unsigned* bar, unsigned x, unsigned& nloc, unsigned& nx) {
    const unsigned G = gridDim.x * gridDim.y * gridDim.z;
    unsigned sum, cnt, mine, sp = 0u;
    for (;;) {
        sum = 0u; cnt = 0u; mine = 0u;
#pragma unroll
        for (unsigned j = 0; j < 16; ++j) { const unsigned c = xb_ld(&bar[XB_XCNT(j)]); sum += c; cnt += (c > 0u) ? 1u : 0u; mine = (j == x) ? c : mine; }
        if (sum == G) break;
        __builtin_amdgcn_s_sleep(1);
        if ((++sp & 255u) == 0u) { if (xb_ld(&bar[XB_TMO])) break; if (sp > XB_SPIN_CAP) { atomicAdd(&bar[XB_TMO], 1u); break; } }
    }
    nloc = mine > 0u ? mine : 1u; nx = cnt > 0u ? cnt : 1u;
}

__device__ __forceinline__ void xcd_barrier(const XcdBarrier& b, bool lead) {
    asm volatile("s_waitcnt vmcnt(0)" ::: "memory");
    __syncthreads();
    if (lead) {
        unsigned* bar = b.bar;
        __builtin_amdgcn_s_waitcnt(0);
        unsigned nloc = b.st[0], nx = b.st[1];
        if (nloc == 0u) { xcd_barrier_complete(bar, b.x, nloc, nx); b.st[0] = nloc; b.st[1] = nx; }
        const unsigned old = xb_add(&bar[XB_XSUB(b.x)], 1u);
        const unsigned gen = old / nloc;
        if (old + 1u == (gen + 1u) * nloc) {
            __builtin_amdgcn_fence(__ATOMIC_RELEASE, "agent");
            asm volatile("s_waitcnt vmcnt(0)" ::: "memory");
            const unsigned og = xb_add(&bar[XB_TOP], 1u);
            const unsigned tg = og / nx;
            if (og + 1u == (tg + 1u) * nx) xb_add(&bar[XB_TOPGEN], 1u);
            else XB_SPIN(xb_ld(&bar[XB_TOPGEN]) == tg, bar);
            __builtin_amdgcn_fence(__ATOMIC_ACQUIRE, "agent");
            xb_add(&bar[XB_XGEN(b.x)], 1u);
            asm volatile("s_waitcnt vmcnt(0)" ::: "memory");
        } else {
            XB_SPIN(xb_ld(&bar[XB_XGEN(b.x)]) == gen, bar);
            __builtin_amdgcn_fence(__ATOMIC_ACQUIRE, "agent");
            asm volatile("s_waitcnt vmcnt(0)" ::: "memory");
        }
    }
    __syncthreads();
}

struct Frame {
    LAS unsigned char* lds;
    volatile LAS unsigned* MISC;
    gu32* ctl;
    int tid, lane, wave, wave0;
    int vcu, G;
    const float *x, *p; const int* positions;
    const float *w_in, *b_in, *sinks, *g_a, *g_b, *w_out, *b_out, *ln1_g, *ln1_b, *w_group, *b_group, *w_er, *b_er, *w_gate, *w_up, *w_down, *w_pg, *b_pg, *w_pp, *ln2_g, *ln2_b;
    float* out;
    float *cs, *rr, *wts, *stats; int* list;
    bf16 *WrT, *WinT, *WoutT, *WpT, *PB, *XB, *QKV, *XG, *O, *PP, *MOE, *Y1B, *Y2B;
    unsigned char *Wg8, *Wgu8, *Wd8, *X18, *H8;
};

__device__ __forceinline__ float wave_sum(float v) {
#pragma unroll
    for (int o = 1; o < 64; o <<= 1) v += __shfl_xor(v, o);
    return v;
}
__device__ __forceinline__ f32x2 pair32(float v) { auto r = __builtin_amdgcn_permlane32_swap(__float_as_uint(v), __float_as_uint(v), false, false); return (f32x2){__uint_as_float(r[0]), __uint_as_float(r[1])}; }


__device__ __forceinline__ int hw_lane() { int l; asm volatile("v_mbcnt_lo_u32_b32 %0, -1, 0\n\tv_mbcnt_hi_u32_b32 %0, -1, %0" : "=v"(l)); return l; }
struct Args { const void* in[24]; float* out; unsigned char* ws; int ph_lo, ph_hi; };
typedef __attribute__((address_space(4))) const Args CArgs;
__device__ __forceinline__ void fill_ptrs(Frame& F) {
    CArgs* ap = (CArgs*)__builtin_amdgcn_kernarg_segment_ptr();
    asm volatile("" : "+s"(ap));
    { int t = F.wave0 * 64 + hw_lane(); asm volatile("" : "+v"(t)); F.tid = t; F.lane = t & 63; F.wave = __builtin_amdgcn_readfirstlane(t >> 6); }
    unsigned char* ws = ap->ws;
    F.x = (const float*)ap->in[0]; F.p = (const float*)ap->in[1]; F.positions = (const int*)ap->in[2];
    F.w_in = (const float*)ap->in[3]; F.b_in = (const float*)ap->in[4]; F.sinks = (const float*)ap->in[5]; F.g_a = (const float*)ap->in[6]; F.g_b = (const float*)ap->in[7];
    F.w_out = (const float*)ap->in[8]; F.b_out = (const float*)ap->in[9]; F.ln1_g = (const float*)ap->in[10]; F.ln1_b = (const float*)ap->in[11];
    F.w_group = (const float*)ap->in[12]; F.b_group = (const float*)ap->in[13]; F.w_er = (const float*)ap->in[14]; F.b_er = (const float*)ap->in[15];
    F.w_gate = (const float*)ap->in[16]; F.w_up = (const float*)ap->in[17]; F.w_down = (const float*)ap->in[18];
    F.w_pg = (const float*)ap->in[19]; F.b_pg = (const float*)ap->in[20]; F.w_pp = (const float*)ap->in[21]; F.ln2_g = (const float*)ap->in[22]; F.ln2_b = (const float*)ap->in[23];
    F.out = ap->out;
    F.ctl = (gu32*)(ws + WS_CTL);
    F.cs = (float*)(ws + WS_CS); F.rr = (float*)(ws + WS_RR); F.wts = (float*)(ws + WS_WTS); F.stats = (float*)(ws + WS_STATS); F.list = (int*)(ws + WS_LIST);
    F.WrT = (bf16*)(ws + WS_WRT); F.WinT = (bf16*)(ws + WS_WINT); F.WoutT = (bf16*)(ws + WS_WOUTT); F.Wg8 = ws + WS_WGT; F.WpT = (bf16*)(ws + WS_WPT); F.PB = (bf16*)(ws + WS_PB);
    F.Wgu8 = ws + WS_WGUT; F.Wd8 = ws + WS_WDT; F.XB = (bf16*)(ws + WS_XB); F.QKV = (bf16*)(ws + WS_QKV); F.XG = (bf16*)(ws + WS_XG);
    F.O = (bf16*)(ws + WS_O); F.H8 = ws + WS_H; F.X18 = ws + WS_X1B; F.PP = (bf16*)(ws + WS_PP); F.MOE = (bf16*)(ws + WS_MOE); F.Y1B = (bf16*)(ws + WS_Y1B); F.Y2B = (bf16*)(ws + WS_Y2B);
}

struct CvItem { const float* src; bf16* dst; int N, K, f8; };
__device__ __forceinline__ void cv_load(const CvItem& d, f32x4 (&v)[16], int lane) {
    if (d.f8) {
#pragma unroll
        for (int ii = 0; ii < 4; ++ii)
#pragma unroll
            for (int jj = 0; jj < 4; ++jj) v[4 * ii + jj] = NT_LD((const GAS f32x4*)(d.src + (size_t)(4 * ((lane >> 3) + 8 * ii) + jj) * d.N + 4 * (lane & 7)));
        return; }
#pragma unroll
    for (int i = 0; i < 8; ++i) { const float* p = d.src + (size_t)(2 * ((lane >> 4) + 4 * i)) * d.N + 4 * (lane & 15);
        v[2 * i] = NT_LD((const GAS f32x4*)p); v[2 * i + 1] = NT_LD((const GAS f32x4*)(p + d.N)); }
}
__device__ __forceinline__ void cv_finish(const CvItem& d, const f32x4 (&v)[16], LAS float* scrf, int lane) {
    LAS unsigned* scr = (LAS unsigned*)scrf;
    if (d.f8) {
#pragma unroll
        for (int ii = 0; ii < 4; ++ii) { LAS unsigned* p = scr + ((lane >> 3) + 8 * ii) * 33 + 4 * (lane & 7);
#pragma unroll
            for (int cc = 0; cc < 4; ++cc) p[cc] = pg8::cvt_pk_fp8x4(v[4 * ii][cc] * 64.0f, v[4 * ii + 1][cc] * 64.0f, v[4 * ii + 2][cc] * 64.0f, v[4 * ii + 3][cc] * 64.0f); }
        LDS_WAIT(); asm volatile("" ::: "memory");
        const int ch = lane & 7;
#pragma unroll
        for (int j = 0; j < 4; ++j) { const int n = (lane >> 3) + 8 * j; const LAS unsigned* sp = scr + (4 * ch) * 33 + n;
            v4u o; o.x = sp[0 * 33]; o.y = sp[1 * 33]; o.z = sp[2 * 33]; o.w = sp[3 * 33];
            *(GAS v4u*)((unsigned char*)d.dst + (size_t)n * d.K + 16 * ch) = o; }
        LDS_WAIT(); asm volatile("" ::: "memory");
        return; }
#pragma unroll
    for (int i = 0; i < 8; ++i) { LAS unsigned* p = scr + ((lane >> 4) + 4 * i) * 65 + 4 * (lane & 15);
#pragma unroll
        for (int j = 0; j < 4; ++j) p[j] = cvt_pk_bf16(v[2 * i][j], v[2 * i + 1][j]); }
    LDS_WAIT(); asm volatile("" ::: "memory");
    const int c = lane & 7;
#pragma unroll
    for (int j = 0; j < 8; ++j) { const int n = (lane >> 3) + 8 * j; const LAS unsigned* s = scr + (4 * c) * 65 + n;
        v4u o; o.x = s[0 * 65]; o.y = s[1 * 65]; o.z = s[2 * 65]; o.w = s[3 * 65];
        *(GAS v4u*)(d.dst + (size_t)n * d.K + 8 * c) = o; }
    LDS_WAIT(); asm volatile("" ::: "memory");
}
__device__ const double ROPE_INV_FREQ[32] = {1.0, 0.7498942093324559, 0.5623413251903491, 0.4216965034285822, 0.31622776601683794, 0.23713737056616552, 0.1778279410038923, 0.1333521432163324,
    0.1, 0.07498942093324558, 0.05623413251903491, 0.042169650342858224, 0.03162277660168379, 0.023713737056616554, 0.01778279410038923, 0.01333521432163324,
    0.01, 0.007498942093324558, 0.005623413251903491, 0.004216965034285823, 0.0031622776601683794, 0.0023713737056616554, 0.0017782794100389228, 0.001333521432163324,
    0.001, 0.0007498942093324559, 0.0005623413251903491, 0.00042169650342858224, 0.00031622776601683794, 0.00023713737056616554, 0.00017782794100389227, 0.0001333521432163324};

constexpr int I_IN = (DM / 64) * (NIN / 64), I_SQ = (DM / 64) * (DM / 64), I_PP = (PLE / 64) * (DM / 64);
constexpr int I_GU = (DM / 64) * (DEXP / 64), I_DN = (DEXP / 64) * (DM / 64);
constexpr int I_A = I_IN + I_PP, NITEMS = I_A + 2 * I_SQ + NEXP * (2 * I_GU + I_DN);
constexpr int QCHUNK = 16, NCHUNK = (NITEMS - I_A + QCHUNK - 1) / QCHUNK;
__device__ __forceinline__ CvItem cv_decode(const Frame& F, int it) {
    int r = it; CvItem d;
#define CV_SET(W, Kk, Nn, WT, nb, drow) do { const int kb_ = r / (nb), n0_ = 64 * (r % (nb)); d.src = (W) + (size_t)(64 * kb_) * (Nn) + n0_; d.dst = (WT) + (size_t)(drow) * (Kk) + 64 * kb_; d.N = (Nn); d.K = (Kk); d.f8 = 0; } while (0)
#define CV_SET8(W, Kk, Nn, WT8, nb, drow) do { const int kb_ = r / (nb), n0_ = 32 * (r % (nb)); d.src = (W) + (size_t)(128 * kb_) * (Nn) + n0_; d.dst = (bf16*)((WT8) + (size_t)(drow) * (Kk) + 128 * kb_); d.N = (Nn); d.K = (Kk); d.f8 = 1; } while (0)
    if (r < I_IN) { CV_SET(F.w_in, DM, NIN, F.WinT, NIN / 64, (size_t)n0_); return d; } r -= I_IN;
    if (r < I_PP) { CV_SET(F.w_pp, PLE, DM, F.WpT, DM / 64, (size_t)n0_); return d; } r -= I_PP;
    if (r < OKS) { CV_SET(F.w_out, pg8::ORB / 2, DM, F.WoutT, DM / 64, (size_t)n0_); return d; }
    if (r < I_SQ) { r -= OKS; CV_SET8(F.w_out + (size_t)OKS * DM, pg8::ORB, DM, (unsigned char*)F.WoutT + 2 * OKS, DM / 32, (size_t)n0_); return d; }
    r -= I_SQ;
    if (r < I_SQ) { CV_SET8(F.w_pg, DM, DM, F.Wg8, DM / 32, (size_t)n0_); return d; } r -= I_SQ;
    const int e = r / (2 * I_GU + I_DN); r -= e * (2 * I_GU + I_DN);
    if (r < 2 * I_GU) { const int up = r >= I_GU; if (up) r -= I_GU;
        CV_SET8((up ? F.w_up : F.w_gate) + (size_t)e * DM * DEXP, DM, DEXP, F.Wgu8, DEXP / 32, (size_t)e * 1024 + (size_t)(n0_ >> 7) * 256 + (up ? 128 : 0) + (n0_ & 127)); return d; }
    r -= 2 * I_GU;
    CV_SET8(F.w_down + (size_t)e * DEXP * DM, DEXP, DM, F.Wd8, DM / 32, (size_t)e * DM + n0_); return d;
#undef CV_SET
#undef CV_SET8
}
__device__ __forceinline__ void cv_run(const Frame& F, int first, int stride, int end, LAS float* scr) {
    if (first >= end) return;
    CvItem cur = cv_decode(F, first); f32x4 va[16], vb[16];
    cv_load(cur, va, F.lane);
    for (int it = first; it < end; it += stride) {
        const bool more = it + stride < end; CvItem nxt = cur;
        if (more) { nxt = cv_decode(F, it + stride); cv_load(nxt, vb, F.lane); }
        cv_finish(cur, va, scr, F.lane);
        cur = nxt;
#pragma unroll
        for (int i = 0; i < 16; ++i) va[i] = vb[i];
    }
}
__device__ __forceinline__ void conv_queue(Frame& F, int budget = 1 << 30) {
    LAS float* scr = (LAS float*)(F.lds + RING_OFF + F.wave * 16384);
    constexpr int IPW = QCHUNK / NWAVES;
    __syncthreads();
    if (budget <= 0) return;
    if (F.tid == 0) F.MISC[16] = __hip_atomic_fetch_add(F.ctl + CW_Q, 1u, RLX_AGENT);
    __syncthreads();
    int ch = (int)F.MISC[16], slot = 0, k = 0, nf = 1;
    if (ch >= NCHUNK) return;
    if (F.tid == 0) F.MISC[17] = (nf < budget) ? __hip_atomic_fetch_add(F.ctl + CW_Q, 1u, RLX_AGENT) : (unsigned)NCHUNK;
    ++nf;
#define CV_NEXT(dst) do { if (k == IPW) { __syncthreads(); slot ^= 1; ch = (int)F.MISC[16 + slot]; k = 0; \
            if (F.tid == 0 && ch < NCHUNK) F.MISC[16 + (slot ^ 1)] = (nf < budget) ? __hip_atomic_fetch_add(F.ctl + CW_Q, 1u, RLX_AGENT) : (unsigned)NCHUNK; ++nf; } \
        dst = (ch < NCHUNK) ? I_A + ch * QCHUNK + F.wave * IPW + k : -1; ++k; } while (0)
    int it0; CV_NEXT(it0);
    CvItem cur = cv_decode(F, it0); f32x4 va[16], vb[16];
    cv_load(cur, va, F.lane);
    for (;;) {
        int it1; CV_NEXT(it1);
        CvItem nxt = cur;
        if (it1 >= 0) { nxt = cv_decode(F, it1); cv_load(nxt, vb, F.lane); }
        cv_finish(cur, va, scr, F.lane);
        if (it1 < 0) break;
        cur = nxt;
#pragma unroll
        for (int i = 0; i < 16; ++i) va[i] = vb[i];
    }
    __syncthreads();
#undef CV_NEXT
}
__device__ __forceinline__ void p0_prologue(Frame& F) {
    LAS float* scr = (LAS float*)(F.lds + RING_OFF + F.wave * 16384);
    const int gw = F.vcu * NWAVES + F.wave, NGW = F.G * NWAVES;
    cv_run(F, gw, NGW, I_A, scr);
    const int gt = gw * 64 + F.lane, NGT = NGW * 64;
    for (int idx = gt; idx < NRT * DM; idx += NGT) { const int c = idx / DM, k = idx - c * DM; float v = 0.f;
        if (c < 4) v = F.w_group[(size_t)k * 4 + c]; else if (c < 36) v = F.w_er[((size_t)((c - 4) >> 3) * DM + k) * 8 + ((c - 4) & 7)];
        F.WrT[idx] = (bf16)(cvt_pk_bf16(v, 0.f) & 0xffffu); }
    for (size_t i = gt; i < (size_t)M * DM / 8; i += NGT) { const f32x4 a = NT_LD((const f32x4*)(F.x + 8 * i)), b = NT_LD((const f32x4*)(F.x + 8 * i + 4));
        v4u o; o.x = cvt_pk_bf16(a[0], a[1]); o.y = cvt_pk_bf16(a[2], a[3]); o.z = cvt_pk_bf16(b[0], b[1]); o.w = cvt_pk_bf16(b[2], b[3]); *(GAS v4u*)(F.XB + 8 * i) = o; }
    for (size_t i = gt; i < (size_t)M * PLE / 8; i += NGT) { const f32x4 a = NT_LD((const f32x4*)(F.p + 8 * i)), b = NT_LD((const f32x4*)(F.p + 8 * i + 4));
        v4u o; o.x = cvt_pk_bf16(a[0], a[1]); o.y = cvt_pk_bf16(a[2], a[3]); o.z = cvt_pk_bf16(b[0], b[1]); o.w = cvt_pk_bf16(b[2], b[3]); *(GAS v4u*)(F.PB + 8 * i) = o; }
    for (int idx = gt; idx < M * 32; idx += NGT) { const int m = idx >> 5, pr = idx & 31;
        const float ang = (float)F.positions[m] * (float)ROPE_INV_FREQ[pr];
        const double rev = (double)ang * 0.15915494309189535; const float fr = (float)(rev - __builtin_floor(rev));
        F.cs[2 * (size_t)idx] = __builtin_amdgcn_cosf(fr); F.cs[2 * (size_t)idx + 1] = __builtin_amdgcn_sinf(fr); }
}

__device__ __forceinline__ int crow(int r, int hi) { return (r & 3) + 8 * (r >> 2) + 4 * hi; }
__device__ __forceinline__ s16x4 tr_read(const LAS unsigned char* p) {
    typedef short v4i16_t __attribute__((ext_vector_type(4)));
    return __builtin_bit_cast(s16x4, __builtin_amdgcn_ds_read_tr16_b64_v4i16((LAS v4i16_t*)p)); }
__device__ __forceinline__ bf16x8 pack8(const f32x16& x, int s) {
    v4u p; p.x = cvt_pk_bf16(x[8 * s], x[8 * s + 1]); p.y = cvt_pk_bf16(x[8 * s + 2], x[8 * s + 3]); p.z = cvt_pk_bf16(x[8 * s + 4], x[8 * s + 5]); p.w = cvt_pk_bf16(x[8 * s + 6], x[8 * s + 7]);
    return __builtin_bit_cast(bf16x8, p); }

#define GLDS16(gptr, ldsptr) __builtin_amdgcn_global_load_lds((const unsigned*)(gptr), (LAS unsigned*)(ldsptr), 16, 0, 0)
#define ATT_WAIT_V(n) asm volatile("s_waitcnt vmcnt(" #n ")" ::: "memory")
#define ATT_WAIT_L() asm volatile("s_waitcnt lgkmcnt(0)" ::: "memory")
template <int NDQ>
__device__ __forceinline__ void att_issue(const unsigned char* base, unsigned loff, LAS unsigned char* img) {
#pragma unroll
    for (int kh = 0; kh < 2; ++kh)
#pragma unroll
        for (int dq = 0; dq < NDQ; ++dq) GLDS16(base + (size_t)kh * (16 * NIN * 2) + dq * 64 + loff, img + (kh * NDQ + dq) * 1024);
}

#define SB_ISSUE(KF, b, key0) do { const bf16* kr_ = kbase + (size_t)(key0) * NIN; \
    _Pragma("unroll") for (int s = 0; s < 8; ++s) KF[s] = *(const bf16x8*)(kr_ + 16 * s); \
    att_issue<4>(vg + (size_t)(key0) * (NIN * 2), voff, vimg + (b) * 8192); } while (0)
#define SB_TILE(KF, b, k0, NEXT) do { \
        f32x16 z; \
        _Pragma("unroll") for (int i = 0; i < 16; ++i) z[i] = 0.f; \
        _Pragma("unroll") for (int s = 0; s < 8; ++s) z = MFMA32(KF[s], qf[s], z); \
        const int cdiag = ((k0) == s0) ? c : 64;                            \
        float L[16], G[4]; \
        _Pragma("unroll") for (int i = 0; i < 16; ++i) { const float z2 = z[i], e = __builtin_amdgcn_exp2f(-__builtin_fabsf(z2)); \
            float l = __builtin_fmaxf(z2, 0.f) + __builtin_amdgcn_logf(1.0f + e);         \
            if (crow(i, hh) >= cdiag) l = 0.f;                                                 \
            L[i] = l; } \
        _Pragma("unroll") for (int g = 0; g < 4; ++g) G[g] = (L[4 * g] + L[4 * g + 1]) + (L[4 * g + 2] + L[4 * g + 3]); \
        f32x2 GP[4]; \
        _Pragma("unroll") for (int g = 0; g < 4; ++g) GP[g] = pair32(G[g]);                                   \
        float after[4]; float tail = 0.f;                                                   \
        _Pragma("unroll") for (int g = 3; g >= 0; --g) { after[g] = tail + (hh ? 0.f : GP[g].y); tail += GP[g].x + GP[g].y; } \
        f32x16 pt; \
        _Pragma("unroll") for (int g = 0; g < 4; ++g) { float run = carry + after[g]; \
            _Pragma("unroll") for (int u = 3; u >= 0; --u) { const int i = 4 * g + u; run += L[i]; \
                float a = __builtin_amdgcn_exp2f(z[i] - run); \
                if (crow(i, hh) >= cdiag) a = 0.f; \
                pt[i] = a; } } \
        carry += tail; \
        if (NEXT) ATT_WAIT_V(16); else ATT_WAIT_V(0);                       \
        const LAS unsigned char* vb = vimg + (b) * 8192 + trb; \
        _Pragma("unroll") for (int s2 = 0; s2 < 2; ++s2) { const bf16x8 pb = pack8(pt, s2); \
            _Pragma("unroll") for (int db = 0; db < 4; ++db) { \
                const s16x4 lo = tr_read(vb + (s2 * 4 + db) * 1024), hi = tr_read(vb + (s2 * 4 + db) * 1024 + 512); \
                const bf16x8 va = __builtin_shufflevector(lo, hi, 0, 1, 2, 3, 4, 5, 6, 7); \
                o[db] = MFMA32(va, pb, o[db]); } } \
    } while (0)
__device__ __forceinline__ float sb_head(const Frame& F, int m0, int s0, int h, LAS unsigned char* vimg, const LAS float* gl) {
    int lane_ = F.lane; asm volatile("" : "+v"(lane_));
    const int lane = lane_, c = lane & 31, hh = lane >> 5;
    const bf16* qrow = F.QKV + (size_t)(m0 + c) * NIN + QB0 + h * 128 + 8 * hh;
    bf16x8 qf[8];
#pragma unroll
    for (int s = 0; s < 8; ++s) qf[s] = *(const bf16x8*)(qrow + 16 * s);
    f32x16 o[4];
#pragma unroll
    for (int d = 0; d < 4; ++d)
#pragma unroll
        for (int i = 0; i < 16; ++i) o[d][i] = 0.f;
    float carry = 0.f;
    const int rowbase = m0 - s0;
    const int q4 = (lane & 15) >> 2, p4 = lane & 3, g1 = (lane >> 4) & 1;
    const int trb = (4 * hh + q4) * 64 + (16 * g1 + 4 * p4) * 2;
    const unsigned voff = (unsigned)((lane >> 2) * (NIN * 2) + (lane & 3) * 16);
    const bf16* kbase = F.QKV + (size_t)(rowbase + c) * NIN + KB0 + h * 128 + 8 * hh;
    const unsigned char* vg = (const unsigned char*)(F.QKV + (size_t)rowbase * NIN + VB0 + h * 128);
    int kt = s0 >> 5;
    bf16x8 kf[8], kn[8];
    SB_ISSUE(kf, 0, kt * 32);
    if (kt > 0) SB_ISSUE(kn, 1, kt * 32 - 32);
    for (;;) {
        SB_TILE(kf, 0, kt * 32, kt > 0);
        if (kt == 0 || __all(carry > SB_STOP)) break;
        if (kt >= 2) { ATT_WAIT_L(); SB_ISSUE(kf, 0, kt * 32 - 64); }
        --kt;
        SB_TILE(kn, 1, kt * 32, kt > 0);
        if (kt == 0 || __all(carry > SB_STOP)) break;
        if (kt >= 2) { ATT_WAIT_L(); SB_ISSUE(kn, 1, kt * 32 - 64); }
        --kt;
    }
    ATT_WAIT_V(0);
    ATT_WAIT_L();
    float ssq = 0.f;
    LAS unsigned char* ot = vimg;
    const LAS float* gp = gl + 2048 + h * 128;
    const int OCOL = 2048 + h * 128;
#pragma unroll
    for (int db = 0; db < 4; ++db)
#pragma unroll
        for (int g = 0; g < 4; ++g) { const int d0 = 32 * db + 8 * g + 4 * hh; const f32x4 gv = *(const LAS f32x4*)(gp + d0);
            const float a0 = o[db][4 * g], a1 = o[db][4 * g + 1], a2 = o[db][4 * g + 2], a3 = o[db][4 * g + 3];
            ssq += (a0 * a0 + a1 * a1) + (a2 * a2 + a3 * a3);
            if (OCOL >= OKS) *(LAS unsigned*)(ot + c * 144 + d0) = pg8::cvt_pk_fp8x4(a0 * gv[0] * 8.0f, a1 * gv[1] * 8.0f, a2 * gv[2] * 8.0f, a3 * gv[3] * 8.0f);
            else { v2u w; w.x = cvt_pk_bf16(a0 * gv[0], a1 * gv[1]); w.y = cvt_pk_bf16(a2 * gv[2], a3 * gv[3]); *(LAS v2u*)(ot + c * 272 + d0 * 2) = w; } }
    asm volatile("" ::: "memory");
    if (OCOL >= OKS) { unsigned char* ob = (unsigned char*)F.O + (size_t)(m0 + (lane >> 3)) * pg8::ORB + (2 * OKS + OCOL - OKS) + (lane & 7) * 16;
#pragma unroll
      for (int k = 0; k < 4; ++k) { const v4u val = *(const LAS v4u*)(ot + (8 * k + (lane >> 3)) * 144 + (lane & 7) * 16); *(GAS v4u*)(ob + (size_t)(8 * k) * pg8::ORB) = val; } }
    else { unsigned char* ob = (unsigned char*)F.O + (size_t)(m0 + (lane >> 4)) * pg8::ORB + 2 * OCOL + (lane & 15) * 16;
#pragma unroll
      for (int k = 0; k < 8; ++k) { const v4u val = *(const LAS v4u*)(ot + (4 * k + (lane >> 4)) * 272 + (lane & 15) * 16); *(GAS v4u*)(ob + (size_t)(4 * k) * pg8::ORB) = val; } }
    ATT_WAIT_L();
    const f32x2 sp = pair32(ssq);
    return sp.x + sp.y;
}

__device__ __forceinline__ float swa_pair(const Frame& F, int m0, int s0, int hq, LAS unsigned char* vimg, const LAS float* gl) {
    int lane_ = F.lane; asm volatile("" : "+v"(lane_));
    const int lane = lane_, c = lane & 31, hh = lane >> 5, kvh = hq >> 3;
    LAS unsigned char* kimg = vimg + 8192;
    const bf16* qrow = F.QKV + (size_t)(m0 + c) * NIN + QA0 + hq * 64 + 8 * hh;
    bf16x8 qa[4], qb[4];
#pragma unroll
    for (int s = 0; s < 4; ++s) { qa[s] = *(const bf16x8*)(qrow + 16 * s); qb[s] = *(const bf16x8*)(qrow + 64 + 16 * s); }
    f32x16 oa[2], ob[2];
#pragma unroll
    for (int d = 0; d < 2; ++d)
#pragma unroll
        for (int i = 0; i < 16; ++i) { oa[d][i] = 0.f; ob[d][i] = 0.f; }
    float mxa = F.sinks[hq] * LOG2E, mxb = F.sinks[hq + 1] * LOG2E, la = 1.0f, lb = 1.0f;
    const int rowbase = m0 - s0;
    const int q4 = (lane & 15) >> 2, p4 = lane & 3, g1 = (lane >> 4) & 1;
    const int trb = (4 * hh + q4) * 64 + (16 * g1 + 4 * p4) * 2;
    const unsigned voff = (unsigned)((lane >> 2) * (NIN * 2) + (lane & 3) * 16);
    const unsigned koff = (unsigned)((lane >> 2) * (NIN * 2) + (((lane & 3) ^ ((lane >> 4) & 3)) * 16));
    const unsigned char* kg = (const unsigned char*)(F.QKV + (size_t)rowbase * NIN + KA0 + kvh * 64);
    const unsigned char* vg = (const unsigned char*)(F.QKV + (size_t)rowbase * NIN + VA0 + kvh * 64);
    const int x4 = (c >> 2) & 3;
    const int kr0 = (c >> 4) * 2048 + (c & 15) * 64 + ((hh ^ x4) << 4), kr1 = (c >> 4) * 2048 + (c & 15) * 64 + (((2 + hh) ^ x4) << 4);
    int j = (s0 >= 128) ? 0 : (128 - s0) >> 5;
#define SWA_ISSUE(jj) do { const ptrdiff_t ko_ = (ptrdiff_t)(s0 - 128 + 32 * (jj)) * (NIN * 2); const int b_ = ((jj) & 1) * 4096; \
        att_issue<2>(kg + ko_, koff, kimg + b_); att_issue<2>(vg + ko_, voff, vimg + b_); } while (0)
    SWA_ISSUE(j);
    if (j < 4) SWA_ISSUE(j + 1);
#pragma unroll 1
    for (; j < 5; ++j) {
        const int bo = (j & 1) * 4096;
        if (j < 4) ATT_WAIT_V(8); else ATT_WAIT_V(0);
        bf16x8 kf[4];
#pragma unroll
        for (int s = 0; s < 4; ++s) kf[s] = *(const LAS bf16x8*)(kimg + bo + ((s & 1) ? kr1 : kr0) + (s >> 1) * 1024);
        f32x16 za, zb;
#pragma unroll
        for (int i = 0; i < 16; ++i) { za[i] = 0.f; zb[i] = 0.f; }
#pragma unroll
        for (int s = 0; s < 4; ++s) { za = MFMA32(kf[s], qa[s], za); zb = MFMA32(kf[s], qb[s], zb); }
        const int wlo = (j == 0) ? c : -1, whi = (j == 4) ? c : 64;
        float tma = -1e30f, tmb = -1e30f;
#pragma unroll
        for (int i = 0; i < 16; ++i) { const int r = crow(i, hh); if (r <= wlo || r > whi) { za[i] = -1e30f; zb[i] = -1e30f; }
            tma = __builtin_fmaxf(tma, za[i]); tmb = __builtin_fmaxf(tmb, zb[i]); }
        const f32x2 tpa = pair32(tma), tpb = pair32(tmb);
        const float mna = __builtin_fmaxf(mxa, __builtin_fmaxf(tpa.x, tpa.y)), ala = __builtin_amdgcn_exp2f(mxa - mna);
        const float mnb = __builtin_fmaxf(mxb, __builtin_fmaxf(tpb.x, tpb.y)), alb = __builtin_amdgcn_exp2f(mxb - mnb);
        f32x16 pa, pb; float psa = 0.f, psb = 0.f;
#pragma unroll
        for (int i = 0; i < 16; ++i) { pa[i] = __builtin_amdgcn_exp2f(za[i] - mna); psa += pa[i]; pb[i] = __builtin_amdgcn_exp2f(zb[i] - mnb); psb += pb[i]; }
        const f32x2 ppa = pair32(psa), ppb = pair32(psb);
        la = la * ala + (ppa.x + ppa.y); mxa = mna; lb = lb * alb + (ppb.x + ppb.y); mxb = mnb;
#pragma unroll
        for (int d = 0; d < 2; ++d)
#pragma unroll
            for (int i = 0; i < 16; ++i) { oa[d][i] *= ala; ob[d][i] *= alb; }
        const LAS unsigned char* vb = vimg + bo + trb;
#pragma unroll
        for (int s2 = 0; s2 < 2; ++s2) { const bf16x8 fa = pack8(pa, s2), fb = pack8(pb, s2);
#pragma unroll
            for (int db = 0; db < 2; ++db) {
                const s16x4 lo = tr_read(vb + (s2 * 2 + db) * 1024), hi = tr_read(vb + (s2 * 2 + db) * 1024 + 512);
                const bf16x8 va = __builtin_shufflevector(lo, hi, 0, 1, 2, 3, 4, 5, 6, 7);
                oa[db] = MFMA32(va, fa, oa[db]); ob[db] = MFMA32(va, fb, ob[db]); } }
        if (j < 3) { ATT_WAIT_L(); SWA_ISSUE(j + 2); }
    }
#undef SWA_ISSUE
    const float inva = 1.0f / la, invb = 1.0f / lb;
    ATT_WAIT_L();
    float ssq = 0.f;
    LAS unsigned char* ot = vimg;
    const LAS float* gp = gl + hq * 64;
    const int OCOL = hq * 64;
#pragma unroll
    for (int db = 0; db < 2; ++db)
#pragma unroll
        for (int g = 0; g < 4; ++g) { const int d0 = 32 * db + 8 * g + 4 * hh; const f32x4 gva = *(const LAS f32x4*)(gp + d0), gvb = *(const LAS f32x4*)(gp + 64 + d0);
            const float a0 = oa[db][4 * g] * inva, a1 = oa[db][4 * g + 1] * inva, a2 = oa[db][4 * g + 2] * inva, a3 = oa[db][4 * g + 3] * inva;
            const float b0 = ob[db][4 * g] * invb, b1 = ob[db][4 * g + 1] * invb, b2 = ob[db][4 * g + 2] * invb, b3 = ob[db][4 * g + 3] * invb;
            ssq += ((a0 * a0 + a1 * a1) + (a2 * a2 + a3 * a3)) + ((b0 * b0 + b1 * b1) + (b2 * b2 + b3 * b3));
            if (OCOL >= OKS) { *(LAS unsigned*)(ot + c * 144 + d0) = pg8::cvt_pk_fp8x4(a0 * gva[0] * 8.0f, a1 * gva[1] * 8.0f, a2 * gva[2] * 8.0f, a3 * gva[3] * 8.0f);
                *(LAS unsigned*)(ot + c * 144 + 64 + d0) = pg8::cvt_pk_fp8x4(b0 * gvb[0] * 8.0f, b1 * gvb[1] * 8.0f, b2 * gvb[2] * 8.0f, b3 * gvb[3] * 8.0f); }
            else { v2u w; w.x = cvt_pk_bf16(a0 * gva[0], a1 * gva[1]); w.y = cvt_pk_bf16(a2 * gva[2], a3 * gva[3]); *(LAS v2u*)(ot + c * 272 + d0 * 2) = w;
                v2u x; x.x = cvt_pk_bf16(b0 * gvb[0], b1 * gvb[1]); x.y = cvt_pk_bf16(b2 * gvb[2], b3 * gvb[3]); *(LAS v2u*)(ot + c * 272 + 128 + d0 * 2) = x; } }
    asm volatile("" ::: "memory");
    if (OCOL >= OKS) { unsigned char* obp = (unsigned char*)F.O + (size_t)(m0 + (lane >> 3)) * pg8::ORB + (2 * OKS + OCOL - OKS) + (lane & 7) * 16;
#pragma unroll
      for (int k = 0; k < 4; ++k) { const v4u val = *(const LAS v4u*)(ot + (8 * k + (lane >> 3)) * 144 + (lane & 7) * 16); *(GAS v4u*)(obp + (size_t)(8 * k) * pg8::ORB) = val; } }
    else { unsigned char* obp = (unsigned char*)F.O + (size_t)(m0 + (lane >> 4)) * pg8::ORB + 2 * OCOL + (lane & 15) * 16;
#pragma unroll
      for (int k = 0; k < 8; ++k) { const v4u val = *(const LAS v4u*)(ot + (4 * k + (lane >> 4)) * 272 + (lane & 15) * 16); *(GAS v4u*)(obp + (size_t)(4 * k) * pg8::ORB) = val; } }
    ATT_WAIT_L();
    const f32x2 sp = pair32(ssq);
    return sp.x + sp.y;
}

__device__ __forceinline__ void p2_attention(Frame& F) {
    LAS unsigned char* vimg = F.lds + F.wave * ATT_VIMG;
    LAS float* red = (LAS float*)(F.lds + ATT_RED);
    LAS float* gl = (LAS float*)(F.lds + ATT_G);
    { const int i4 = 4 * F.tid;
      *(LAS f32x4*)(gl + i4) = *(const f32x4*)(F.g_a + i4); *(LAS f32x4*)(gl + 2048 + i4) = *(const f32x4*)(F.g_b + i4); }
    __syncthreads();
    for (int u = F.vcu; u < M / 32; u += F.G) {
        const int m0 = 32 * u, s0 = m0 & (SEQ - 1);
        float sa = 0.f, sb = 0.f;
        if (F.wave >= 4) __builtin_amdgcn_s_setprio(1); else __builtin_amdgcn_s_setprio(0);
#pragma unroll 1
        for (int i = 0; i < 2; ++i) sa += swa_pair(F, m0, s0, 4 * F.wave + 2 * i, vimg, gl);
        if (F.wave >= 4) __builtin_amdgcn_s_setprio(0); else __builtin_amdgcn_s_setprio(1);
#pragma unroll 1
        for (int i = 0; i < 2; ++i) sb += sb_head(F, m0, s0, 2 * F.wave + i, vimg, gl);
        __builtin_amdgcn_s_setprio(0);
        if (F.lane < 32) { red[(F.wave * 32 + F.lane) * 2] = sa; red[(F.wave * 32 + F.lane) * 2 + 1] = sb; }
        __syncthreads();
        if (F.tid < 32) { float ta = 0.f, tb = 0.f;
#pragma unroll
            for (int w = 0; w < 8; ++w) { ta += red[(w * 32 + F.tid) * 2]; tb += red[(w * 32 + F.tid) * 2 + 1]; }
            F.rr[2 * (size_t)(m0 + F.tid)] = 1.0f / __builtin_sqrtf(ta * (1.0f / 2048.0f) + RMS_EPS);
            F.rr[2 * (size_t)(m0 + F.tid) + 1] = 1.0f / __builtin_sqrtf(tb * (1.0f / 2048.0f) + RMS_EPS); }
        __syncthreads();
    }
}

__device__ __forceinline__ void p4_ln1_router(Frame& F, float* x1dst, int cw_cnt) {
    LAS unsigned char* ximg = F.lds;
    LAS float* red = (LAS float*)(F.lds + LN_RED);
    LAS float* lg = (LAS float*)(F.lds + LN_LOG);
    LAS float* bt = (LAS float*)(F.lds + LN_LOG + 3072);
    const int lane = F.lane, w = F.wave;
    if (F.tid < NRT) bt[F.tid] = F.tid < 4 ? F.b_group[F.tid] : (F.tid < 36 ? F.b_er[F.tid - 4] : 0.f);
    for (int it = F.vcu; it < M / 16; it += F.G) {
        const int row0 = 16 * it;
        v4u raw[2][8];
#pragma unroll
        for (int r2 = 0; r2 < 2; ++r2)
#pragma unroll
            for (int j = 0; j < 8; ++j) raw[r2][j] = *(const GAS v4u*)(F.Y1B + (size_t)(row0 + 2 * w + r2) * DM + 8 * lane + 512 * j);
#define LN_DEC(wd, lo4, hi4) const f32x4 lo4 = {__uint_as_float((wd).x << 16), __uint_as_float((wd).x & 0xffff0000u), __uint_as_float((wd).y << 16), __uint_as_float((wd).y & 0xffff0000u)}, \
                                         hi4 = {__uint_as_float((wd).z << 16), __uint_as_float((wd).z & 0xffff0000u), __uint_as_float((wd).w << 16), __uint_as_float((wd).w & 0xffff0000u)}
        float mean[2], rstd[2];
#pragma unroll
        for (int r2 = 0; r2 < 2; ++r2) { float s = 0.f;
#pragma unroll
            for (int j = 0; j < 8; ++j) { LN_DEC(raw[r2][j], a, b); s += ((a[0] + a[1]) + (a[2] + a[3])) + ((b[0] + b[1]) + (b[2] + b[3])); }
            mean[r2] = wave_sum(s) * (1.0f / DM); float q = 0.f;
#pragma unroll
            for (int j = 0; j < 8; ++j) { LN_DEC(raw[r2][j], a0, b0); const f32x4 a = a0 - mean[r2], b = b0 - mean[r2]; q += ((a[0] * a[0] + a[1] * a[1]) + (a[2] * a[2] + a[3] * a[3])) + ((b[0] * b[0] + b[1] * b[1]) + (b[2] * b[2] + b[3] * b[3])); }
            rstd[r2] = 1.0f / __builtin_sqrtf(wave_sum(q) * (1.0f / DM) + LN_EPS);
            if (lane == 0) *(f32x2*)(x1dst + 2 * (size_t)(row0 + 2 * w + r2)) = (f32x2){mean[r2], rstd[r2]}; }
#pragma unroll
        for (int j = 0; j < 8; ++j) { const int col = 8 * lane + 512 * j;
            const f32x4 g0 = *(const f32x4*)(F.ln1_g + col), g1 = *(const f32x4*)(F.ln1_g + col + 4), b0 = *(const f32x4*)(F.ln1_b + col), b1 = *(const f32x4*)(F.ln1_b + col + 4);
#pragma unroll
            for (int r2 = 0; r2 < 2; ++r2) { const int lr = 2 * w + r2, row = row0 + lr;
                LN_DEC(raw[r2][j], ya, yc);
                const f32x4 xa = (ya - mean[r2]) * rstd[r2] * g0 + b0, xc = (yc - mean[r2]) * rstd[r2] * g1 + b1;
                v4u pk; pk.x = cvt_pk_bf16(xa[0], xa[1]); pk.y = cvt_pk_bf16(xa[2], xa[3]); pk.z = cvt_pk_bf16(xc[0], xc[1]); pk.w = cvt_pk_bf16(xc[2], xc[3]);
                v2u p8; p8.x = pg8::cvt_pk_fp8x4(xa[0], xa[1], xa[2], xa[3]); p8.y = pg8::cvt_pk_fp8x4(xc[0], xc[1], xc[2], xc[3]);
                *(GAS v2u*)(F.X18 + (size_t)row * DM + col) = p8;
                *(LAS v4u*)(ximg + lr * LN_ROWB + col * 2) = pk; }
            if ((j & 1) == 1) asm volatile("" ::: "memory"); }
#undef LN_DEC
        __syncthreads();
        f32x4 acc[3];
#pragma unroll
        for (int cb = 0; cb < 3; ++cb) acc[cb] = (f32x4){0.f, 0.f, 0.f, 0.f};
#pragma unroll 8
        for (int ks = 0; ks < 16; ++ks) { const int k0 = 512 * w + 32 * ks + 8 * (lane >> 4);
            const bf16x8 a = *(const LAS bf16x8*)(ximg + (lane & 15) * LN_ROWB + k0 * 2);
#pragma unroll
            for (int cb = 0; cb < 3; ++cb) { const bf16x8 b = *(const bf16x8*)(F.WrT + (size_t)(16 * cb + (lane & 15)) * DM + k0); acc[cb] = MFMA16(a, b, acc[cb]); } }
#pragma unroll
        for (int cb = 0; cb < 3; ++cb)
#pragma unroll
            for (int j = 0; j < 4; ++j) red[(w * 16 + 4 * (lane >> 4) + j) * NRT + 16 * cb + (lane & 15)] = acc[cb][j];
        __syncthreads();
        for (int idx = F.tid; idx < 16 * NRT; idx += NWAVES * 64) { float t = 0.f;
#pragma unroll
            for (int ww = 0; ww < 8; ++ww) t += red[ww * 16 * NRT + idx];
            lg[idx] = t + bt[idx % NRT]; }
        __syncthreads();
        if (F.tid < 16) {
            const int tok = row0 + F.tid; const LAS float* lp = lg + F.tid * NRT;
            float gl[4]; int gi = 0;
#pragma unroll
            for (int cgi = 0; cgi < 4; ++cgi) gl[cgi] = lp[cgi];
#pragma unroll
            for (int cgi = 1; cgi < 4; ++cgi) if (gl[cgi] > gl[gi]) gi = cgi;
            float den = 0.f;
#pragma unroll
            for (int cgi = 0; cgi < 4; ++cgi) den += __expf(gl[cgi] - gl[gi]);
            const float gw = 1.0f / den;
            float el[8];
#pragma unroll
            for (int e = 0; e < 8; ++e) el[e] = lp[4 + 8 * gi + e];
            int i0 = 0;
#pragma unroll
            for (int e = 1; e < 8; ++e) if (el[e] > el[i0]) i0 = e;
            int i1 = (i0 == 0) ? 1 : 0;
#pragma unroll
            for (int e = 0; e < 8; ++e) if (e != i0 && el[e] > el[i1]) i1 = e;
            const float w0 = 1.0f / (1.0f + __expf(el[i1] - el[i0])), w1 = 1.0f - w0;
            const int e0 = 8 * gi + i0, e1 = 8 * gi + i1;
            const unsigned sl0 = __hip_atomic_fetch_add(F.ctl + cw_cnt + 64 * e0, 1u, RLX_AGENT);
            const unsigned sl1 = __hip_atomic_fetch_add(F.ctl + cw_cnt + 64 * e1, 1u, RLX_AGENT);
            F.list[e0 * M + sl0] = 2 * tok; F.list[e1 * M + sl1] = 2 * tok + 1;
            F.wts[2 * tok] = w0 * gw; F.wts[2 * tok + 1] = w1 * gw;
        }
    }
}

__device__ __forceinline__ void build_tab(Frame& F) {
    LAS int* tab = (LAS int*)(F.lds + TAB_OFF);
    __syncthreads();
    if (F.tid < NEXP) tab[33 + F.tid] = (int)__hip_atomic_load(F.ctl + CW_CNT + 64 * F.tid, RLX_AGENT);
    __syncthreads();
    if (F.tid == 0) { int a = 0; for (int e = 0; e < NEXP; ++e) { tab[e] = a; a += (tab[33 + e] + 255) >> 8; } tab[32] = a; }
    __syncthreads();
}

__device__ __forceinline__ void p9_ln2(Frame& F, float* dst) {
    const int gw = F.vcu * NWAVES + F.wave, NGW = F.G * NWAVES, lane = F.lane;
    for (int row = gw; row < M; row += NGW) {
        const bf16* y2 = F.Y2B + (size_t)row * DM + 8 * lane;
        const bf16* m0 = F.MOE + (size_t)row * DM + 8 * lane; const bf16* m1 = m0 + (size_t)M * DM;
        f32x4 v[16]; float s = 0.f;
#pragma unroll
        for (int j = 0; j < 8; ++j) { const v4u y = NT_LD((const GAS v4u*)(y2 + 512 * j)), a = NT_LD((const GAS v4u*)(m0 + 512 * j)), b = NT_LD((const GAS v4u*)(m1 + 512 * j));
#define BF3(f) ((__uint_as_float((y.f) << 16) + __uint_as_float((a.f) << 16)) + __uint_as_float((b.f) << 16))
#define BF3H(f) ((__uint_as_float((y.f) & 0xffff0000u) + __uint_as_float((a.f) & 0xffff0000u)) + __uint_as_float((b.f) & 0xffff0000u))
            v[2 * j] = (f32x4){BF3(x), BF3H(x), BF3(y), BF3H(y)}; v[2 * j + 1] = (f32x4){BF3(z), BF3H(z), BF3(w), BF3H(w)};
#undef BF3
#undef BF3H
            s += ((v[2 * j][0] + v[2 * j][1]) + (v[2 * j][2] + v[2 * j][3])) + ((v[2 * j + 1][0] + v[2 * j + 1][1]) + (v[2 * j + 1][2] + v[2 * j + 1][3]));
            if ((j & 1) == 1) asm volatile("" ::: "memory"); }
        const float mean = wave_sum(s) * (1.0f / DM); float q = 0.f;
#pragma unroll
        for (int j = 0; j < 16; ++j) { v[j] = v[j] - mean; q += (v[j][0] * v[j][0] + v[j][1] * v[j][1]) + (v[j][2] * v[j][2] + v[j][3] * v[j][3]); }
        const float rstd = 1.0f / __builtin_sqrtf(wave_sum(q) * (1.0f / DM) + LN_EPS);
#pragma unroll
        for (int j = 0; j < 8; ++j) { const int col = 8 * lane + 512 * j;
            const f32x4 g0 = *(const f32x4*)(F.ln2_g + col), g1 = *(const f32x4*)(F.ln2_g + col + 4), b0 = *(const f32x4*)(F.ln2_b + col), b1 = *(const f32x4*)(F.ln2_b + col + 4);
            NT_ST(v[2 * j] * rstd * g0 + b0, (f32x4*)(dst + (size_t)row * DM + col)); NT_ST(v[2 * j + 1] * rstd * g1 + b1, (f32x4*)(dst + (size_t)row * DM + col + 4));
            if ((j & 1) == 1) asm volatile("" ::: "memory"); }
    }
}

__global__ void __launch_bounds__(NWAVES * 64, 2) hymba_fwd(Args args) {
    extern __shared__ __attribute__((aligned(16))) unsigned char lds[];
    Frame F;
    F.lds = (LAS unsigned char*)lds;
    F.MISC = (volatile LAS unsigned*)(F.lds + MISC_OFF);
    F.wave0 = __builtin_amdgcn_readfirstlane((int)threadIdx.x >> 6);
#define KTID() (F.wave0 * 64 + hw_lane())
    F.tid = KTID(); F.lane = F.tid & 63; F.wave = F.wave0;
    F.G = gridDim.x; { const int bx = blockIdx.x; F.vcu = (F.G % 8 == 0) ? (bx % 8) * (F.G / 8) + bx / 8 : bx; }
    F.ctl = (gu32*)(args.ws + WS_CTL);
    for (int u = KTID(); u < (LDS_BYTES - MISC_OFF) / 4; u += NWAVES * 64) ((LAS unsigned*)(F.lds + MISC_OFF))[u] = 0u;
    __syncthreads();
    XcdBarrier bar; bar.bar = (unsigned*)(F.ctl + CW_BAR); bar.x = 0; bar.st = nullptr;
    const unsigned ctl_tag = (((unsigned)(size_t)__builtin_amdgcn_dispatch_ptr() >> 6) << 1) | 1u;
    if (N_LAUNCHES == 1 && blockIdx.x == 0) {
        for (int u = KTID(); u < (int)(CTL_ZERO_BYTES / 4); u += NWAVES * 64) __hip_atomic_store(F.ctl + u, 0u, RLX_AGENT);
        __builtin_amdgcn_fence(__ATOMIC_RELEASE, "agent");
        asm volatile("s_waitcnt vmcnt(0)" ::: "memory");
        __syncthreads();
        if (KTID() == 0) __hip_atomic_store(F.ctl + CW_READY, ctl_tag, __ATOMIC_RELEASE, __HIP_MEMORY_SCOPE_AGENT);
    }
    bool ctl_ready = (N_LAUNCHES != 1);
#define CTL_READY() do { if (!ctl_ready) { ctl_ready = true; \
        if (KTID() == 0) { unsigned sp_ = 0; while (__hip_atomic_load(F.ctl + CW_READY, __ATOMIC_ACQUIRE, __HIP_MEMORY_SCOPE_AGENT) != ctl_tag) { __builtin_amdgcn_s_sleep(2); if (++sp_ > (1u << 22)) break; } } \
        __syncthreads(); bar = xcd_barrier_post((unsigned*)(F.ctl + CW_BAR), F.MISC + 8, KTID() == 0); } } while (0)
#define GRID_BAR() do { if (N_LAUNCHES == 1) { CTL_READY(); xcd_barrier(bar, KTID() == 0); } } while (0)
    const int lo = args.ph_lo, hi = args.ph_hi;
#ifndef PH_MASK
#define PH_MASK 0x3ff
#endif
#define IN(k) (((PH_MASK >> (k)) & 1) && lo <= (k) && (k) < hi)
#define BOTH(k) (IN(k) && IN((k) + 1))
#ifndef PROBE_REP
#define PROBE_REP 0
#endif
#define REP(k) (((PROBE_REP >> (k)) & 1) ? 2 : 1)
    const LAS int* tab = (const LAS int*)(F.lds + TAB_OFF);

    if (IN(0)) { Frame P = F; fill_ptrs(P); for (int rep = 0; rep < REP(0); ++rep) p0_prologue(P); if (BOTH(0)) GRID_BAR(); }
    if (IN(1)) { Frame P = F; fill_ptrs(P);
        { pg8::Gemm g{P.PB, P.WpT, M, DM, PLE}; pg8::StaticOrder S; S.init(M, DM, F.G, (int)blockIdx.x);
          pg8::EpiPlainBf16 E{P.PP, DM};
          pg8::gemm_phase<pg8::EpiPlainBf16, pg8::StaticOrder, true, true>(F.lds + RING_OFF, g, S, E, P.tid); }
        const int NG = (F.G == 256) ? 218 : F.G;
#ifndef STAG_CHUNKS
#define STAG_CHUNKS 4
#endif
        if (STAG_CHUNKS > 0 && (int)blockIdx.x < NG && ((blockIdx.x >> 3) & 1)) conv_queue(P, STAG_CHUNKS);
        if ((int)blockIdx.x < NG) { pg8::Gemm g{P.XB, P.WinT, M, NIN, DM}; pg8::StaticOrder S; S.init(M, NIN, NG, (int)blockIdx.x);
          pg8::EpiProj E{P.QKV, P.b_in, P.cs};
          for (int rep = 0; rep < REP(1); ++rep) pg8::gemm_phase<pg8::EpiProj, pg8::StaticOrder, true, true>(F.lds + RING_OFF, g, S, E, P.tid); }
        conv_queue(P);
        if (BOTH(1)) GRID_BAR();
    }
    if (IN(2)) { Frame P = F; fill_ptrs(P); for (int rep = 0; rep < REP(2); ++rep) p2_attention(P); if (BOTH(2)) GRID_BAR(); }
    if (IN(3)) { Frame P = F; fill_ptrs(P);
        pg8::Gemm g{P.O, P.WoutT, M, DM, D_FP8 ? pg8::ORB : DM}; pg8::StaticOrder S; S.init(M, DM, F.G, (int)blockIdx.x);
        pg8::EpiWout E{P.XB, P.Y1B, P.b_out, P.rr};
        for (int rep = 0; rep < REP(3); ++rep) pg8::gemm_phase<pg8::EpiWout, pg8::StaticOrder, true, true, D_FP8 ? 1 : 2, pg8::O_TSPLIT, D_FP8 ? 0x79797979 : 0x7c7c7c7c>(F.lds + RING_OFF, g, S, E, P.tid);
        if (BOTH(3)) GRID_BAR();
    }
    if (IN(4)) { Frame P = F; fill_ptrs(P);
        p4_ln1_router(P, P.stats, CW_CNT); if (BOTH(4)) GRID_BAR(); }
    if (IN(5)) { Frame P = F; fill_ptrs(P);
    }
    if (IN(6)) { Frame P = F; fill_ptrs(P);
        build_tab(P);
        const int G = F.G, c = (int)blockIdx.x, U6 = 4 * tab[32]; int x = 3 * G - U6; x = x < 0 ? 0 : (x > 512 ? 512 : x);
        int n6 = 0; while (n6 < 3 && c + G * n6 < U6) ++n6;
        if (U6 > 3 * G) n6 = 1 << 20;
        { pg8::Gemm g{(const pg8::bf16_t*)P.X18, (const pg8::bf16_t*)P.Wgu8, M, NEXP * 1024, DM}; pg8::GroupedList<true> S{tab, 4, tab[32], c, G, n6, P.list};
          pg8::EpiGateUp E{P.H8};
          pg8::gemm_phase<pg8::EpiGateUp, pg8::GroupedList<true>, true, true, 1>(F.lds + RING_OFF, g, S, E, P.tid); }
        { pg8::Gemm g{(const pg8::bf16_t*)P.X18, (const pg8::bf16_t*)P.Wg8, M, DM, DM}; pg8::DenseList S; const int lf = c + G * n6 - U6;
          int n8f = 0; if (n6 <= 3) { while (lf + G * n8f < x) ++n8f; }
          S.init(M, DM, lf, G, n8f);
          pg8::EpiPle E{P.Y1B, P.Y2B, P.b_pg, P.PP, P.stats, P.ln1_g, P.ln1_b};
          pg8::gemm_phase<pg8::EpiPle, pg8::DenseList, true, true, 1>(F.lds + RING_OFF, g, S, E, P.tid); }
        if (BOTH(6)) GRID_BAR();
    }
    if (IN(7)) { Frame P = F; fill_ptrs(P);
        build_tab(P);
        const int G = F.G, c = (int)blockIdx.x, U6 = 4 * tab[32]; int x = 3 * G - U6; x = x < 0 ? 0 : (x > 512 ? 512 : x);
        const int n8 = 512 - x;
        const bool one_each = n8 <= G;
        { pg8::Gemm g{(const pg8::bf16_t*)P.X18, (const pg8::bf16_t*)P.Wg8, M, DM, DM}; pg8::DenseList S;
          if (one_each) S.init(M, DM, x + c, 1, c < n8 ? 1 : 0); else S.init(M, DM, x + c, G, 1 << 20);
          pg8::EpiPle E{P.Y1B, P.Y2B, P.b_pg, P.PP, P.stats, P.ln1_g, P.ln1_b};
          pg8::gemm_phase<pg8::EpiPle, pg8::DenseList, true, true, 1>(F.lds + RING_OFF, g, S, E, P.tid); }
        { pg8::Gemm g{(const pg8::bf16_t*)P.H8, (const pg8::bf16_t*)P.Wd8, MPAD_MAX, NEXP * DM, DEXP};
          const int nw = one_each ? (G - n8) : G;
          int na = 0;
#if G_BALANCE
          if (one_each && n8 > 0 && nw > 0) { const int U = 16 * tab[32]; int best = 1 << 30;
              for (int a = 0; a <= 3 && a * n8 <= U; ++a) { const int rest = U - a * n8, per = (rest + nw - 1) / nw; const int cost = (46 + 10 * a) > 10 * per ? (46 + 10 * a) : 10 * per; if (cost < best) { best = cost; na = a; } } }
#endif
          const bool ple_wg = one_each && c < n8;
          pg8::GroupedList<false> S{tab, 16, tab[32], one_each ? (ple_wg ? c : na * n8 + (c - n8)) : c, one_each ? (ple_wg ? (n8 > 0 ? n8 : 1) : (nw > 0 ? nw : 1)) : G,
                                    one_each ? (ple_wg ? na : (nw <= 0 ? 0 : (1 << 20))) : (1 << 20), nullptr};
          pg8::EpiDown E{P.MOE, P.list, P.wts, tab + 33};
          pg8::gemm_phase<pg8::EpiDown, pg8::GroupedList<false>, true, true, 1>(F.lds + RING_OFF, g, S, E, P.tid); }
        if (BOTH(7)) GRID_BAR();
    }
    if (IN(8)) { Frame P = F; fill_ptrs(P); if (REP(8) == 2) p9_ln2(P, (float*)P.XG);
        p9_ln2(P, P.out); }
    if (N_LAUNCHES == 1 && blockIdx.x == 0 && KTID() == 0) __hip_atomic_store(F.ctl + CW_READY, 0u, RLX_AGENT);
#undef IN
#undef BOTH
#undef GRID_BAR
}

extern "C" void kernel_launch(void* const* d_in, const int* in_sizes, int n_in, void* d_out, int out_size, void* d_ws, size_t ws_size, hipStream_t stream) {
    static int grid = 0;
    if (grid == 0) {
        if (n_in != 24 || in_sizes[0] != M * DM || out_size != M * DM || ws_size < WS_END) { fprintf(stderr, "kernel_launch: unexpected shapes (n_in %d, in0 %d, out %d, ws %zu < %zu); nothing launched\n", n_in, n_in > 0 ? in_sizes[0] : -1, out_size, ws_size, (size_t)WS_END); grid = -1; return; }
        int dev = 0, cus = 0, per_cu = 0;
        if (hipGetDevice(&dev) != hipSuccess || hipDeviceGetAttribute(&cus, hipDeviceAttributeMultiprocessorCount, dev) != hipSuccess) { fprintf(stderr, "kernel_launch: device query failed\n"); grid = -1; return; }
        if (hipFuncSetAttribute((const void*)hymba_fwd, hipFuncAttributeMaxDynamicSharedMemorySize, LDS_BYTES) != hipSuccess) { fprintf(stderr, "kernel_launch: hipFuncSetAttribute failed\n"); grid = -1; return; }
        if (hipOccupancyMaxActiveBlocksPerMultiprocessor(&per_cu, (const void*)hymba_fwd, NWAVES * 64, LDS_BYTES) != hipSuccess || per_cu < 1)
            fprintf(stderr, "kernel_launch: note: occupancy query reports %d workgroups per CU\n", per_cu);
        (void)hipGetLastError();
        grid = cus < 256 ? cus : 256;
    }
    if (grid < 0) return;
    if (N_LAUNCHES != 1 && hipMemsetAsync((char*)d_ws + WS_CTL, 0, CTL_ZERO_BYTES, stream) != hipSuccess) { fprintf(stderr, "kernel_launch: hipMemsetAsync failed\n"); return; }
    Args a{};
    for (int i = 0; i < 24; ++i) a.in[i] = d_in[i];
    a.out = (float*)d_out; a.ws = (unsigned char*)d_ws;
    for (int li = 0; li < N_LAUNCHES; ++li) {
        a.ph_lo = (N_LAUNCHES == 1) ? 0 : li; a.ph_hi = (N_LAUNCHES == 1) ? N_PHASES : li + 1;
        hipLaunchKernelGGL(hymba_fwd, dim3(grid), dim3(NWAVES * 64), LDS_BYTES, stream, a);
        const hipError_t le = hipPeekAtLastError();
        if (le != hipSuccess) { fprintf(stderr, "kernel_launch: launch %d failed: %s\n", li, hipGetErrorName(le)); break; }
    }
}
```
